# Optimizing an MI355X kernel written in HIP

```python
import math
import jax
import jax.numpy as jnp
from jax import lax
import numpy as np

D_MODEL = 2048
BATCH = 16
SEQ = 256
DEPTH = 2
DEC_BATCH = 8
DEC_SEQ = 1024
PAST_LEN = 512

GRID_W = 64
N_EVEN = (DEPTH + 1) // 2
N_ODD = DEPTH // 2
MIX_W = D_MODEL
HEAD_DIM = 128
HY_W = MIX_W // 2
HY_ORDER = 2
SHORT_CONV = 3
POS_EMB = 33
FILTER_ORDER = 64
HY_FAST_DECAY = 0.3
HY_SLOW_DECAY = 1.5
HY_TARGET = 1e-2
ATT_HEADS = (MIX_W // 2) // HEAD_DIM
ATT_KV_HEADS = ATT_HEADS // 4
ATT_GROUP = ATT_HEADS // ATT_KV_HEADS
WINDOW = 128
BLK = 128
EV_IN = (HY_ORDER + 1) * HY_W + (ATT_HEADS + 2 * ATT_KV_HEADS) * HEAD_DIM
HG_W = MIX_W // 2
HG_HEADS = HG_W // HEAD_DIM
HG_DK = HEAD_DIM
HG_DV = HEAD_DIM
CHUNK = 64
Q_LORA = 512
KV_LORA = 256
NOPE = 128
ROPE = 64
V_DIM = 128
MLA_HEADS = (MIX_W // 2) // V_DIM
OD_IN = 5 * HG_W + Q_LORA + KV_LORA + ROPE
D_FF = 5632
MACARON_W = 0.5
N_MOD = 9
ROPE_BASE = 10000.0
EPS = 1e-6
QBLK = 128
ATT_SCALE = HEAD_DIM ** -0.5
MLA_SCALE = (NOPE + ROPE) ** -0.5

kernel_name = 'hybrid_diffusion_prefix_step'


def _rmsnorm(x, g):
    xf = x.astype(jnp.float32)
    y = xf * lax.rsqrt(jnp.mean(xf * xf, axis=-1, keepdims=True) + EPS)
    return (y * g.astype(jnp.float32)).astype(x.dtype)


def _modulation(cvec, w, b):
    m = jax.nn.silu(cvec) @ w + b
    return m.reshape(cvec.shape[0], N_MOD, 1, D_MODEL)


def _modulate(x, g, mods, j):
    return _rmsnorm(x, g) * (1.0 + mods[:, 3 * j + 1]) + mods[:, 3 * j]


def _residual(x, out, g, mods, j, w):
    return x + w * mods[:, 3 * j + 2] * _rmsnorm(out.astype(x.dtype), g)


def _ffn_sublayer(x, mods, j, g_pre, g_post, wg, wu, wd):
    h = _modulate(x, g_pre, mods, j)
    out = (jax.nn.silu(h @ wg) * (h @ wu)) @ wd
    return _residual(x, out, g_post, mods, j, MACARON_W)


def _axial_angles(L, rot_dim):
    rows = L // GRID_W
    half = rot_dim // 2
    inv = ROPE_BASE ** (-jnp.arange(0, half, 2, dtype=jnp.float32) / half)
    row = jnp.repeat(jnp.arange(rows), GRID_W).astype(jnp.float32)
    col = jnp.tile(jnp.arange(GRID_W), rows).astype(jnp.float32)
    return row[:, None] * inv, col[:, None] * inv


def _rot_half(x, ang):
    x1, x2 = jnp.split(x, 2, axis=-1)
    cos = jnp.cos(ang).astype(x.dtype)
    sin = jnp.sin(ang).astype(x.dtype)
    return jnp.concatenate([x1 * cos - x2 * sin, x2 * cos + x1 * sin], axis=-1)


def _rope2d(x):
    row, col = _axial_angles(x.shape[-2], x.shape[-1])
    xr, xc = jnp.split(x, 2, axis=-1)
    return jnp.concatenate([_rot_half(xr, row), _rot_half(xc, col)], axis=-1)


def _probs(s, sink):
    if sink is None:
        return jax.nn.softmax(s, axis=-1)
    sk = sink.astype(jnp.float32)[None, :, :, None, None]
    m = jnp.maximum(jnp.max(s, axis=-1, keepdims=True), sk)
    p = jnp.exp(s - m)
    return p / (jnp.sum(p, axis=-1, keepdims=True) + jnp.exp(sk - m))


def _attend_dense(q, k, v, scale, sink=None):
    B, Hk, G, Lq, dq = q.shape
    nb = Lq // QBLK
    qb = jnp.moveaxis(q.reshape(B, Hk, G, nb, QBLK, dq), 3, 0)

    def one(qi):
        s = jnp.einsum('bhgqd,bhkd->bhgqk', qi, k).astype(jnp.float32) * scale
        p = _probs(s, sink)
        return jnp.einsum('bhgqk,bhkd->bhgqd', p.astype(v.dtype), v)

    o = lax.map(one, qb)
    return jnp.moveaxis(o, 0, 3).reshape(B, Hk, G, Lq, v.shape[-1])


def _attend_window_ctx(q, k, v, k_ctx, v_ctx, sink, scale):
    B, Hk, G, L, d = q.shape
    nb = L // BLK

    def band(a):
        ap = jnp.pad(a, ((0, 0), (0, 0), (BLK, BLK), (0, 0))).reshape(B, Hk, nb + 2, BLK, a.shape[-1])
        return jnp.concatenate([ap[:, :, :-2], ap[:, :, 1:-1], ap[:, :, 2:]], axis=3)

    kb, vb = band(k), band(v)
    jb = jnp.arange(nb)[:, None, None]
    qpos = jb * BLK + jnp.arange(BLK)[None, :, None]
    kpos = (jb - 1) * BLK + jnp.arange(3 * BLK)[None, None, :]
    mask = (jnp.abs(kpos - qpos) <= WINDOW) & (kpos >= 0) & (kpos < L)
    xs = (jnp.moveaxis(q.reshape(B, Hk, G, nb, BLK, d), 3, 0), jnp.moveaxis(kb, 2, 0),
          jnp.moveaxis(vb, 2, 0), mask)

    def one(args):
        qi, ki, vi, mk = args
        s_loc = jnp.einsum('bhgqd,bhkd->bhgqk', qi, ki).astype(jnp.float32) * scale
        s_loc = jnp.where(mk, s_loc, -jnp.inf)
        s_ctx = jnp.einsum('bhgqd,bhkd->bhgqk', qi, k_ctx).astype(jnp.float32) * scale
        p = _probs(jnp.concatenate([s_loc, s_ctx], axis=-1), sink)
        p_loc, p_ctx = p[..., :3 * BLK], p[..., 3 * BLK:]
        return (jnp.einsum('bhgqk,bhkd->bhgqd', p_loc.astype(vi.dtype), vi)
                + jnp.einsum('bhgqk,bhkd->bhgqd', p_ctx.astype(v_ctx.dtype), v_ctx))

    o = lax.map(one, xs)
    return jnp.moveaxis(o, 0, 3).reshape(B, Hk, G, L, d)


def _short_conv(u, w, b):
    L = u.shape[1]
    pad = SHORT_CONV // 2
    up = jnp.pad(u, ((0, 0), (pad, pad), (0, 0)))
    out = b
    for j in range(SHORT_CONV):
        out = out + up[:, j:j + L] * w[j]
    return out


def _hyena_filters(L, w1, b1, w2, b2, w3, freq):
    f32 = jnp.float32
    t = jnp.linspace(0.0, 1.0, L, dtype=f32)[:, None]
    bands = (POS_EMB - 1) // 2
    w = 2.0 * math.pi * jnp.arange(L, dtype=f32)[:, None] / L
    fb = jnp.linspace(1e-4, bands - 1, bands, dtype=f32)[None, :]
    z = jnp.concatenate([t, jnp.cos(fb * w), -jnp.sin(fb * w)], axis=-1)
    fr = freq.astype(f32)
    h = jnp.sin(fr * (z @ w1.astype(f32) + b1.astype(f32)))
    h = jnp.sin(fr * (h @ w2.astype(f32) + b2.astype(f32)))
    h = (h @ w3.astype(f32)).reshape(L, HY_ORDER, 2, HY_W)
    deltas = jnp.abs(jnp.linspace(math.log(HY_TARGET) / HY_SLOW_DECAY,
                                  math.log(HY_TARGET) / HY_FAST_DECAY, HY_W, dtype=f32))
    decay = jnp.exp(-t * deltas)
    return jnp.moveaxis(h * decay[:, None, None, :], 0, 2)


def _long_conv(z, hf, hb):
    L = z.shape[1]
    filt = jnp.concatenate([hf, jnp.zeros_like(hf[:1]), hb[:0:-1]], axis=0)
    Z = jnp.fft.rfft(z.astype(jnp.float32), n=2 * L, axis=1)
    K = jnp.fft.rfft(filt, n=2 * L, axis=0)
    return jnp.fft.irfft(Z * K[None], n=2 * L, axis=1)[:, :L]


def _hyena(u, conv_w, conv_b, f_w1, f_b1, f_w2, f_b2, f_w3, f_freq, h_bias):
    L = u.shape[1]
    uc = _short_conv(u, conv_w, conv_b).astype(jnp.float32)
    v, *gates = jnp.split(uc, HY_ORDER + 1, axis=-1)
    h = _hyena_filters(L, f_w1, f_b1, f_w2, f_b2, f_w3, f_freq)
    z = v
    for n in range(HY_ORDER):
        z = gates[n] * (_long_conv(z, h[n, 0], h[n, 1]) + h_bias[n].astype(jnp.float32) * z)
    return z


def _gla_chunk(q, k, v, logf, S0):
    B, H, L, dk = q.shape
    n = L // CHUNK

    def blocks(a):
        return a.reshape(B, H, n, CHUNK, a.shape[-1])

    q, k, v, logf = blocks(q), blocks(k), blocks(v), blocks(logf)
    b = jnp.cumsum(logf, axis=3)
    b_end = b[:, :, :, -1:]
    qd = q * jnp.exp(b)
    kd = k * jnp.exp(-b)
    kend = k * jnp.exp(b_end - b)
    causal = jnp.tril(jnp.ones((CHUNK, CHUNK), dtype=bool))
    A = jnp.where(causal, jnp.einsum('bhncd,bhnsd->bhncs', qd, kd), 0.0)
    o_intra = jnp.einsum('bhncs,bhnsv->bhncv', A, v)

    def step(S, xs):
        qc, kc, vc, dc = xs
        o = jnp.einsum('bhcd,bhdv->bhcv', qc, S)
        S = dc[..., None] * S + jnp.einsum('bhcd,bhcv->bhdv', kc, vc)
        return S, o

    xs = tuple(jnp.moveaxis(a, 2, 0) for a in (qd, kend, v, jnp.exp(b_end[:, :, :, 0])))
    S, o_inter = lax.scan(step, S0.astype(jnp.float32), xs)
    o = o_intra + jnp.moveaxis(o_inter, 0, 2)
    return o.reshape(B, H, L, -1), S


def _heads(a):
    B, L, _ = a.shape
    return a.reshape(B, L, HG_HEADS, -1).transpose(0, 2, 1, 3).astype(jnp.float32)


def _hgrn(q_h, f_f, f_b, i_h, g_h, lb, norm_g, S0):
    q = jax.nn.silu(_heads(q_h))
    v = _heads(i_h)
    o = 0.0
    states = []
    for d, fz in enumerate((f_f, f_b)):
        lbd = lb[d].reshape(HG_HEADS, 1, HG_DK)
        f = lbd + (1.0 - lbd) * jax.nn.sigmoid(_heads(fz))
        args = (q, 1.0 - f, v, jnp.log(f))
        if d == 1:
            args = tuple(a[:, :, ::-1] for a in args)
        od, Sd = _gla_chunk(*args, S0[:, d])
        o = o + (od[:, :, ::-1] if d == 1 else od)
        states.append(Sd)
    o = _rmsnorm(o, norm_g) * jax.nn.silu(_heads(g_h))
    B, H, L, dv = o.shape
    return o.transpose(0, 2, 1, 3).reshape(B, L, H * dv), jnp.stack(states, axis=1)


def _mla_q(q_lat, q_norm, w_qb):
    B, L, _ = q_lat.shape
    q = (_rmsnorm(q_lat, q_norm) @ w_qb).reshape(B, L, MLA_HEADS, NOPE + ROPE).transpose(0, 2, 1, 3)
    return q[..., :NOPE], q[..., NOPE:]


def _mla_kv(ckv, krope, w_kvb):
    B, L, _ = ckv.shape
    kv = (ckv @ w_kvb).reshape(B, L, MLA_HEADS, NOPE + V_DIM).transpose(0, 2, 1, 3)
    kr = jnp.broadcast_to(krope[:, None], (B, MLA_HEADS, L, ROPE)).astype(kv.dtype)
    return jnp.concatenate([kv[..., :NOPE], kr], axis=-1), kv[..., NOPE:]


def _merge(y_a, attn, w_out, dtype):
    B, Hk, G, L, dv = attn.shape
    a = attn.transpose(0, 3, 1, 2, 4).reshape(B, L, Hk * G * dv)
    return jnp.concatenate([y_a.astype(dtype), a.astype(dtype)], axis=-1) @ w_out


def _even_project(h, w_in):
    B, L, _ = h.shape
    p = h @ w_in
    n_hy = (HY_ORDER + 1) * HY_W
    n_q = ATT_HEADS * HEAD_DIM
    n_kv = ATT_KV_HEADS * HEAD_DIM
    u = p[..., :n_hy]
    q = p[..., n_hy:n_hy + n_q].reshape(B, L, ATT_KV_HEADS, ATT_GROUP, HEAD_DIM).transpose(0, 2, 3, 1, 4)
    k = p[..., n_hy + n_q:n_hy + n_q + n_kv].reshape(B, L, ATT_KV_HEADS, HEAD_DIM).transpose(0, 2, 1, 3)
    v = p[..., n_hy + n_q + n_kv:].reshape(B, L, ATT_KV_HEADS, HEAD_DIM).transpose(0, 2, 1, 3)
    return u, q, k, v


def _even_context(h, w_in, w_out, sink, hy_w):
    u, q, k, v = _even_project(h, w_in)
    a = _attend_dense(q, k, v, ATT_SCALE, sink)
    return _merge(_hyena(u, *hy_w), a, w_out, h.dtype), k, v


def _even_latent(h, k_ctx, v_ctx, w_in, w_out, sink, hy_w):
    u, q, k, v = _even_project(h, w_in)
    a = _attend_window_ctx(_rope2d(q), _rope2d(k), v, k_ctx, v_ctx, sink, ATT_SCALE)
    return _merge(_hyena(u, *hy_w), a, w_out, h.dtype)


def _odd_project(h, w_in):
    sizes = [HG_W] * 5 + [Q_LORA, KV_LORA, ROPE]
    idx = np.cumsum(sizes)[:-1].tolist()
    return jnp.split(h @ w_in, idx, axis=-1)


def _odd_context(h, lb, w_in, w_out, hg_g, qn, wqb, kvn, wkvb):
    q_h, f_f, f_b, i_h, g_h, q_lat, kv_lat, k_rope = _odd_project(h, w_in)
    S0 = jnp.zeros((h.shape[0], 2, HG_HEADS, HG_DK, HG_DV), jnp.float32)
    o_hg, S = _hgrn(q_h, f_f, f_b, i_h, g_h, lb, hg_g, S0)
    q_nope, q_rope = _mla_q(q_lat, qn, wqb)
    ckv = _rmsnorm(kv_lat, kvn)
    k, v = _mla_kv(ckv, k_rope, wkvb)
    q = jnp.concatenate([q_nope, q_rope], axis=-1)[:, :, None]
    a = _attend_dense(q, k, v, MLA_SCALE)
    return _merge(o_hg, a, w_out, h.dtype), S, ckv, k_rope


def _odd_latent(h, S_ctx, ckv_ctx, kr_ctx, lb, w_in, w_out, hg_g, qn, wqb, kvn, wkvb):
    q_h, f_f, f_b, i_h, g_h, q_lat, kv_lat, k_rope = _odd_project(h, w_in)
    o_hg, _ = _hgrn(q_h, f_f, f_b, i_h, g_h, lb, hg_g, S_ctx)
    q_nope, q_rope = _mla_q(q_lat, qn, wqb)
    q = jnp.concatenate([q_nope, _rope2d(q_rope)], axis=-1)[:, :, None]
    k_l, v_l = _mla_kv(_rmsnorm(kv_lat, kvn), _rope2d(k_rope), wkvb)
    k_c, v_c = _mla_kv(ckv_ctx, kr_ctx, wkvb)
    a = _attend_dense(q, jnp.concatenate([k_l, k_c.astype(k_l.dtype)], axis=2),
                      jnp.concatenate([v_l, v_c.astype(v_l.dtype)], axis=2), MLA_SCALE)
    return _merge(o_hg, a, w_out, h.dtype)


def setup_inputs(seed: int = 0) -> dict:
    key = jax.random.key(seed)
    ks = iter(jax.random.split(key, 64))
    D = D_MODEL

    def nrm(shape, s):
        return jax.random.normal(next(ks), shape, jnp.float32) * s

    def gain(shape):
        return 1.0 + nrm(shape, 0.05)

    return {
        'x_prompt': nrm((BATCH, SEQ, D), 1.0),
        'x_sample': nrm((DEC_BATCH, DEC_SEQ, D), 1.0),
        'c': nrm((DEC_BATCH, D), 1.0),
        'c_ctx': nrm((D,), 1.0),
        'cache_attn_k': nrm((DEC_BATCH, N_EVEN, ATT_KV_HEADS, PAST_LEN, HEAD_DIM), 1.0),
        'cache_attn_v': nrm((DEC_BATCH, N_EVEN, ATT_KV_HEADS, PAST_LEN, HEAD_DIM), 1.0),
        'cache_mla_ckv': nrm((DEC_BATCH, N_ODD, PAST_LEN, KV_LORA), 1.0),
        'cache_mla_krope': nrm((DEC_BATCH, N_ODD, PAST_LEN, ROPE), 1.0),
        'state_hgrn': nrm((DEC_BATCH, N_ODD, 2, HG_HEADS, HG_DK, HG_DV), 0.5),
        'mod_w': nrm((DEPTH, D, N_MOD * D), 0.5 * D ** -0.5),
        'mod_b': nrm((DEPTH, N_MOD * D), 0.02),
        'norm_g': gain((DEPTH, 6, D)),
        'ffn_wg': nrm((DEPTH, 2, D, D_FF), D ** -0.5),
        'ffn_wu': nrm((DEPTH, 2, D, D_FF), D ** -0.5),
        'ffn_wd': nrm((DEPTH, 2, D_FF, D), D_FF ** -0.5),
        'ev_w_in': nrm((N_EVEN, D, EV_IN), D ** -0.5),
        'ev_w_out': nrm((N_EVEN, MIX_W, D), MIX_W ** -0.5),
        'hy_conv_w': nrm((N_EVEN, SHORT_CONV, (HY_ORDER + 1) * HY_W), SHORT_CONV ** -0.5),
        'hy_conv_b': nrm((N_EVEN, (HY_ORDER + 1) * HY_W), 0.02),
        'hy_f_w1': nrm((N_EVEN, POS_EMB, FILTER_ORDER), POS_EMB ** -0.5),
        'hy_f_b1': nrm((N_EVEN, FILTER_ORDER), 0.1),
        'hy_f_w2': nrm((N_EVEN, FILTER_ORDER, FILTER_ORDER), FILTER_ORDER ** -0.5),
        'hy_f_b2': nrm((N_EVEN, FILTER_ORDER), 0.1),
        'hy_f_w3': nrm((N_EVEN, FILTER_ORDER, HY_ORDER * 2 * HY_W), 0.1 * FILTER_ORDER ** -0.5),
        'hy_f_freq': 1.0 + nrm((N_EVEN, FILTER_ORDER), 0.1),
        'hy_bias': nrm((N_EVEN, HY_ORDER, HY_W), 0.5),
        'attn_sink': nrm((N_EVEN, ATT_HEADS), 0.5),
        'od_w_in': nrm((N_ODD, D, OD_IN), D ** -0.5),
        'od_w_out': nrm((N_ODD, MIX_W, D), MIX_W ** -0.5),
        'hg_lb': nrm((DEPTH, 2, HG_W), 0.1),
        'hg_norm': gain((N_ODD, HG_DV)),
        'mla_q_norm': gain((N_ODD, Q_LORA)),
        'mla_w_qb': nrm((N_ODD, Q_LORA, MLA_HEADS * (NOPE + ROPE)), Q_LORA ** -0.5),
        'mla_kv_norm': gain((N_ODD, KV_LORA)),
        'mla_w_kvb': nrm((N_ODD, KV_LORA, MLA_HEADS * (NOPE + V_DIM)), KV_LORA ** -0.5),
    }


def reference(x_prompt, x_sample, c, c_ctx, cache_attn_k, cache_attn_v, cache_mla_ckv, cache_mla_krope,
              state_hgrn, mod_w, mod_b, norm_g, ffn_wg, ffn_wu, ffn_wd, ev_w_in, ev_w_out, hy_conv_w,
              hy_conv_b, hy_f_w1, hy_f_b1, hy_f_w2, hy_f_b2, hy_f_w3, hy_f_freq, hy_bias, attn_sink,
              od_w_in, od_w_out, hg_lb, hg_norm, mla_q_norm, mla_w_qb, mla_kv_norm, mla_w_kvb):
    lb_all = jnp.cumsum(jax.nn.softmax(hg_lb.astype(jnp.float32), axis=0), axis=0)
    lb_all = lb_all - lb_all[:1]
    xp, xs = x_prompt, x_sample
    new_k, new_v, new_ckv, new_kr, new_s = [], [], [], [], []
    for l in range(DEPTH):
        mp = _modulation(c_ctx[None, :], mod_w[l], mod_b[l])
        ms = _modulation(c, mod_w[l], mod_b[l])
        xp = _ffn_sublayer(xp, mp, 0, norm_g[l, 0], norm_g[l, 1], ffn_wg[l, 0], ffn_wu[l, 0], ffn_wd[l, 0])
        xs = _ffn_sublayer(xs, ms, 0, norm_g[l, 0], norm_g[l, 1], ffn_wg[l, 0], ffn_wu[l, 0], ffn_wd[l, 0])
        hp = _modulate(xp, norm_g[l, 2], mp, 1)
        hs = _modulate(xs, norm_g[l, 2], ms, 1)
        if l % 2 == 0:
            e = l // 2
            hy_w = (hy_conv_w[e], hy_conv_b[e], hy_f_w1[e], hy_f_b1[e], hy_f_w2[e], hy_f_b2[e],
                    hy_f_w3[e], hy_f_freq[e], hy_bias[e])
            sink = attn_sink[e].reshape(ATT_KV_HEADS, ATT_GROUP)
            op, kc, vc = _even_context(hp, ev_w_in[e], ev_w_out[e], sink, hy_w)
            osm = _even_latent(hs, cache_attn_k[:, e], cache_attn_v[:, e], ev_w_in[e], ev_w_out[e], sink, hy_w)
            new_k.append(kc)
            new_v.append(vc)
        else:
            o = l // 2
            ow = (od_w_in[o], od_w_out[o], hg_norm[o], mla_q_norm[o], mla_w_qb[o], mla_kv_norm[o], mla_w_kvb[o])
            op, sc, ckv, kr = _odd_context(hp, lb_all[l], *ow)
            osm = _odd_latent(hs, state_hgrn[:, o], cache_mla_ckv[:, o], cache_mla_krope[:, o], lb_all[l], *ow)
            new_s.append(sc)
            new_ckv.append(ckv)
            new_kr.append(kr)
        xp = _residual(xp, op, norm_g[l, 3], mp, 1, 1.0)
        xs = _residual(xs, osm, norm_g[l, 3], ms, 1, 1.0)
        xp = _ffn_sublayer(xp, mp, 2, norm_g[l, 4], norm_g[l, 5], ffn_wg[l, 1], ffn_wu[l, 1], ffn_wd[l, 1])
        xs = _ffn_sublayer(xs, ms, 2, norm_g[l, 4], norm_g[l, 5], ffn_wg[l, 1], ffn_wu[l, 1], ffn_wd[l, 1])
    return (xp, xs, jnp.stack(new_k, axis=1), jnp.stack(new_v, axis=1), jnp.stack(new_ckv, axis=1),
            jnp.stack(new_kr, axis=1), jnp.stack(new_s, axis=1))
```

```cpp
#ifdef EMU
#include "emu.h"
#define LAS
#define GAS
#else
#include <hip/hip_runtime.h>
#define LAS __attribute__((address_space(3)))
#define GAS __attribute__((address_space(1)))
#endif
#include <cstdio>
#include <cstdint>
#include <cmath>

#ifndef CFG_BATCH
#define CFG_BATCH 16
#define CFG_SEQ 256
#define CFG_DEC_BATCH 8
#define CFG_DEC_SEQ 1024
#define CFG_PAST 512
#define CFG_DFF 5632
#endif
#define DEV __device__ __forceinline__

typedef unsigned short bf16;
typedef float f32x4 __attribute__((ext_vector_type(4)));
typedef float f32x2 __attribute__((ext_vector_type(2)));
typedef short bf16x8 __attribute__((ext_vector_type(8)));
typedef short bf16x4 __attribute__((ext_vector_type(4)));
typedef unsigned u32x4 __attribute__((ext_vector_type(4)));
typedef unsigned u32x2 __attribute__((ext_vector_type(2)));
typedef _Float16 f16x4 __attribute__((ext_vector_type(4)));

constexpr int D = 2048, NB_P = CFG_BATCH, L_P = CFG_SEQ, NB_S = CFG_DEC_BATCH, L_S = CFG_DEC_SEQ, PAST = CFG_PAST, DFF = CFG_DFF;
constexpr int TP = NB_P * L_P, TS = NB_S * L_S, T = TP + TS, CTX = NB_S * PAST, TK = T + CTX;
constexpr int EV_IN = 4608, OD_IN = 5952, OD_INP = 6144, NQKV = 1536;
constexpr int NMOD = 9, NGRP = 1 + NB_S, MODW = NMOD * D;
constexpr int GV_KS = 16, GV_KC = D / GV_KS;
constexpr int NWAVES = 8, NTHR = 512;
static_assert(T % 256 == 0 && TK % 256 == 0 && TP % 256 == 0 && DFF % 256 == 0 && (DFF / 2) % 128 == 0, "tile multiples");
static_assert(L_P % 128 == 0 && L_S % 128 == 0 && PAST % 32 == 0 && L_P % 8 == 0, "sequence multiples");

constexpr size_t MiB = 1u << 20;
constexpr size_t al(size_t x) { return (x + MiB - 1) / MiB * MiB; }
constexpr size_t WS_CTL = 0, CTL_BYTES = 1 * MiB;
constexpr size_t WS_WGU = WS_CTL + CTL_BYTES;
constexpr size_t SZ_WGU1 = (size_t)2 * DFF * D * 2;
constexpr size_t WS_WD = WS_WGU + al(4 * SZ_WGU1);
constexpr size_t SZ_WD1 = (size_t)D * DFF * 2;
constexpr size_t WS_WEVIN = WS_WD + al(4 * SZ_WD1);
constexpr size_t WS_WEVOUT = WS_WEVIN + al((size_t)EV_IN * D * 2);
constexpr size_t WS_WODIN = WS_WEVOUT + al((size_t)D * D * 2);
constexpr size_t WS_WODOUT = WS_WODIN + al((size_t)OD_INP * D * 2);
constexpr size_t WS_WQB = WS_WODOUT + al((size_t)D * D * 2);
constexpr size_t WS_WKVK = WS_WQB + al((size_t)1536 * 512 * 2);
constexpr size_t WS_WKVV = WS_WKVK + al((size_t)1024 * 256 * 2);
constexpr size_t WS_X = WS_WKVV + al((size_t)1024 * 256 * 2);
constexpr size_t WS_HN = WS_X + al((size_t)T * D * 4);
constexpr size_t WS_HFF = WS_HN + al((size_t)T * D * 2);
constexpr size_t SZ_HFF = al((size_t)T * DFF * 2) > al((size_t)2 * T * 1024 * 4) ? al((size_t)T * DFF * 2) : al((size_t)2 * T * 1024 * 4);
constexpr size_t WS_OUT = WS_HFF + SZ_HFF;
constexpr size_t SZ_OUT1 = (size_t)T * D * 4;
constexpr size_t WS_QN = WS_OUT;
constexpr size_t WS_CKV = WS_QN + al((size_t)T * 512 * 2);
constexpr size_t WS_KR = WS_CKV + al((size_t)TK * 256 * 2);
constexpr size_t WS_QM = WS_KR + al((size_t)TK * 64 * 2);
constexpr size_t WS_KN = WS_QM + al((size_t)T * 1536 * 2);
constexpr size_t WS_VTM = WS_KN + al((size_t)TK * 1024 * 2);
constexpr size_t MLA_END = WS_VTM + al((size_t)1024 * TK * 2);
constexpr size_t SZ_OUT = (al(2 * SZ_OUT1) > (MLA_END - WS_OUT)) ? al(2 * SZ_OUT1) : (MLA_END - WS_OUT);
constexpr size_t WS_P = WS_OUT + SZ_OUT;
constexpr size_t WS_UT = WS_P;
constexpr size_t WS_QKV = WS_UT + al((size_t)3072 * T * 2);
constexpr size_t WS_VTE = WS_QKV + al((size_t)T * NQKV * 2);
constexpr size_t WS_YT = WS_VTE + al((size_t)256 * T * 2);
constexpr size_t EV_END = WS_YT + al((size_t)1024 * T * 2);
constexpr size_t SZ_P = (al((size_t)T * OD_INP * 2) > (EV_END - WS_P)) ? al((size_t)T * OD_INP * 2) : (EV_END - WS_P);
constexpr size_t WS_MIX = WS_P + SZ_P;
constexpr size_t WS_FILT = WS_MIX + al((size_t)T * D * 2);
constexpr size_t WS_H2 = WS_FILT + al((size_t)4 * (L_P + L_S) * 1024 * 2);
constexpr size_t WS_MODP = WS_H2 + al((size_t)(L_P + L_S) * 64 * 4);
constexpr size_t WS_MODS = WS_MODP + al((size_t)GV_KS * 2 * NGRP * MODW * 4);
constexpr size_t WS_KC = WS_MODS + al((size_t)2 * NGRP * MODW * 4);
constexpr size_t WS_VTC = WS_KC + al((size_t)NB_S * 2 * PAST * 128 * 2);
constexpr size_t WS_END = WS_VTC + al((size_t)NB_S * 2 * PAST * 128 * 2);
#if CFG_BATCH == 16 && CFG_DFF == 5632
static_assert(WS_END <= (size_t)1152 * MiB, "d_ws map exceeds the guaranteed workspace");
#endif

constexpr size_t OUT_Y = 0;
constexpr size_t OUT_K = (size_t)T * D;
constexpr size_t OUT_V = OUT_K + (size_t)NB_P * 2 * L_P * 128;
constexpr size_t OUT_CKV = OUT_V + (size_t)NB_P * 2 * L_P * 128;
constexpr size_t OUT_KR = OUT_CKV + (size_t)NB_P * L_P * 256;
constexpr size_t OUT_ST = OUT_KR + (size_t)NB_P * L_P * 64;
constexpr size_t OUT_END = OUT_ST + (size_t)NB_P * 2 * 8 * 128 * 128;

constexpr int RING_BYTES = 131072, MISC_OFF = RING_BYTES + 320, LDS_BYTES = 147456;

#ifdef EMU
#define SCHED_FENCE() do { } while (0)
#else
#define SCHED_FENCE() __builtin_amdgcn_sched_barrier(0)
#endif
#ifdef EMU
DEV void lds_barrier() { __syncthreads(); }
#else
DEV void lds_barrier() { asm volatile("s_waitcnt lgkmcnt(0)" ::: "memory"); __builtin_amdgcn_s_barrier(); asm volatile("" ::: "memory"); }
#endif
#ifdef EMU
DEV int tid_l() { return (int)threadIdx.x; }
#else
DEV int tid_l() { int t = (int)threadIdx.x; asm volatile("" : "+v"(t)); return t; }
#endif
DEV float bf2f(bf16 v) { return __uint_as_float((unsigned)v << 16); }
DEV unsigned f2bf(float f) { unsigned u = __float_as_uint(f); return (u + 0x7fffu + ((u >> 16) & 1u)) >> 16; }
#ifdef EMU
DEV unsigned pk2(float lo, float hi) { return f2bf(lo) | (f2bf(hi) << 16); }
DEV float fast_exp2(float x) { return exp2f(x); }
#else
DEV unsigned pk2(float lo, float hi) { unsigned r; asm("v_cvt_pk_bf16_f32 %0, %1, %2" : "=v"(r) : "v"(lo), "v"(hi)); return r; }
DEV float fast_exp2(float x) { return __builtin_amdgcn_exp2f(x); }
#endif
#ifdef EMU
DEV float xrow16_max(float x) { x = fmaxf(x, __shfl_xor(x, 16)); return fmaxf(x, __shfl_xor(x, 32)); }
DEV float xrow16_sum(float x) { x += __shfl_xor(x, 16); return x + __shfl_xor(x, 32); }
#else
DEV float xrow16_max(float x) {
    auto s = __builtin_amdgcn_permlane16_swap(__float_as_uint(x), __float_as_uint(x), false, false);
    x = fmaxf(__uint_as_float(s[0]), __uint_as_float(s[1]));
    auto t = __builtin_amdgcn_permlane32_swap(__float_as_uint(x), __float_as_uint(x), false, false);
    return fmaxf(__uint_as_float(t[0]), __uint_as_float(t[1]));
}
DEV float xrow16_sum(float x) {
    auto s = __builtin_amdgcn_permlane16_swap(__float_as_uint(x), __float_as_uint(x), false, false);
    x = __uint_as_float(s[0]) + __uint_as_float(s[1]);
    auto t = __builtin_amdgcn_permlane32_swap(__float_as_uint(x), __float_as_uint(x), false, false);
    return __uint_as_float(t[0]) + __uint_as_float(t[1]);
}
#endif
DEV float wave_sum(float v) {
#pragma unroll
    for (int o = 1; o < 64; o <<= 1) v += __shfl_xor(v, o);
    return v;
}
#ifdef EMU
DEV float fast_rcp(float x) { return 1.0f / x; }
#else
DEV float fast_rcp(float x) { return __builtin_amdgcn_rcpf(x); }
#endif
#ifdef EMU
DEV float fast_sin(float x) { return sinf(x); }
DEV float fast_cos(float x) { return cosf(x); }
#else
DEV float fast_sin(float x) { return __sinf(x); }
DEV float fast_cos(float x) { return __cosf(x); }
#endif
DEV float silu_f(float x) { return x * fast_rcp(1.0f + __expf(-x)); }
DEV float sigmoid_f(float x) { return fast_rcp(1.0f + __expf(-x)); }
DEV int grp_of_row(int row) { return row < TP ? 0 : 1 + (row - TP) / L_S; }
DEV bf16x8 ld_bf16x8(const bf16* p) { return *(const bf16x8*)p; }
DEV bf16x8 lds_bf16x8(const LAS unsigned char* p) { return *(const LAS bf16x8*)p; }
DEV f32x4 mfma16(bf16x8 a, bf16x8 b, f32x4 c) { return __builtin_amdgcn_mfma_f32_16x16x32_bf16(a, b, c, 0, 0, 0); }

namespace pg8 {
constexpr int BM = 256, BK = 64, HALF = 128, HTB = HALF * BK * 2, STAGE_BYTES = 8 * HTB, NXCD = 8, WGM = 4;
__host__ __device__ __forceinline__ int lds_byte(int r, int c) { const int st = (r >> 4) * 2 + (c >> 5), rr = r & 15, cc = c & 31, ob = rr * 64 + cc * 2; return st * 1024 + (ob ^ (((ob >> 9) & 1) << 5)); }
__host__ __device__ __forceinline__ void stage_rc(int b, int& R, int& C) { const int st = b / 1024, sb = b % 1024, swz = sb ^ (((sb >> 9) & 1) << 5); R = (st >> 1) * 16 + swz / 64; C = (st & 1) * 32 + (swz % 64) / 2; }
__host__ __device__ __forceinline__ int perm32(int rho) { const int n = rho >> 4, i = rho & 15; return 8 * (i >> 2) + 4 * n + (i & 3); }

struct Unit { int pm, pn, sub; };
struct Gemm { int K, lda, ldb; };
struct SubG { const bf16* A; const bf16* Bt; int nM, nN; };

struct MultiOrder {
    const char* A0; const char* B0; long dA1, dB1, dA2, dB2; int nM0, nN0, dM1, dN1, dM2, dN2, n0, n1, n2, G, c, lda, ldb;
    DEV void init(const SubG& g0, const SubG& g1, const SubG& g2, int ns, int G_, int c_, int lda_, int ldb_) {
        A0 = (const char*)g0.A; B0 = (const char*)g0.Bt; dA1 = (const char*)g1.A - A0; dB1 = (const char*)g1.Bt - B0; dA2 = (const char*)g2.A - A0; dB2 = (const char*)g2.Bt - B0;
        nM0 = g0.nM; nN0 = g0.nN; dM1 = g1.nM - g0.nM; dN1 = g1.nN - g0.nN; dM2 = g2.nM - g0.nM; dN2 = g2.nN - g0.nN;
        n0 = g0.nM * g0.nN; n1 = ns > 1 ? g1.nM * g1.nN : 0; n2 = ns > 2 ? g2.nM * g2.nN : 0; G = G_; c = c_; lda = lda_; ldb = ldb_;
    }
    DEV bool next(int i, Unit& u) const {
        const long L = (long)i * G + c;
        if (L >= (long)n0 + n1 + n2) return false;
        int l = (int)L; const int sub = (l >= n0 ? 1 : 0) + (l >= n0 + n1 ? 1 : 0);
        l -= (sub >= 1 ? n0 : 0) + (sub >= 2 ? n1 : 0);
        const int nM = nM0 + (sub == 1 ? dM1 : 0) + (sub == 2 ? dM2 : 0), nN = nN0 + (sub == 1 ? dN1 : 0) + (sub == 2 ? dN2 : 0);
        const int nwg = nM * nN; int wgid = l; { const int q = nwg / NXCD, r = nwg % NXCD, xcd = wgid % NXCD, off = wgid / NXCD; wgid = (xcd < r ? xcd * (q + 1) : r * (q + 1) + (xcd - r) * q) + off; }
        const int nig = WGM * nN, gid = wgid / nig, fm = gid * WGM, gsz = (nM - fm) < WGM ? (nM - fm) : WGM;
        u.pm = fm + ((wgid % nig) % gsz); u.pn = (wgid % nig) / gsz; u.sub = sub; return true;
    }
    DEV const char* pa(const Unit& u) const { return A0 + ((u.sub == 1 ? dA1 : 0) + (u.sub == 2 ? dA2 : 0)) + (size_t)u.pm * BM * lda * 2; }
    DEV const char* pb(const Unit& u) const { return B0 + ((u.sub == 1 ? dB1 : 0) + (u.sub == 2 ? dB2 : 0)) + (size_t)u.pn * BM * ldb * 2; }
    DEV void a_ready(const Unit&) const {}
    DEV void done(const Unit&) const {}
};

struct EpiBf16M {
    static constexpr bool PERM = true, AFTER_DRAIN = false;
    bf16* O0; long dO1, dO2; int ldc0, dl1, dl2;
    DEV static EpiBf16M make(bf16* o0, bf16* o1, bf16* o2, int l0, int l1, int l2) { EpiBf16M e; e.O0 = o0; e.dO1 = o1 ? o1 - o0 : 0; e.dO2 = o2 ? o2 - o0 : 0; e.ldc0 = l0; e.dl1 = l1 - l0; e.dl2 = l2 - l0; return e; }
    DEV void operator()(const f32x4 (&acc)[2][2][4][2], const Unit& u, int wr, int wc, int fr, int fq) const {
        bf16* base = O0 + ((u.sub == 1 ? dO1 : 0) + (u.sub == 2 ? dO2 : 0)); const int ldc = ldc0 + (u.sub == 1 ? dl1 : 0) + (u.sub == 2 ? dl2 : 0);
        const int row0 = u.pm * BM + wr * 64 + fr, col0 = u.pn * BM + wc * 32 + 8 * fq;
#pragma unroll
        for (int ai = 0; ai < 2; ++ai)
#pragma unroll
            for (int m = 0; m < 4; ++m) { bf16* rowp = base + (size_t)(row0 + ai * HALF + m * 16) * ldc + col0;
#pragma unroll
                for (int bj = 0; bj < 2; ++bj) { const f32x4 v0 = acc[ai][bj][m][0], v1 = acc[ai][bj][m][1];
                    u32x4 w; w.x = pk2(v0[0], v0[1]); w.y = pk2(v0[2], v0[3]); w.z = pk2(v1[0], v1[1]); w.w = pk2(v1[2], v1[3]);
                    *(u32x4*)(rowp + bj * HALF) = w; } }
    }
};
struct EpiSwiGLU {
    static constexpr bool PERM = true, AFTER_DRAIN = false;
    bf16* O; int ldc;
    DEV void operator()(const f32x4 (&acc)[2][2][4][2], const Unit& u, int wr, int wc, int fr, int fq) const {
        const int row0 = u.pm * BM + wr * 64 + fr, col0 = u.pn * HALF + wc * 32 + 8 * fq;
#pragma unroll
        for (int ai = 0; ai < 2; ++ai)
#pragma unroll
            for (int m = 0; m < 4; ++m) { bf16* rowp = O + (size_t)(row0 + ai * HALF + m * 16) * ldc + col0;
                float h[8];
#pragma unroll
                for (int n = 0; n < 2; ++n)
#pragma unroll
                    for (int i = 0; i < 4; ++i) { const float ag = acc[ai][0][m][n][i], au = acc[ai][1][m][n][i]; h[4 * n + i] = (ag * au) * fast_rcp(1.0f + fast_exp2(ag)); }
                u32x4 w; w.x = pk2(h[0], h[1]); w.y = pk2(h[2], h[3]); w.z = pk2(h[4], h[5]); w.w = pk2(h[6], h[7]);
                *(u32x4*)rowp = w; }
    }
};
struct EpiF32S {
    static constexpr bool PERM = false, AFTER_DRAIN = false;
    float* O0; long dO1; int ldc;
    DEV void operator()(const f32x4 (&acc)[2][2][4][2], const Unit& u, int wr, int wc, int fr, int fq) const {
        float* base = O0 + (u.sub == 1 ? dO1 : 0);
        const int row0 = u.pm * BM + wr * 64 + fr, col0 = u.pn * BM + wc * 32 + 4 * fq;
#pragma unroll
        for (int ai = 0; ai < 2; ++ai)
#pragma unroll
            for (int m = 0; m < 4; ++m) { float* rowp = base + (size_t)(row0 + ai * HALF + m * 16) * ldc + col0;
#pragma unroll
                for (int bj = 0; bj < 2; ++bj)
#pragma unroll
                    for (int n = 0; n < 2; ++n) *(f32x4*)(rowp + bj * HALF + 16 * n) = acc[ai][bj][m][n]; }
    }
};

#ifdef EMU
template <class Epi, class Sched, bool ALIGN_EPI = false, bool SP2 = false>
inline void gemm_phase(unsigned char* lds, const Gemm g, const Sched& S, const Epi& E) {
    static thread_local std::vector<float> tile(256 * 256);
    const int tid = tid_l(), wid = tid >> 6, lane = tid & 63, wr = wid >> 2, wc = wid & 3, fr = lane & 15, fq = lane >> 4;
    Unit cur;
    for (int ui = 0; S.next(ui, cur); ++ui) {
        __syncthreads();
        if (tid == 0) {
            const bf16* A = (const bf16*)S.pa(cur); const bf16* B = (const bf16*)S.pb(cur);
            std::vector<float> af((size_t)256 * g.K), bfv((size_t)256 * g.K);
            for (int r = 0; r < 256; ++r) for (int k = 0; k < g.K; ++k) { af[(size_t)r * g.K + k] = bf2f(A[(size_t)r * g.lda + k]); bfv[(size_t)r * g.K + k] = bf2f(B[(size_t)r * g.ldb + k]); }
            for (int r = 0; r < 256; ++r) for (int c = 0; c < 256; ++c) { const float* a = &af[(size_t)r * g.K]; const float* b = &bfv[(size_t)c * g.K]; float s = 0.f; for (int k = 0; k < g.K; ++k) s += a[k] * b[k]; tile[r * 256 + c] = s; }
        }
        __syncthreads();
        f32x4 acc[2][2][4][2];
        for (int ai = 0; ai < 2; ++ai) for (int bj = 0; bj < 2; ++bj) for (int m = 0; m < 4; ++m) for (int n = 0; n < 2; ++n) for (int i = 0; i < 4; ++i) {
            const int r = 128 * ai + 64 * wr + 16 * m + fr; const int c = 128 * bj + 32 * wc + (Epi::PERM ? (8 * fq + 4 * n + i) : (16 * n + 4 * fq + i));
            acc[ai][bj][m][n][i] = tile[r * 256 + c]; }
        E(acc, cur, wr, wc, fr, fq);
    }
    __syncthreads();
}
#else
template <class Epi, class Sched, bool ALIGN_EPI = false, bool SP2 = false>
__device__ __forceinline__ void gemm_phase(LAS unsigned char* lds, const Gemm g, const Sched& S, const Epi& E) {
    const int tid = tid_l(), wid = __builtin_amdgcn_readfirstlane(tid >> 6), lane = tid & 63, wr = wid >> 2, wc = wid & 3, fr = lane & 15, fq = lane >> 4;
    const int K = g.K, nt = K / BK;
    unsigned voffA[2], voffB[2];
#pragma unroll
    for (int i = 0; i < 2; ++i) { int R, C; stage_rc(tid * 16 + i * 8192, R, C); const int Rb = Epi::PERM ? ((R & ~31) + perm32(R & 31)) : R;
        voffA[i] = (unsigned)(R * g.lda + C) * 2u; voffB[i] = (unsigned)(Rb * g.ldb + C) * 2u; }
    const size_t kstep = (size_t)(BK * 2);
    const size_t hstepA = (size_t)HALF * g.lda * 2, hstepB = (size_t)HALF * g.ldb * 2;
    const unsigned ldsw = (unsigned)wid * 1024u;
    const int aoff = lds_byte(wr * 64 + fr, fq * 8), boff = lds_byte(wc * 32 + fr, fq * 8);
#define PG8_SA(b, h) (((b) * 2 + (h)) * HTB)
#define PG8_SB(b, h) ((4 + (b) * 2 + (h)) * HTB)
#define PG8_STAGE(bufoff, gbase, voff) do { _Pragma("unroll") for (int _i = 0; _i < 2; ++_i) \
        __builtin_amdgcn_global_load_lds((const unsigned*)((const char*)(gbase) + (voff)[_i]), (LAS unsigned*)(lds + (bufoff) + ldsw + _i * 8192), 16, 0, 0); } while (0)
#define PG8_LDA(dst, b, h) do { _Pragma("unroll") for (int m = 0; m < 4; ++m) _Pragma("unroll") for (int k = 0; k < 2; ++k) dst[m][k] = *(const LAS bf16x8*)(lds + PG8_SA(b, h) + aoff + m * 2048 + k * 1024); } while (0)
#define PG8_LDB(dst, b, h) do { _Pragma("unroll") for (int n = 0; n < 2; ++n) _Pragma("unroll") for (int k = 0; k < 2; ++k) dst[n][k] = *(const LAS bf16x8*)(lds + PG8_SB(b, h) + boff + n * 2048 + k * 1024); } while (0)
#define PG8_MMA(ai, bj, At, Bt) do { __builtin_amdgcn_s_setprio(1); _Pragma("unroll") for (int m = 0; m < 4; ++m) _Pragma("unroll") for (int n = 0; n < 2; ++n) _Pragma("unroll") for (int k = 0; k < 2; ++k) \
        acc[ai][bj][m][n] = __builtin_amdgcn_mfma_f32_16x16x32_bf16(Bt[n][k], At[m][k], acc[ai][bj][m][n], 0, 0, 0); __builtin_amdgcn_s_setprio(0); } while (0)
#define PG8_WAIT_V(n) asm volatile("s_waitcnt vmcnt(" #n ")" ::: "memory")
#define PG8_WAIT_L(n) asm volatile("s_waitcnt lgkmcnt(" #n ")" ::: "memory")
#define PG8_BAR __builtin_amdgcn_s_barrier()
#define PG8_SCHED __builtin_amdgcn_sched_barrier(0)
    Unit cur, nxt; int ui = 0;
    if (!S.next(0, cur)) return;
    f32x4 acc[2][2][4][2];
#pragma unroll
    for (int a = 0; a < 2; ++a)
#pragma unroll
        for (int b = 0; b < 2; ++b)
#pragma unroll
            for (int m = 0; m < 4; ++m)
#pragma unroll
                for (int n = 0; n < 2; ++n) acc[a][b][m][n] = (f32x4){0.f, 0.f, 0.f, 0.f};
    bf16x8 At[4][2], B0[2][2], B1[2][2];
    const char* cA = S.pa(cur); const char* cB = S.pb(cur);
    S.a_ready(cur);
    if constexpr (SP2) {
        PG8_STAGE(PG8_SB(0, 0), cB, voffB); PG8_STAGE(PG8_SB(0, 1), cB + hstepB, voffB); PG8_STAGE(PG8_SA(0, 0), cA, voffA); PG8_STAGE(PG8_SA(0, 1), cA + hstepA, voffA);
        if (wr == 1) PG8_BAR;
        PG8_WAIT_V(2); PG8_BAR;
        PG8_STAGE(PG8_SB(1, 0), cB + kstep, voffB); PG8_STAGE(PG8_SA(1, 0), cA + kstep, voffA); PG8_STAGE(PG8_SB(1, 1), cB + hstepB + kstep, voffB);
        PG8_WAIT_V(6); PG8_BAR;
    } else {
        PG8_STAGE(PG8_SB(0, 0), cB, voffB); PG8_STAGE(PG8_SA(0, 0), cA, voffA); PG8_STAGE(PG8_SB(0, 1), cB + hstepB, voffB); PG8_STAGE(PG8_SA(0, 1), cA + hstepA, voffA);
        if (wr == 1) PG8_BAR;
        PG8_WAIT_V(4); PG8_BAR;
        PG8_STAGE(PG8_SB(1, 0), cB + kstep, voffB); PG8_STAGE(PG8_SA(1, 0), cA + kstep, voffA); PG8_STAGE(PG8_SB(1, 1), cB + hstepB + kstep, voffB);
        PG8_WAIT_V(6); PG8_BAR;
    }
    for (;;) {
        const bool has_next = S.next(ui + 1, nxt);
        const char* nA = has_next ? S.pa(nxt) : cA; const char* nB = has_next ? S.pb(nxt) : cB;
        for (int t = 0; t < nt; t += 2) {
            const bool last = (t == nt - 2);
            const char* a1 = cA + (size_t)(t + 1) * kstep;
            const char* a2 = last ? nA : cA + (size_t)(t + 2) * kstep; const char* b2 = last ? nB : cB + (size_t)(t + 2) * kstep;
            const char* a3 = a2 + kstep; const char* b3 = b2 + kstep;
            if (last && has_next) S.a_ready(nxt);
            if constexpr (SP2) {
            PG8_LDB(B0, 0, 0); PG8_LDB(B1, 0, 1); PG8_SCHED; PG8_LDA(At, 0, 0); PG8_STAGE(PG8_SA(1, 1), a1 + hstepA, voffA);
            PG8_WAIT_V(8); PG8_WAIT_L(0); PG8_BAR; PG8_MMA(0, 0, At, B0); PG8_MMA(0, 1, At, B1); PG8_BAR; PG8_SCHED;
            PG8_LDA(At, 0, 1); PG8_STAGE(PG8_SB(0, 0), b2, voffB); PG8_STAGE(PG8_SB(0, 1), b2 + hstepB, voffB); PG8_STAGE(PG8_SA(0, 0), a2, voffA);
            PG8_WAIT_V(8); PG8_WAIT_L(0); PG8_BAR; PG8_MMA(1, 0, At, B0); PG8_MMA(1, 1, At, B1); PG8_BAR; PG8_SCHED;
            PG8_LDB(B0, 1, 0); PG8_LDB(B1, 1, 1); PG8_SCHED; PG8_LDA(At, 1, 0); PG8_STAGE(PG8_SA(0, 1), a2 + hstepA, voffA);
            PG8_WAIT_V(8); PG8_WAIT_L(0); PG8_BAR; PG8_MMA(0, 0, At, B0); PG8_MMA(0, 1, At, B1); PG8_BAR; PG8_SCHED;
            PG8_LDA(At, 1, 1); PG8_STAGE(PG8_SB(1, 0), b3, voffB); PG8_STAGE(PG8_SB(1, 1), b3 + hstepB, voffB); PG8_STAGE(PG8_SA(1, 0), a3, voffA);
            PG8_WAIT_V(8); PG8_WAIT_L(0); PG8_BAR; PG8_MMA(1, 0, At, B0); PG8_MMA(1, 1, At, B1); PG8_BAR; PG8_SCHED;
            } else {
            PG8_LDB(B0, 0, 0); PG8_SCHED; PG8_LDA(At, 0, 0); PG8_STAGE(PG8_SA(1, 1), a1 + hstepA, voffA);
            PG8_WAIT_L(8); PG8_BAR; PG8_WAIT_L(0); PG8_MMA(0, 0, At, B0); PG8_BAR; PG8_SCHED;
            PG8_LDB(B1, 0, 1); PG8_STAGE(PG8_SB(0, 0), b2, voffB);
            PG8_BAR; PG8_WAIT_L(0); PG8_MMA(0, 1, At, B1); PG8_BAR;
            PG8_LDA(At, 0, 1); PG8_STAGE(PG8_SA(0, 0), a2, voffA);
            PG8_BAR; PG8_WAIT_L(0); PG8_MMA(1, 0, At, B0); PG8_BAR; PG8_SCHED;
            PG8_STAGE(PG8_SB(0, 1), b2 + hstepB, voffB);
            PG8_WAIT_V(6); PG8_BAR; PG8_MMA(1, 1, At, B1); PG8_BAR;
            PG8_LDB(B0, 1, 0); PG8_SCHED; PG8_LDA(At, 1, 0); PG8_STAGE(PG8_SA(0, 1), a2 + hstepA, voffA);
            PG8_WAIT_L(8); PG8_BAR; PG8_WAIT_L(0); PG8_MMA(0, 0, At, B0); PG8_BAR; PG8_SCHED;
            PG8_LDB(B1, 1, 1); PG8_STAGE(PG8_SB(1, 0), b3, voffB);
            PG8_BAR; PG8_WAIT_L(0); PG8_MMA(0, 1, At, B1); PG8_BAR;
            PG8_LDA(At, 1, 1); PG8_STAGE(PG8_SA(1, 0), a3, voffA);
            PG8_BAR; PG8_WAIT_L(0); PG8_MMA(1, 0, At, B0); PG8_BAR; PG8_SCHED;
            PG8_STAGE(PG8_SB(1, 1), b3 + hstepB, voffB);
            PG8_WAIT_V(6); PG8_BAR; PG8_MMA(1, 1, At, B1); PG8_BAR;
            }
        }
        if constexpr (ALIGN_EPI) { if (wr == 0) PG8_BAR; }
        if constexpr (!Epi::AFTER_DRAIN) { E(acc, cur, wr, wc, fr, fq); S.done(cur); }
        if (!has_next) break;
#pragma unroll
        for (int a = 0; a < 2; ++a)
#pragma unroll
            for (int b = 0; b < 2; ++b)
#pragma unroll
                for (int m = 0; m < 4; ++m)
#pragma unroll
                    for (int n = 0; n < 2; ++n) acc[a][b][m][n] = (f32x4){0.f, 0.f, 0.f, 0.f};
        cur = nxt; cA = nA; cB = nB; ++ui;
        if constexpr (ALIGN_EPI) { if (wr == 1) PG8_BAR; }
    }
    PG8_WAIT_V(0);
    if constexpr (!ALIGN_EPI) { if (wr == 0) PG8_BAR; }
    PG8_BAR;
#undef PG8_SA
#undef PG8_SB
#undef PG8_STAGE
#undef PG8_LDA
#undef PG8_LDB
#undef PG8_MMA
#undef PG8_WAIT_V
#undef PG8_WAIT_L
#undef PG8_BAR
#undef PG8_SCHED
}
#endif
}
struct Args {
    const float* in[35]; float* out; unsigned char* ws;
    int pad0, pad1;

};
#ifdef EMU
typedef const Args* KArgs;
extern thread_local const Args* emu_args_p;
thread_local const Args* emu_args_p = nullptr;
DEV KArgs kargs() { return emu_args_p; }
#else
typedef const __attribute__((address_space(4))) Args* KArgs;
DEV KArgs kargs() { unsigned long long k = (unsigned long long)__builtin_amdgcn_kernarg_segment_ptr(); asm volatile("" : "+s"(k)); return (KArgs)k; }
#endif
enum { I_XP = 0, I_XS, I_C, I_CCTX, I_CK, I_CV, I_CCKV, I_CKR, I_ST, I_MODW, I_MODB, I_NORMG, I_WG, I_WU, I_WD, I_EVIN, I_EVOUT, I_HCW, I_HCB, I_HW1, I_HB1, I_HW2, I_HB2, I_HW3,
       I_HFREQ, I_HBIAS, I_SINK, I_ODIN, I_ODOUT, I_HGLB, I_HGNORM, I_QNORM, I_WQB, I_KVNORM, I_WKVB };

#ifdef EMU
DEV void wsync() { emu_wave_sync(); }
#else
DEV void wsync() { asm volatile("s_waitcnt lgkmcnt(0)" ::: "memory"); __builtin_amdgcn_wave_barrier(); asm volatile("" ::: "memory"); }
#endif
struct TrJob { const float* src; bf16* dst; int N, ldd; float scale; };
DEV void tr_load(const TrJob& j, f32x4 (&v)[8], int lane) {
#pragma unroll
    for (int i = 0; i < 8; ++i) { const int kk = 8 * i + (lane >> 3); v[i] = __builtin_nontemporal_load((const f32x4*)&j.src[(size_t)kk * j.N + 4 * (lane & 7)]) * j.scale; }
}
DEV void tr_finish(const TrJob& j, const f32x4 (&v)[8], LAS float* scr, int lane) {
    wsync();
#pragma unroll
    for (int i = 0; i < 8; ++i) { const int kk = 8 * i + (lane >> 3);
#pragma unroll
        for (int x = 0; x < 4; ++x) scr[kk * 33 + 4 * (lane & 7) + x] = v[i][x]; }
    wsync();
    const int c = lane & 7;
#pragma unroll
    for (int jj = 0; jj < 4; ++jj) { const int n = (lane >> 3) + 8 * jj; const LAS float* s = scr + (8 * c) * 33 + n;
        u32x4 o; o.x = pk2(s[0 * 33], s[1 * 33]); o.y = pk2(s[2 * 33], s[3 * 33]); o.z = pk2(s[4 * 33], s[5 * 33]); o.w = pk2(s[6 * 33], s[7 * 33]);
        __builtin_nontemporal_store(o, (u32x4*)(j.dst + (size_t)n * j.ldd + 8 * c)); }
}
constexpr int tri(int K, int N, int nb) { return nb * (K / 64) * (N / 32); }
template <int K, int N, int LDD, int MODE>
DEV TrJob tr_job(const float* src, long sstride, bf16* dst, bf16* dst2, long dstride, int r) {
    constexpr int nblk = N / 32, per = (K / 64) * nblk; const int bt = r / per; r -= bt * per;
    const int kb = r / nblk, nb = r % nblk, k0 = 64 * kb, n0 = 32 * nb;
    bf16* WT = dst + (size_t)bt * dstride; int drow0 = n0;
    if (MODE == 1) drow0 = 256 * (n0 / 128) + (n0 % 128);
    else if (MODE == 2) drow0 = 256 * (n0 / 128) + 128 + (n0 % 128);
    else if (MODE == 3) { drow0 = 128 * (n0 / 256) + (n0 % 128); if ((n0 % 256) >= 128) WT = dst2; }
    TrJob j; j.src = src + (size_t)bt * sstride + (size_t)k0 * N + n0; j.dst = WT + (size_t)drow0 * LDD + k0; j.N = N; j.ldd = LDD;
    j.scale = MODE == 1 ? -1.4426950408889634f : (MODE == 2 ? -0.6931471805599453f : 1.0f); return j;
}
constexpr int NW_FFN = 2 * tri(D, DFF, 1) + tri(DFF, D, 1);
DEV TrJob ffn_w_job(KArgs a, int ls, int it) {
    unsigned char* ws = a->ws; constexpr int n1 = tri(D, DFF, 1);
    if (it < n1) return tr_job<D, DFF, D, 1>(a->in[I_WG] + (size_t)ls * D * DFF, 0, (bf16*)(ws + WS_WGU + (size_t)ls * SZ_WGU1), nullptr, 0, it);
    if (it < 2 * n1) return tr_job<D, DFF, D, 2>(a->in[I_WU] + (size_t)ls * D * DFF, 0, (bf16*)(ws + WS_WGU + (size_t)ls * SZ_WGU1), nullptr, 0, it - n1);
    return tr_job<DFF, D, DFF, 0>(a->in[I_WD] + (size_t)ls * D * DFF, 0, (bf16*)(ws + WS_WD + (size_t)ls * SZ_WD1), nullptr, 0, it - 2 * n1);
}
constexpr int NW_EV = tri(D, EV_IN, 1) + tri(D, D, 1) + tri(PAST, 128, NB_S * 2);
DEV TrJob ev_w_job(KArgs a, int it) {
    unsigned char* ws = a->ws; constexpr int n1 = tri(D, EV_IN, 1), n2 = n1 + tri(D, D, 1);
    if (it < n1) return tr_job<D, EV_IN, D, 0>(a->in[I_EVIN], 0, (bf16*)(ws + WS_WEVIN), nullptr, 0, it);
    if (it < n2) return tr_job<D, D, D, 0>(a->in[I_EVOUT], 0, (bf16*)(ws + WS_WEVOUT), nullptr, 0, it - n1);
    return tr_job<PAST, 128, PAST, 0>(a->in[I_CV], (long)PAST * 128, (bf16*)(ws + WS_VTC), nullptr, (long)PAST * 128, it - n2);
}
constexpr int NW_OD = tri(D, OD_IN, 1) + tri(D, D, 1) + tri(512, 1536, 1) + tri(256, 2048, 1);
DEV TrJob od_w_job(KArgs a, int it) {
    unsigned char* ws = a->ws; constexpr int n1 = tri(D, OD_IN, 1), n2 = n1 + tri(D, D, 1), n3 = n2 + tri(512, 1536, 1);
    if (it < n1) return tr_job<D, OD_IN, D, 0>(a->in[I_ODIN], 0, (bf16*)(ws + WS_WODIN), nullptr, 0, it);
    if (it < n2) return tr_job<D, D, D, 0>(a->in[I_ODOUT], 0, (bf16*)(ws + WS_WODOUT), nullptr, 0, it - n1);
    if (it < n3) return tr_job<512, 1536, 512, 0>(a->in[I_WQB], 0, (bf16*)(ws + WS_WQB), nullptr, 0, it - n2);
    return tr_job<256, 2048, 256, 3>(a->in[I_WKVB], 0, (bf16*)(ws + WS_WKVK), (bf16*)(ws + WS_WKVV), 0, it - n3);
}
constexpr int NW_GU = 2 * tri(D, DFF, 1), NW_WD = tri(DFF, D, 1), NW_EVW = tri(D, EV_IN, 1) + tri(D, D, 1), NW_VTC = NW_EV - NW_EVW, NW_ODIN = tri(D, OD_IN, 1), NW_ODR = NW_OD - NW_ODIN;
template <int TL> constexpr int tl_count() { return TL == 0 ? NW_GU + NW_EV : TL == 3 ? NW_WD + NW_FFN : TL == 12 ? NW_FFN + NW_ODR : TL == 15 ? NW_GU + NW_ODIN : NW_WD; }
template <int TL> DEV TrJob tl_job(KArgs a, int it) {
    if constexpr (TL == 0) { if (it < NW_GU) return ffn_w_job(a, 0, it); return ev_w_job(a, it - NW_GU); }
    else if constexpr (TL == 3) { if (it < NW_WD) return ffn_w_job(a, 0, NW_GU + it); return ffn_w_job(a, 1, it - NW_WD); }
    else if constexpr (TL == 12) { if (it < NW_FFN) return ffn_w_job(a, 2, it); return od_w_job(a, NW_ODIN + it - NW_FFN); }
    else if constexpr (TL == 15) { if (it < NW_GU) return ffn_w_job(a, 3, it); return od_w_job(a, it - NW_GU); }
    else return ffn_w_job(a, 3, NW_GU + it);
}
template <int TL> DEV void run_tr_jobs(KArgs a, int gw, int NGW, LAS float* scr, int lane) {
    constexpr int n = tl_count<TL>();
    if (gw >= n) return;
    TrJob j0 = tl_job<TL>(a, gw), j1 = j0, j2 = j0, j3 = j0; f32x4 v0[8], v1[8], v2[8], v3[8]; tr_load(j0, v0, lane);
    if (gw + NGW < n) { j1 = tl_job<TL>(a, gw + NGW); tr_load(j1, v1, lane); }
    if (gw + 2 * NGW < n) { j2 = tl_job<TL>(a, gw + 2 * NGW); tr_load(j2, v2, lane); }
    for (int it = gw; ; it += 4 * NGW) {
        if (it + 3 * NGW < n) { j3 = tl_job<TL>(a, it + 3 * NGW); tr_load(j3, v3, lane); }
        tr_finish(j0, v0, scr, lane);
        if (it + NGW >= n) break;
        if (it + 4 * NGW < n) { j0 = tl_job<TL>(a, it + 4 * NGW); tr_load(j0, v0, lane); }
        tr_finish(j1, v1, scr, lane);
        if (it + 2 * NGW >= n) break;
        if (it + 5 * NGW < n) { j1 = tl_job<TL>(a, it + 5 * NGW); tr_load(j1, v1, lane); }
        tr_finish(j2, v2, scr, lane);
        if (it + 3 * NGW >= n) break;
        if (it + 6 * NGW < n) { j2 = tl_job<TL>(a, it + 6 * NGW); tr_load(j2, v2, lane); }
        tr_finish(j3, v3, scr, lane);
        if (it + 4 * NGW >= n) break;
    }
}
constexpr int NW_GEMV = GV_KS * (MODW / 256);
constexpr int NW_GEMV_A = (GV_KS / 8) * (MODW / 256);
DEV void p0_gemv_item(KArgs a, int l, int it, LAS float* scr, int lane) {
    constexpr int NCB = MODW / 256;
    const int cb = it % NCB, ks = it / NCB;
    const float* c = a->in[I_C]; const float* cctx = a->in[I_CCTX];
    wsync();
    for (int e = lane; e < NGRP * GV_KC; e += 64) { const int g = e / GV_KC, kk = e % GV_KC, k = ks * GV_KC + kk; const float v = (g == 0) ? cctx[k] : c[(size_t)(g - 1) * D + k]; scr[e] = silu_f(v); }
    wsync();
    f32x4 acc[NGRP];
#pragma unroll
    for (int g = 0; g < NGRP; ++g) acc[g] = (f32x4){0.f, 0.f, 0.f, 0.f};
    const float* wp = a->in[I_MODW] + ((size_t)l * D + (size_t)ks * GV_KC) * MODW + cb * 256 + lane * 4;
#pragma unroll 8
    for (int kk = 0; kk < GV_KC; ++kk) { const f32x4 w = __builtin_nontemporal_load((const f32x4*)(wp + (size_t)kk * MODW));
#pragma unroll
        for (int g = 0; g < NGRP; ++g) acc[g] += w * scr[g * GV_KC + kk]; }
    float* po = (float*)(a->ws + WS_MODP) + ((size_t)(ks * 2 + l) * NGRP) * MODW + cb * 256 + lane * 4;
#pragma unroll
    for (int g = 0; g < NGRP; ++g) *(f32x4*)(po + (size_t)g * MODW) = acc[g];
}
DEV void p0_filter_item(KArgs a, int it, LAS float* scr, int lane) {
    const int set = it >= L_P ? 1 : 0, t = set ? it - L_P : it, L = set ? L_S : L_P;
    const float* w1 = a->in[I_HW1]; const float* b1 = a->in[I_HB1]; const float* w2 = a->in[I_HW2]; const float* b2 = a->in[I_HB2]; const float* fr = a->in[I_HFREQ];
    LAS float* z = scr; LAS float* h1 = scr + 64;
    wsync();
    if (lane < 33) { float v;
        if (lane == 0) v = (float)((double)t / (double)(L - 1));
        else { const int i = (lane - 1) & 15; const double fb = 1e-4 + (double)i * ((15.0 - 1e-4) / 15.0); const double w = 2.0 * 3.14159265358979323846 * (double)t / (double)L;
            v = (lane <= 16) ? (float)cos(fb * w) : (float)(-sin(fb * w)); }
        z[lane] = v; }
    wsync();
    { float s = b1[lane];
#pragma unroll 3
      for (int i = 0; i < 33; ++i) s += z[i] * w1[i * 64 + lane]; h1[lane] = sinf(fr[lane] * s); }
    wsync();
    { float s = b2[lane];
#pragma unroll 4
      for (int i = 0; i < 64; ++i) s += h1[i] * w2[i * 64 + lane]; ((float*)(a->ws + WS_H2))[(size_t)it * 64 + lane] = sinf(fr[lane] * s); }
}
DEV void p1_filter_item(KArgs a, int it, LAS float* scr, int lane) {
    const int cb = it & 15, tb = it >> 4; const int it0 = 8 * tb, set = it0 >= L_P ? 1 : 0, t0 = set ? it0 - L_P : it0, L = set ? L_S : L_P;
    const float* w3 = a->in[I_HW3]; const float* H2 = (const float*)(a->ws + WS_H2) + (size_t)it0 * 64;
    wsync();
#pragma unroll
    for (int k = 0; k < 8; ++k) scr[k * 64 + lane] = H2[k * 64 + lane];
    wsync();
    f32x4 acc[8];
#pragma unroll
    for (int k = 0; k < 8; ++k) acc[k] = (f32x4){0.f, 0.f, 0.f, 0.f};
    const float* wp = w3 + cb * 256 + lane * 4;
#pragma unroll 8
    for (int j = 0; j < 64; ++j) { const f32x4 w = *(const f32x4*)(wp + (size_t)j * 4096);
#pragma unroll
        for (int k = 0; k < 8; ++k) acc[k] += w * scr[k * 64 + j]; }
    const int col = cb * 256 + lane * 4, nd = col >> 10, c0 = col & 1023;
    bf16* FT = (bf16*)(a->ws + WS_FILT) + (set ? (size_t)4 * 1024 * L_P : 0);
    const float lo = -3.0701134573253946f, hi = -15.350567286626973f;
#pragma unroll
    for (int i = 0; i < 4; ++i) { const float delta = fabsf(lo + (hi - lo) * ((float)(c0 + i) / 1023.0f)); float v[8];
#pragma unroll
        for (int k = 0; k < 8; ++k) { const float tl = (float)(t0 + k) * (1.0f / (float)(L - 1)); v[k] = acc[k][i] * __expf(-tl * delta); }
        u32x4 o; o.x = pk2(v[0], v[1]); o.y = pk2(v[2], v[3]); o.z = pk2(v[4], v[5]); o.w = pk2(v[6], v[7]);
        *(u32x4*)(FT + ((size_t)(nd * 1024 + c0 + i)) * L + t0) = o; }
}
DEV void p0_prologue(KArgs a, LAS unsigned char* lds, int bid, int G) {
    const int tid = tid_l(), lane = tid & 63, wave = __builtin_amdgcn_readfirstlane(tid >> 6);
    LAS float* scr = (LAS float*)(lds + wave * 16384);
    const int gw = bid * NWAVES + wave, NGW = G * NWAVES;
    for (int it = gw; it < NW_GEMV; it += NGW) p0_gemv_item(a, 0, it, scr, lane);
    run_tr_jobs<0>(a, gw, NGW, scr, lane);
    for (int it = gw; it < L_P + L_S; it += NGW) p0_filter_item(a, it, scr, lane);
    const size_t gt = (size_t)bid * NTHR + tid, NGT = (size_t)G * NTHR;
    { const float* s = a->in[I_CK]; bf16* d = (bf16*)(a->ws + WS_KC); const size_t n = (size_t)NB_S * 2 * PAST * 128 / 4;
      for (size_t i = gt; i < n; i += NGT) { const f32x4 v = *(const f32x4*)(s + 4 * i); u32x2 o; o.x = pk2(v[0], v[1]); o.y = pk2(v[2], v[3]); *(u32x2*)(d + 4 * i) = o; } }
}
DEV void mods_finalize(KArgs a, int l, size_t idx, size_t nthr) {
    const size_t n = (size_t)NGRP * MODW / 4; const float* part = (const float*)(a->ws + WS_MODP); float* mods = (float*)(a->ws + WS_MODS);
    for (size_t i = idx; i < n; i += nthr) { const size_t e = (size_t)l * NGRP * MODW + 4 * i; const int col = (int)((4 * i) % MODW);
        f32x4 s = *(const f32x4*)(a->in[I_MODB] + (size_t)l * MODW + col);
        for (int ks = 0; ks < GV_KS; ++ks) s += *(const f32x4*)(part + (size_t)ks * 2 * NGRP * MODW + e);
        *(f32x4*)(mods + e) = s; }
}
DEV int gemm_groups(int units, int G) { const int r = (units + G - 1) / G; return (units + r - 1) / r; }
template <int ph>
DEV void conv_work(KArgs a, LAS unsigned char* lds, int ib, int nconv) {
    const int tid = tid_l(), lane = tid & 63, wave = __builtin_amdgcn_readfirstlane(tid >> 6);
    LAS float* scr = (LAS float*)(lds + wave * 16384);
    const int gw = ib * NWAVES + wave, NGW = nconv * NWAVES;
    if constexpr (ph == 3) { run_tr_jobs<3>(a, gw, NGW, scr, lane); for (int it = gw; it < NW_GEMV_A; it += NGW) p0_gemv_item(a, 1, it, scr, lane); }
    if constexpr (ph == 6) { for (int it = NW_GEMV_A + gw; it < NW_GEMV; it += NGW) p0_gemv_item(a, 1, it, scr, lane); }
    if constexpr (ph == 12) { mods_finalize(a, 1, (size_t)ib * NTHR + tid, (size_t)nconv * NTHR); run_tr_jobs<12>(a, gw, NGW, scr, lane); }
    if constexpr (ph == 15) run_tr_jobs<15>(a, gw, NGW, scr, lane);
    if constexpr (ph == 18) run_tr_jobs<18>(a, gw, NGW, scr, lane);
}
DEV void p1_mods(KArgs a, LAS unsigned char* lds, int bid, int G) {
    { const int tid = tid_l(), lane = tid & 63, wave = __builtin_amdgcn_readfirstlane(tid >> 6); LAS float* scr = (LAS float*)(lds + wave * 16384);
      for (int it = bid * NWAVES + wave; it < ((L_P + L_S) / 8) * 16; it += G * NWAVES) p1_filter_item(a, it, scr, lane); }
    mods_finalize(a, 0, (size_t)bid * NTHR + tid_l(), (size_t)G * NTHR);
}

DEV const float* modvec(KArgs a, int l, int g, int j) { return (const float*)(a->ws + WS_MODS) + ((size_t)(l * NGRP + g) * NMOD + j) * D; }
DEV void prenorm_store(const f32x4 (&x)[8], const float* gpre, const float* shift, const float* scale, bf16* hrow, int lane) {
    float ss = 0.f;
#pragma unroll
    for (int j = 0; j < 8; ++j) ss += (x[j][0] * x[j][0] + x[j][1] * x[j][1]) + (x[j][2] * x[j][2] + x[j][3] * x[j][3]);
    const float rstd = rsqrtf(wave_sum(ss) * (1.0f / D) + 1e-6f);
#pragma unroll
    for (int j = 0; j < 8; ++j) { const int e = 256 * j + 4 * lane; const f32x4 g = *(const f32x4*)(gpre + e), sh = *(const f32x4*)(shift + e), sc = *(const f32x4*)(scale + e);
        const f32x4 h = x[j] * rstd * g * (1.0f + sc) + sh;
        u32x2 o; o.x = pk2(h[0], h[1]); o.y = pk2(h[2], h[3]); *(u32x2*)(hrow + e) = o; }
}
DEV void phase_norm0(KArgs a, int bid, int G) {
    const int lane = tid_l() & 63, gw = bid * NWAVES + (tid_l() >> 6), NGW = G * NWAVES;
    bf16* HN = (bf16*)(a->ws + WS_HN); const float* ng = a->in[I_NORMG];
    for (int row = gw; row < T; row += NGW) {
        const float* xr = row < TP ? a->in[I_XP] + (size_t)row * D : a->in[I_XS] + (size_t)(row - TP) * D; const int g = grp_of_row(row);
        f32x4 x[8];
#pragma unroll
        for (int j = 0; j < 8; ++j) x[j] = *(const f32x4*)(xr + 256 * j + 4 * lane);
        prenorm_store(x, ng + (size_t)(0 * 6 + 0) * D, modvec(a, 0, g, 0), modvec(a, 0, g, 1), HN + (size_t)row * D, lane);
    }
}
DEV void phase_residual(KArgs a, LAS unsigned char* lds, int bid, int G, int l, int j, float w, int nl, int nj, bool first, bool last) {
    const int tid = tid_l(), lane = tid & 63, wave = tid >> 6;
    LAS float* vec = (LAS float*)lds;
    bf16* HN = (bf16*)(a->ws + WS_HN); const float* ng = a->in[I_NORMG]; _Float16* X = (_Float16*)(a->ws + WS_X);
    const bf16* O0 = (const bf16*)(a->ws + WS_OUT); const bf16* O1 = O0 + (size_t)T * D;
    for (int chunk = bid; chunk < T / 16; chunk += G) {
        const int row0 = 16 * chunk, g = grp_of_row(row0);
        lds_barrier();
        for (int e = tid; e < 5 * D / 4; e += NTHR) { const int v = e / (D / 4), i = 4 * (e % (D / 4)); const float* src;
            if (v == 0) src = modvec(a, l, g, 3 * j + 2); else if (v == 1) src = ng + (size_t)(l * 6 + 2 * j + 1) * D;
            else if (nl < 0) src = ng; else if (v == 2) src = ng + (size_t)(nl * 6 + 2 * nj) * D; else if (v == 3) src = modvec(a, nl, g, 3 * nj); else src = modvec(a, nl, g, 3 * nj + 1);
            *(LAS f32x4*)(vec + v * D + i) = *(const f32x4*)(src + i); }
        lds_barrier();
        u32x2 p0[2][8], p1[2][8]; f32x4 x[2][8]; float ss[2];
#define UNPK_SUM(a_, b_) (f32x4){__uint_as_float((a_).x << 16) + __uint_as_float((b_).x << 16), __uint_as_float((a_).x & 0xffff0000u) + __uint_as_float((b_).x & 0xffff0000u), \
                                 __uint_as_float((a_).y << 16) + __uint_as_float((b_).y << 16), __uint_as_float((a_).y & 0xffff0000u) + __uint_as_float((b_).y & 0xffff0000u)}
#pragma unroll
        for (int rr = 0; rr < 2; ++rr) { const int row = row0 + 2 * wave + rr;
            const float* xr = row < TP ? a->in[I_XP] + (size_t)row * D : a->in[I_XS] + (size_t)(row - TP) * D; const _Float16* xh = X + (size_t)row * D;
#pragma unroll
            for (int k = 0; k < 8; ++k) { const int e = 256 * k + 4 * lane; p0[rr][k] = __builtin_nontemporal_load((const u32x2*)(O0 + (size_t)row * D + e)); p1[rr][k] = __builtin_nontemporal_load((const u32x2*)(O1 + (size_t)row * D + e));
                if (first) x[rr][k] = *(const f32x4*)(xr + e); else x[rr][k] = __builtin_convertvector(__builtin_nontemporal_load((const f16x4*)(xh + e)), f32x4); } }
#pragma unroll
        for (int rr = 0; rr < 2; ++rr) { float s = 0.f;
#pragma unroll
            for (int k = 0; k < 8; ++k) { const f32x4 o = UNPK_SUM(p0[rr][k], p1[rr][k]); s += (o[0] * o[0] + o[1] * o[1]) + (o[2] * o[2] + o[3] * o[3]); }
            ss[rr] = s; }
#pragma unroll
        for (int of = 1; of < 64; of <<= 1) { ss[0] += __shfl_xor(ss[0], of); ss[1] += __shfl_xor(ss[1], of); }
        float s2[2];
#pragma unroll
        for (int rr = 0; rr < 2; ++rr) { const int row = row0 + 2 * wave + rr; const float rstd = rsqrtf(ss[rr] * (1.0f / D) + 1e-6f);
            float* xo = a->out + OUT_Y + (size_t)row * D; _Float16* xoh = X + (size_t)row * D; float s = 0.f;
#pragma unroll
            for (int k = 0; k < 8; ++k) { const int e = 256 * k + 4 * lane; const f32x4 gt = *(const LAS f32x4*)(vec + e), gp = *(const LAS f32x4*)(vec + D + e); const f32x4 o = UNPK_SUM(p0[rr][k], p1[rr][k]);
                x[rr][k] = x[rr][k] + w * gt * (o * rstd * gp);
                if (last) __builtin_nontemporal_store(x[rr][k], (f32x4*)(xo + e)); else __builtin_nontemporal_store(__builtin_convertvector(x[rr][k], f16x4), (f16x4*)(xoh + e));
                s += (x[rr][k][0] * x[rr][k][0] + x[rr][k][1] * x[rr][k][1]) + (x[rr][k][2] * x[rr][k][2] + x[rr][k][3] * x[rr][k][3]); SCHED_FENCE(); }
            s2[rr] = s; }
#undef UNPK_SUM
        if (nl >= 0) {
#pragma unroll
            for (int of = 1; of < 64; of <<= 1) { s2[0] += __shfl_xor(s2[0], of); s2[1] += __shfl_xor(s2[1], of); }
#pragma unroll
            for (int rr = 0; rr < 2; ++rr) { const int row = row0 + 2 * wave + rr; const float rstd = rsqrtf(s2[rr] * (1.0f / D) + 1e-6f);
#pragma unroll
                for (int k = 0; k < 8; ++k) { const int e = 256 * k + 4 * lane; const f32x4 gq = *(const LAS f32x4*)(vec + 2 * D + e), sh = *(const LAS f32x4*)(vec + 3 * D + e), sc = *(const LAS f32x4*)(vec + 4 * D + e);
                    const f32x4 h = x[rr][k] * rstd * gq * (1.0f + sc) + sh; u32x2 ow; ow.x = pk2(h[0], h[1]); ow.y = pk2(h[2], h[3]); *(u32x2*)(HN + (size_t)row * D + e) = ow; SCHED_FENCE(); } }
        }
    }
}
constexpr float LOG2E = 1.4426950408889634f;
DEV void phase_rope_kvout(KArgs a, int bid, int G) {
    const int lane = tid_l() & 63, gw = bid * NWAVES + (tid_l() >> 6), NGW = G * NWAVES;
    bf16* QKV = (bf16*)(a->ws + WS_QKV);
    for (int it = gw; it < TS * 10; it += NGW) {
        const int ts = it / 10, slot = it % 10, pos = ts % L_S; bf16* p = QKV + (size_t)(TP + ts) * NQKV + slot * 128;
        const int half = lane >> 5, dd = lane & 31, d1 = 64 * half + dd;
        const float inv = exp2f(-(float)dd * (13.287712379549449f / 32.0f));
        const float ang = (float)(half ? (pos % 64) : (pos / 64)) * inv; const float cs = fast_cos(ang), sn = fast_sin(ang);
        const float x1 = bf2f(p[d1]), x2 = bf2f(p[d1 + 32]);
        p[d1] = (bf16)f2bf(x1 * cs - x2 * sn); p[d1 + 32] = (bf16)f2bf(x2 * cs + x1 * sn);
    }
    const size_t gt = (size_t)bid * NTHR + tid_l(), NGT = (size_t)G * NTHR; const size_t n = (size_t)NB_P * 2 * L_P * 128;
    for (size_t i = gt; i < 2 * n; i += NGT) { const int isv = i >= n; const size_t o = isv ? i - n : i; const int d = (int)(o % 128), t = (int)((o / 128) % L_P), kvh = (int)((o / ((size_t)128 * L_P)) % 2), b = (int)(o / ((size_t)256 * L_P));
        a->out[(isv ? OUT_V : OUT_K) + o] = bf2f(QKV[(size_t)(b * L_P + t) * NQKV + 1024 + 256 * isv + kvh * 128 + d]); }
}
template <int L, int NB> struct HyRegs { static constexpr int NUC = (3 * NB * L / 8 + NTHR - 1) / NTHR, NFC = (4 * L / 8 + NTHR - 1) / NTHR; u32x4 u[NUC]; u32x4 f[NFC]; float w[3][3], cb[3], hb[2]; };
template <int L, int NB>
DEV void hyena_load(KArgs a, int c, int tok0, const bf16* FT, HyRegs<L, NB>& g, int tid) {
    const bf16* UT = (const bf16*)(a->ws + WS_UT); const float* cw = a->in[I_HCW]; const float* cb = a->in[I_HCB]; const float* hb = a->in[I_HBIAS];
#pragma unroll
    for (int k = 0; k < HyRegs<L, NB>::NUC; ++k) { const int e = tid + NTHR * k; if (e < 3 * NB * L / 8) { const int x = e / (NB * L / 8), i = e % (NB * L / 8), b = i / (L / 8), t8 = i % (L / 8);
        g.u[k] = __builtin_nontemporal_load((const u32x4*)(UT + (size_t)(1024 * x + c) * T + tok0 + b * L + 8 * t8)); } }
#pragma unroll
    for (int k = 0; k < HyRegs<L, NB>::NFC; ++k) { const int e = tid + NTHR * k; if (e < 4 * L / 8) { const int nd = e / (L / 8), t8 = e % (L / 8); g.f[k] = *(const u32x4*)(FT + ((size_t)nd * 1024 + c) * L + 8 * t8); } }
#pragma unroll
    for (int x = 0; x < 3; ++x) { const int ch = 1024 * x + c; g.w[x][0] = cw[ch]; g.w[x][1] = cw[3072 + ch]; g.w[x][2] = cw[2 * 3072 + ch]; g.cb[x] = cb[ch]; }
    g.hb[0] = hb[c]; g.hb[1] = hb[1024 + c];
}
template <int L, int NB>
DEV void hyena_item(KArgs a, LAS unsigned char* lds, int c, int tok0, const HyRegs<L, NB>& g) {
    constexpr int ZP = L + 8, UP = L + 16, NTW = L / 128, NS = L / 32, CS = 2 * L + 32;
    LAS bf16* zin = (LAS bf16*)lds; LAS bf16* z1 = zin + NB * ZP; LAS bf16* R = z1 + NB * ZP; LAS bf16* U = R + 2 * 4 * CS;
    const int tid = tid_l(), lane = tid & 63, wave = tid >> 6, q = lane >> 4, r = lane & 15;
    bf16* YT = (bf16*)(a->ws + WS_YT);
#pragma unroll
    for (int k = 0; k < HyRegs<L, NB>::NUC; ++k) { const int e = tid + NTHR * k; if (e < 3 * NB * L / 8) { const int x = e / (NB * L / 8), i = e % (NB * L / 8), b = i / (L / 8), t8 = i % (L / 8);
        *(LAS u32x4*)(U + (x * NB + b) * UP + 8 + 8 * t8) = g.u[k]; } }
    for (int e = tid; e < 3 * NB * 2; e += NTHR) { const int rowi = e >> 1; U[rowi * UP + ((e & 1) ? 8 + L : 7)] = 0; }
#pragma unroll
    for (int k = 0; k < HyRegs<L, NB>::NFC; ++k) { const int e = tid + NTHR * k; if (e < 4 * L / 8) { const int nd = e / (L / 8), t8 = e % (L / 8), n = nd >> 1, dir = nd & 1; const bf16x8 v = __builtin_bit_cast(bf16x8, g.f[k]);
#pragma unroll
        for (int j = 0; j < 8; ++j) { const int t = 8 * t8 + j; if (dir == 1 && t == 0) continue; const int i = dir ? L + t : L - t;
#pragma unroll
            for (int m = 0; m < 4; ++m) if (i - m >= 0) R[(n * 4 + m) * CS + i - m] = (bf16)v[j]; } } }
    lds_barrier();
    { const float w0 = g.w[0][0], w1 = g.w[0][1], w2 = g.w[0][2], bb = g.cb[0];
      for (int e = tid; e < NB * L / 4; e += NTHR) { const int b = e / (L / 4), t = 4 * (e % (L / 4)); const LAS bf16* u = U + b * UP + 8 + t; float uu[6];
#pragma unroll
          for (int x = 0; x < 6; ++x) uu[x] = bf2f(u[x - 1]);
          u32x2 w; w.x = pk2(bb + w0 * uu[0] + w1 * uu[1] + w2 * uu[2], bb + w0 * uu[1] + w1 * uu[2] + w2 * uu[3]); w.y = pk2(bb + w0 * uu[2] + w1 * uu[3] + w2 * uu[4], bb + w0 * uu[3] + w1 * uu[4] + w2 * uu[5]);
          *(LAS u32x2*)(zin + b * ZP + t) = w; } }
    lds_barrier();
    const int i0 = wave * NTW;
#pragma unroll
    for (int n = 0; n < 2; ++n) {
        const LAS bf16* zi = n == 0 ? zin : z1; const LAS bf16* Rn = R + n * 4 * CS;
        f32x4 acc[NTW];
#pragma unroll
        for (int i = 0; i < NTW; ++i) acc[i] = (f32x4){0.f, 0.f, 0.f, 0.f};
        constexpr int KB = 4, NWV = NTW + 2 * (KB - 1), NKB = NS / KB;
        static_assert(NS % KB == 0, "s-tiles per step");
        const int mshift = (4 - (r & 3)) & 3;
        const LAS bf16* zrow = zi + (r % NB) * ZP + 8 * q; const LAS bf16* Cb = Rn + mshift * CS - mshift + (L - (16 * i0 + r - 8 * q));
#define HY_LOAD(Bf_, Af_, kb_) do { \
            _Pragma("unroll") for (int kk = 0; kk < KB; ++kk) Bf_[kk] = *(const LAS bf16x8*)(zrow + 32 * (KB * (kb_) + kk)); \
            _Pragma("unroll") for (int wv = 0; wv < NWV; ++wv) { const LAS bf16* Cm = Cb + 32 * KB * (kb_) - 16 * (wv - 2 * (KB - 1)); const bf16x4 a0 = *(const volatile LAS bf16x4*)Cm, a1 = *(const volatile LAS bf16x4*)(Cm + 4);     \
                bf16x8 A; A[0] = a0[0]; A[1] = a0[1]; A[2] = a0[2]; A[3] = a0[3]; A[4] = a1[0]; A[5] = a1[1]; A[6] = a1[2]; A[7] = a1[3]; Af_[wv] = A; } } while (0)
#define HY_MMA(Bf_, Af_) do { \
            _Pragma("unroll") for (int kk = 0; kk < KB; ++kk) _Pragma("unroll") for (int ii = 0; ii < NTW; ++ii) acc[ii] = mfma16(Af_[ii - 2 * kk + 2 * (KB - 1)], Bf_[kk], acc[ii]); } while (0)
        bf16x8 Bf0[KB], Af0[NWV], Bf1[KB], Af1[NWV];
        HY_LOAD(Bf0, Af0, 0);
        for (int kb = 0; kb < NKB; kb += 2) {
            if (kb + 1 < NKB) HY_LOAD(Bf1, Af1, kb + 1);
            HY_MMA(Bf0, Af0);
            if (kb + 1 >= NKB) break;
            if (kb + 2 < NKB) HY_LOAD(Bf0, Af0, kb + 2);
            HY_MMA(Bf1, Af1);
        }
#undef HY_LOAD
#undef HY_MMA
        if (r < NB) {
            const float w0 = g.w[n + 1][0], w1 = g.w[n + 1][1], w2 = g.w[n + 1][2], bb = g.cb[n + 1], hbias = g.hb[n];
            const LAS bf16* ug = U + ((n + 1) * NB + r) * UP + 8;
#pragma unroll
            for (int ti = 0; ti < NTW; ++ti) { const int t = 16 * (i0 + ti) + 4 * q; float uu[6];
#pragma unroll
                for (int x = 0; x < 6; ++x) uu[x] = bf2f(ug[t - 1 + x]);
                float o[4];
#pragma unroll
                for (int x = 0; x < 4; ++x) { const float gate = bb + w0 * uu[x] + w1 * uu[x + 1] + w2 * uu[x + 2]; o[x] = gate * (acc[ti][x] + hbias * bf2f(zi[r * ZP + t + x])); }
                u32x2 w; w.x = pk2(o[0], o[1]); w.y = pk2(o[2], o[3]);
                if (n == 0) *(LAS u32x2*)(z1 + r * ZP + t) = w; else __builtin_nontemporal_store(w, (u32x2*)(YT + (size_t)c * T + tok0 + r * L + t)); }
        }
        lds_barrier();
    }
}
template <int L, int NB>
DEV void hyena_run(KArgs a, LAS unsigned char* lds, int first, int last, int G, int cbase, int tok0, const bf16* FT) {
    if (first >= last) return;
    const int tid = tid_l();
    HyRegs<L, NB> cur; hyena_load<L, NB>(a, first - cbase, tok0, FT, cur, tid);
    for (int it = first; it < last; it += G) {
        HyRegs<L, NB> nx = cur; const int nxt = it + G;
        if (nxt < last) hyena_load<L, NB>(a, nxt - cbase, tok0, FT, nx, tid);
        hyena_item<L, NB>(a, lds, it - cbase, tok0, cur);
        cur = nx;
    }
}
DEV void phase_hyena(KArgs a, LAS unsigned char* lds, int bid, int G) {
    const bf16* fp = (const bf16*)(a->ws + WS_FILT); const bf16* fs = fp + (size_t)4 * 1024 * L_P;
    hyena_run<L_S, NB_S>(a, lds, bid, 1024, G, 0, TP, fs);
    const int firstp = bid + ((1024 - bid + G - 1) / G) * G;
    hyena_run<L_P, NB_P>(a, lds, firstp, 2048, G, 1024, 0, fp);
    __syncthreads();
}

template <int NKS, bool WIN>
DEV void attn_segment(float& m, float& lsum, f32x4 (&o)[8], const bf16x8 (&Q)[NKS], const bf16* K, int ldk, const bf16* KR, const bf16* VT, int ldvt, int k0, int k1, int qpos, float sc, int r, int q) {
    for (int kt = k0; kt < k1; kt += 32) {
        f32x4 s[2];
#pragma unroll
        for (int tl = 0; tl < 2; ++tl) { s[tl] = (f32x4){0.f, 0.f, 0.f, 0.f}; const bf16* krow = K + (size_t)(kt + 16 * tl + r) * ldk + 8 * q;
#pragma unroll
            for (int ks = 0; ks < 4; ++ks) s[tl] = mfma16(ld_bf16x8(krow + 32 * ks), Q[ks], s[tl]);
            if constexpr (NKS > 4) { const bf16* kr = KR + (size_t)(kt + 16 * tl + r) * 64 + 8 * q;
#pragma unroll
                for (int ks = 4; ks < NKS; ++ks) s[tl] = mfma16(ld_bf16x8(kr + 32 * (ks - 4)), Q[ks], s[tl]); } }
        float p[8]; float tmax = -1e30f;
#pragma unroll
        for (int tl = 0; tl < 2; ++tl)
#pragma unroll
            for (int x = 0; x < 4; ++x) { float v = s[tl][x] * sc; if (WIN) { const int dlt = kt + 16 * tl + 4 * q + x - qpos; if (dlt > 128 || dlt < -128) v = -1e30f; } p[4 * tl + x] = v; tmax = fmaxf(tmax, v); }
        tmax = fmaxf(tmax, __shfl_xor(tmax, 16)); tmax = fmaxf(tmax, __shfl_xor(tmax, 32));
        const float mnew = fmaxf(m, tmax), alpha = exp2f(m - mnew); float psum = 0.f;
#pragma unroll
        for (int x = 0; x < 8; ++x) { p[x] = exp2f(p[x] - mnew); psum += p[x]; }
        lsum = lsum * alpha + psum; m = mnew;
        bf16x8 P;
#pragma unroll
        for (int x = 0; x < 8; ++x) P[x] = (short)f2bf(p[x]);
#pragma unroll
        for (int dt = 0; dt < 8; ++dt) { const bf16* vp = VT + (size_t)(16 * dt + r) * ldvt + kt + 4 * q; const bf16x4 v0 = *(const bf16x4*)vp, v1 = *(const bf16x4*)(vp + 16);
            bf16x8 V; V[0] = v0[0]; V[1] = v0[1]; V[2] = v0[2]; V[3] = v0[3]; V[4] = v1[0]; V[5] = v1[1]; V[6] = v1[2]; V[7] = v1[3];
            o[dt] = mfma16(V, P, o[dt] * alpha); }
    }
}
DEV void attn_store(const f32x4 (&o)[8], float lsum, bf16* orow  , int q) {
    lsum = xrow16_sum(lsum); const float inv = fast_rcp(lsum);
#pragma unroll
    for (int dt = 0; dt < 8; ++dt) { u32x2 w; w.x = pk2(o[dt][0] * inv, o[dt][1] * inv); w.y = pk2(o[dt][2] * inv, o[dt][3] * inv); *(u32x2*)(orow + 16 * dt + 4 * q) = w; }
}
DEV void phase_attn_even(KArgs a, int bid, int G) {
    const int lane = tid_l() & 63, gw = bid * NWAVES + (tid_l() >> 6), NGW = G * NWAVES, r = lane & 15, q = lane >> 4;
    const bf16* QKV = (const bf16*)(a->ws + WS_QKV); const bf16* VTE = (const bf16*)(a->ws + WS_VTE); const bf16* KC = (const bf16*)(a->ws + WS_KC); const bf16* VTC = (const bf16*)(a->ws + WS_VTC);
    bf16* MIX = (bf16*)(a->ws + WS_MIX); const float* sink = a->in[I_SINK];
    constexpr int NQS = L_S / 16, NQP = L_P / 16, NI_S = NB_S * 2 * NQS * 4, NI_P = NB_P * 2 * NQP * 4;
    const float sc = 0.08838834764831845f * LOG2E;
    for (int it = gw; it < NI_S + NI_P; it += NGW) {
        const bool smp = it < NI_S; const int i2 = smp ? it : it - NI_S; const int g = i2 & 3, NQ = smp ? NQS : NQP, qt = (i2 >> 2) % NQ, bk = (i2 >> 2) / NQ, kvh = bk & 1, b = bk >> 1;
        const int head = kvh * 4 + g, seq0 = smp ? TP + b * L_S : b * L_P, q0 = 16 * qt;
        const bf16* qrow = QKV + (size_t)(seq0 + q0 + r) * NQKV + head * 128 + 8 * q;
        bf16x8 Q[4];
#pragma unroll
        for (int ks = 0; ks < 4; ++ks) Q[ks] = ld_bf16x8(qrow + 32 * ks);
        float m = sink[head] * LOG2E, lsum = (q == 0) ? 1.0f : 0.0f; f32x4 o[8];
#pragma unroll
        for (int dt = 0; dt < 8; ++dt) o[dt] = (f32x4){0.f, 0.f, 0.f, 0.f};
        const bf16* K = QKV + (size_t)seq0 * NQKV + 1024 + kvh * 128; const bf16* VT = VTE + (size_t)(kvh * 128) * T + seq0;
        if (smp) {
            int k0 = q0 - 128; if (k0 < 0) k0 = 0; k0 &= ~31; int k1 = (q0 + 16 + 128 + 31) & ~31; if (k1 > L_S) k1 = L_S;
            attn_segment<4, true>(m, lsum, o, Q, K, NQKV, nullptr, VT, T, k0, k1, q0 + r, sc, r, q);
            attn_segment<4, false>(m, lsum, o, Q, KC + (size_t)((b * 2 + kvh) * PAST) * 128, 128, nullptr, VTC + (size_t)((b * 2 + kvh) * 128) * PAST, PAST, 0, PAST, 0, sc, r, q);
        } else attn_segment<4, false>(m, lsum, o, Q, K, NQKV, nullptr, VT, T, 0, L_P, 0, sc, r, q);
        attn_store(o, lsum, MIX + (size_t)(seq0 + q0 + r) * D + 1024 + head * 128, q);
    }
}
DEV void phase_ytrans(KArgs a, LAS unsigned char* lds, int bid, int G) {
    const int lane = tid_l() & 63, wave = tid_l() >> 6, gw = bid * NWAVES + wave, NGW = G * NWAVES;
    LAS bf16* scr = (LAS bf16*)(lds + wave * 16384); constexpr int PT = 36;
    const bf16* YT = (const bf16*)(a->ws + WS_YT); bf16* MIX = (bf16*)(a->ws + WS_MIX);
    for (int it = gw; it < 32 * (T / 64); it += NGW) { const int c0 = 32 * (it % 32), t0 = 64 * (it / 32);
        wsync();
#pragma unroll
        for (int rr = 0; rr < 8; ++rr) { const int c = 4 * rr + (lane >> 4), tk = (lane & 15) * 4; const bf16x4 v = *(const bf16x4*)(YT + (size_t)(c0 + c) * T + t0 + tk);
#pragma unroll
            for (int x = 0; x < 4; ++x) scr[(tk + x) * PT + c] = (bf16)v[x]; }
        wsync();
#pragma unroll
        for (int rr = 0; rr < 8; ++rr) { const int tk = 8 * rr + (lane >> 3), cc = (lane & 7) * 4; *(u32x2*)(MIX + (size_t)(t0 + tk) * D + c0 + cc) = *(const LAS u32x2*)(scr + tk * PT + cc); }
    }
}
#ifdef EMU
DEV bool ANY_LANE(bool p) { int v = p ? 1 : 0; for (int o = 1; o < 64; o <<= 1) v |= __shfl_xor(v, o); return v != 0; }
#else
DEV bool ANY_LANE(bool p) { return __builtin_amdgcn_ballot_w64(p) != 0ull; }
#endif
struct AttnSeg { const bf16* K; const bf16* KR; const bf16* VT; int ldk, ldvt, ntiles, kt0; };
template <int DQK> struct AttnLds { static constexpr int KP = DQK + 8, KB = 32 * KP * 2, VB = 128 * 40 * 2, BUF = KB + VB; };
template <int DQK>
DEV void attn_tile_load(const AttnSeg& s, int kt, u32x4 (&kreg)[2], u32x4& vreg, int tid) {
    constexpr int CPR = DQK / 8;
#pragma unroll
    for (int i = 0; i < 2; ++i) { const int c = tid + 512 * i; if (c < 32 * CPR) { const int key = c / CPR, part = c % CPR;
        const bf16* p = (part < 16) ? s.K + (size_t)(kt + key) * s.ldk + part * 8 : s.KR + (size_t)(kt + key) * 64 + (part - 16) * 8; kreg[i] = *(const u32x4*)p; } }
    { const int dv = tid >> 2, kc = tid & 3; vreg = *(const u32x4*)(s.VT + (size_t)dv * s.ldvt + kt + 8 * kc); }
}
template <int DQK>
DEV void attn_tile_store(LAS unsigned char* buf, const u32x4 (&kreg)[2], const u32x4& vreg, int tid) {
    constexpr int CPR = DQK / 8, KP = AttnLds<DQK>::KP;
#pragma unroll
    for (int i = 0; i < 2; ++i) { const int c = tid + 512 * i; if (c < 32 * CPR) { const int key = c / CPR, part = c % CPR; *(LAS u32x4*)(buf + (key * KP + part * 8) * 2) = kreg[i]; } }
    { const int dv = tid >> 2, kc = tid & 3; LAS unsigned char* vb = buf + AttnLds<DQK>::KB + dv * 80;
      const int k4a = 2 * kc, k4b = 2 * kc + 1;
      *(LAS u32x2*)(vb + (8 * (k4a & 3) + 4 * (k4a >> 2)) * 2) = (u32x2){vreg.x, vreg.y}; *(LAS u32x2*)(vb + (8 * (k4b & 3) + 4 * (k4b >> 2)) * 2) = (u32x2){vreg.z, vreg.w}; }
}
template <int DQK, int QT>
DEV void attn_block(LAS unsigned char* lds, const AttnSeg& s0, const AttnSeg& s1, const bf16x8 (&Q)[QT][DQK / 32], float m0, float l0, bool active, bool win, int qw0, float sc,
                    bf16* orow0  , int tid) {
    constexpr int NKS = DQK / 32, KP = AttnLds<DQK>::KP, BUF = AttnLds<DQK>::BUF;
    const int lane = tid & 63, r = lane & 15, q = lane >> 4;
    float m[QT], ls[QT]; f32x4 o[QT][8];
#pragma unroll
    for (int qi = 0; qi < QT; ++qi) { m[qi] = m0; ls[qi] = (q == 0) ? l0 : 0.f;
#pragma unroll
        for (int dt = 0; dt < 8; ++dt) o[qi][dt] = (f32x4){0.f, 0.f, 0.f, 0.f}; }
    const int nt = s0.ntiles + s1.ntiles;
    u32x4 kreg[2]; u32x4 vreg;
    __syncthreads();
    attn_tile_load<DQK>(s0, s0.kt0, kreg, vreg, tid);
    attn_tile_store<DQK>(lds, kreg, vreg, tid);
    __syncthreads();
    for (int ti = 0; ti < nt; ++ti) {
        LAS unsigned char* cur = lds + (ti & 1) * BUF; LAS unsigned char* nxt = lds + ((ti + 1) & 1) * BUF;
        const bool has_next = ti + 1 < nt;
        if (has_next) { const int tn = ti + 1; if (tn < s0.ntiles) attn_tile_load<DQK>(s0, s0.kt0 + 32 * tn, kreg, vreg, tid); else attn_tile_load<DQK>(s1, s1.kt0 + 32 * (tn - s0.ntiles), kreg, vreg, tid); }
        const bool seg0 = ti < s0.ntiles; const int kt = seg0 ? s0.kt0 + 32 * ti : s1.kt0 + 32 * (ti - s0.ntiles);
        const bool wmask = win && seg0;
        bool doit = active;
        if (wmask) doit = doit && (kt + 31 >= qw0 - 128) && (kt <= qw0 + 16 * QT - 1 + 128);
        if (doit) {
            f32x4 sacc[QT][2];
#pragma unroll
            for (int tl = 0; tl < 2; ++tl) { bf16x8 Kf[NKS];
#pragma unroll
                for (int ks = 0; ks < NKS; ++ks) Kf[ks] = *(const LAS bf16x8*)(cur + ((16 * tl + r) * KP + 32 * ks + 8 * q) * 2);
#pragma unroll
                for (int qi = 0; qi < QT; ++qi) { sacc[qi][tl] = (f32x4){0.f, 0.f, 0.f, 0.f};
#pragma unroll
                    for (int ks = 0; ks < NKS; ++ks) sacc[qi][tl] = mfma16(Kf[ks], Q[qi][ks], sacc[qi][tl]); } }
            bf16x8 P[QT]; float alpha[QT]; bool moved = false;
#pragma unroll
            for (int qi = 0; qi < QT; ++qi) {
                const f32x4 (&s)[2] = sacc[qi];
                float p[8]; float tmax = -1e30f; const int qpos = qw0 + 16 * qi + r;
#pragma unroll
                for (int tl = 0; tl < 2; ++tl)
#pragma unroll
                    for (int x = 0; x < 4; ++x) { float v = s[tl][x]; if (wmask) { const int dlt = kt + 16 * tl + 4 * q + x - qpos; if (dlt > 128 || dlt < -128) v = -1e30f; } p[4 * tl + x] = v; tmax = fmaxf(tmax, v); }
                tmax = xrow16_max(tmax);
                const float mnew = fmaxf(m[qi], tmax * sc); alpha[qi] = fast_exp2(m[qi] - mnew); moved = moved || (mnew > m[qi]); float psum = 0.f;
#pragma unroll
                for (int x = 0; x < 8; ++x) { p[x] = fast_exp2(__builtin_fmaf(p[x], sc, -mnew)); psum += p[x]; }
                ls[qi] = ls[qi] * alpha[qi] + psum; m[qi] = mnew;
                { u32x4 pw; pw.x = pk2(p[0], p[1]); pw.y = pk2(p[2], p[3]); pw.z = pk2(p[4], p[5]); pw.w = pk2(p[6], p[7]); P[qi] = __builtin_bit_cast(bf16x8, pw); }
            }
            if (ANY_LANE(moved)) {
#pragma unroll
                for (int qi = 0; qi < QT; ++qi)
#pragma unroll
                    for (int dt = 0; dt < 8; ++dt) o[qi][dt] = o[qi][dt] * alpha[qi];
            }
#pragma unroll
            for (int dt = 0; dt < 8; ++dt) { const bf16x8 V = *(const LAS bf16x8*)(cur + AttnLds<DQK>::KB + (16 * dt + r) * 80 + 16 * q);
#pragma unroll
                for (int qi = 0; qi < QT; ++qi) o[qi][dt] = mfma16(V, P[qi], o[qi][dt]);
                SCHED_FENCE(); }
        }
        if (has_next) attn_tile_store<DQK>(nxt, kreg, vreg, tid);
        __syncthreads();
    }
    if (active) {
#pragma unroll
        for (int qi = 0; qi < QT; ++qi) attn_store(o[qi], ls[qi], orow0 + (size_t)(16 * qi + r) * D, q);
    }
}
constexpr int PO_QH = 0, PO_FF = 1024, PO_FB = 2048, PO_IH = 3072, PO_GH = 4096, PO_QL = 5120, PO_KVL = 5632, PO_KRP = 5888;
DEV void phase_mla_prep(KArgs a, int bid, int G) {
    const int lane = tid_l() & 63, gw = bid * NWAVES + (tid_l() >> 6), NGW = G * NWAVES;
    const bf16* P = (const bf16*)(a->ws + WS_P); bf16* QN = (bf16*)(a->ws + WS_QN); bf16* CKV = (bf16*)(a->ws + WS_CKV); bf16* KR = (bf16*)(a->ws + WS_KR);
    const float* qn = a->in[I_QNORM]; const float* kvn = a->in[I_KVNORM];
    for (int row = gw; row < T; row += NGW) {
        const bf16* pr = P + (size_t)row * OD_INP;
        { float v[8]; float ss = 0.f; const bf16x8 x = ld_bf16x8(pr + PO_QL + 8 * lane);
#pragma unroll
          for (int i = 0; i < 8; ++i) { v[i] = bf2f((bf16)x[i]); ss += v[i] * v[i]; }
          const float rstd = rsqrtf(wave_sum(ss) * (1.0f / 512.0f) + 1e-6f); u32x4 o;
          o.x = pk2(v[0] * rstd * qn[8 * lane + 0], v[1] * rstd * qn[8 * lane + 1]); o.y = pk2(v[2] * rstd * qn[8 * lane + 2], v[3] * rstd * qn[8 * lane + 3]);
          o.z = pk2(v[4] * rstd * qn[8 * lane + 4], v[5] * rstd * qn[8 * lane + 5]); o.w = pk2(v[6] * rstd * qn[8 * lane + 6], v[7] * rstd * qn[8 * lane + 7]);
          *(u32x4*)(QN + (size_t)row * 512 + 8 * lane) = o; }
        { float v[4]; float ss = 0.f; const bf16x4 x = *(const bf16x4*)(pr + PO_KVL + 4 * lane);
#pragma unroll
          for (int i = 0; i < 4; ++i) { v[i] = bf2f((bf16)x[i]); ss += v[i] * v[i]; }
          const float rstd = rsqrtf(wave_sum(ss) * (1.0f / 256.0f) + 1e-6f);
#pragma unroll
          for (int i = 0; i < 4; ++i) v[i] = v[i] * rstd * kvn[4 * lane + i];
          u32x2 o; o.x = pk2(v[0], v[1]); o.y = pk2(v[2], v[3]); *(u32x2*)(CKV + (size_t)row * 256 + 4 * lane) = o;
          if (row < TP) *(f32x4*)(a->out + OUT_CKV + (size_t)row * 256 + 4 * lane) = (f32x4){v[0], v[1], v[2], v[3]}; }
        { const float x = bf2f(pr[PO_KRP + lane]);
          if (row < TP) { KR[(size_t)row * 64 + lane] = pr[PO_KRP + lane]; a->out[OUT_KR + (size_t)row * 64 + lane] = x; }
          else { const int pos = (row - TP) % L_S, half = lane >> 5, dd = lane & 15, hi = (lane >> 4) & 1;
              const float inv = exp2f(-(float)dd * (13.287712379549449f / 16.0f)); const float ang = (float)(half ? (pos % 64) : (pos / 64)) * inv; const float cs = fast_cos(ang), sn = fast_sin(ang);
              const float other = __shfl_xor(x, 16);
              const float y = hi ? (x * cs + other * sn) : (x * cs - other * sn);
              KR[(size_t)row * 64 + lane] = (bf16)f2bf(y); } }
    }
    const size_t gt = (size_t)bid * NTHR + tid_l(), NGT = (size_t)G * NTHR;
    { const float* s = a->in[I_CCKV]; bf16* d = (bf16*)(a->ws + WS_CKV) + (size_t)T * 256; const size_t n = (size_t)CTX * 256 / 4;
      for (size_t i = gt; i < n; i += NGT) { const f32x4 v = *(const f32x4*)(s + 4 * i); u32x2 o; o.x = pk2(v[0], v[1]); o.y = pk2(v[2], v[3]); *(u32x2*)(d + 4 * i) = o; } }
    { const float* s = a->in[I_CKR]; bf16* d = (bf16*)(a->ws + WS_KR) + (size_t)T * 64; const size_t n = (size_t)CTX * 64 / 4;
      for (size_t i = gt; i < n; i += NGT) { const f32x4 v = *(const f32x4*)(s + 4 * i); u32x2 o; o.x = pk2(v[0], v[1]); o.y = pk2(v[2], v[3]); *(u32x2*)(d + 4 * i) = o; } }
}

constexpr int HG_QD = 0, HG_KD = HG_QD + 64 * 136 * 2, HG_KT = HG_KD + 64 * 136 * 2, HG_VT = HG_KT + 128 * 72 * 2, HG_AL = HG_VT + 128 * 72 * 2, HG_ST = HG_AL + 64 * 72 * 2,
              HG_TOT = HG_ST + 128 * 136 * 2, HG_BEND = HG_TOT + 8 * 128 * 4, HG_END = HG_BEND + 128 * 4;
static_assert(HG_END <= RING_BYTES, "HGRN LDS");
DEV void hgrn_load(const bf16* P, int seq0, int L, int dir, int n, int cg, int colf, int colq, int colv, unsigned (&rf)[8], unsigned (&rq)[8], unsigned (&rv)[8]) {
#pragma unroll
    for (int i = 0; i < 8; ++i) { const int cpos = 64 * n + 8 * cg + i; const int tok = seq0 + (dir ? (L - 1 - cpos) : cpos); const bf16* p = P + (size_t)tok * OD_INP;
        rf[i] = *(const unsigned*)(p + colf); rq[i] = *(const unsigned*)(p + colq); rv[i] = *(const unsigned*)(p + colv); }
}
DEV void hgrn_item(KArgs a, LAS unsigned char* lds, int seq0, int L, int h, int dir, const float* S0  , float* Sout  ) {
    const int tid = tid_l(), lane = tid & 63, wave = tid >> 6, q = lane >> 4, r = lane & 15;
    LAS bf16* qd = (LAS bf16*)(lds + HG_QD); LAS bf16* kd = (LAS bf16*)(lds + HG_KD); LAS bf16* kT = (LAS bf16*)(lds + HG_KT); LAS bf16* vT = (LAS bf16*)(lds + HG_VT);
    LAS bf16* aL = (LAS bf16*)(lds + HG_AL); LAS bf16* sT = (LAS bf16*)(lds + HG_ST); LAS float* tot = (LAS float*)(lds + HG_TOT); LAS float* bend = (LAS float*)(lds + HG_BEND);
    const bf16* P = (const bf16*)(a->ws + WS_P); _Float16* OD = (_Float16*)(a->ws + WS_HFF) + (size_t)dir * T * 1024;
    const int d = 2 * (tid & 63), cg = tid >> 6;
    float lb[2];
#pragma unroll
    for (int y = 0; y < 2; ++y) lb[y] = sigmoid_f(a->in[I_HGLB][(size_t)(1 * 2 + dir) * 1024 + h * 128 + d + y] - a->in[I_HGLB][(size_t)(0 * 2 + dir) * 1024 + h * 128 + d + y]);
    const int colf = (dir ? PO_FB : PO_FF) + h * 128 + d, colq = PO_QH + h * 128 + d, colv = PO_IH + h * 128 + d;
    f32x4 S[8];
#pragma unroll
    for (int dvt = 0; dvt < 8; ++dvt) S[dvt] = (f32x4){0.f, 0.f, 0.f, 0.f};
    if (S0) {
#pragma unroll
        for (int dvt = 0; dvt < 8; ++dvt)
#pragma unroll
            for (int x = 0; x < 4; ++x) S[dvt][x] = S0[(size_t)(16 * wave + 4 * q + x) * 128 + 16 * dvt + r]; }
#pragma unroll
    for (int dvt = 0; dvt < 8; ++dvt) {
        u32x2 w; w.x = pk2(S[dvt][0], S[dvt][1]); w.y = pk2(S[dvt][2], S[dvt][3]); *(LAS u32x2*)(sT + (16 * dvt + r) * 136 + 16 * wave + 4 * q) = w; }
    const int nch = L / 64;
    unsigned rf[8], rq[8], rv[8];
    hgrn_load(P, seq0, L, dir, 0, cg, colf, colq, colv, rf, rq, rv);
    f16x4 opend[4]; _Float16* opend_p = OD;
#pragma unroll
    for (int x = 0; x < 4; ++x) opend[x] = (f16x4){0, 0, 0, 0};
    for (int n = 0; n < nch; ++n) {
        if (n > 0) {
#pragma unroll
            for (int x = 0; x < 4; ++x) __builtin_nontemporal_store(opend[x], (f16x4*)(opend_p + 16 * x)); }
        unsigned nf[8], nq[8], nv[8];
        if (n + 1 < nch) hgrn_load(P, seq0, L, dir, n + 1, cg, colf, colq, colv, nf, nq, nv);
        float lf[2][8], kk[2][8], run[2] = {0.f, 0.f};
#pragma unroll
        for (int i = 0; i < 8; ++i)
#pragma unroll
            for (int y = 0; y < 2; ++y) { const float fz = y ? __uint_as_float(rf[i] & 0xffff0000u) : __uint_as_float(rf[i] << 16); const float f = lb[y] + (1.0f - lb[y]) * sigmoid_f(fz);
                kk[y][i] = 1.0f - f; run[y] += __logf(f); lf[y][i] = run[y]; }
        *(LAS f32x2*)(tot + cg * 128 + d) = (f32x2){run[0], run[1]};
        lds_barrier();
        float base[2] = {0.f, 0.f}, be[2] = {0.f, 0.f};
#pragma unroll
        for (int x = 0; x < 8; ++x) { const f32x2 tv = *(const LAS f32x2*)(tot + x * 128 + d); if (x < cg) { base[0] += tv[0]; base[1] += tv[1]; } be[0] += tv[0]; be[1] += tv[1]; }
        const float bendv[2] = {__expf(be[0]), __expf(be[1])};
        if (cg == 0) *(LAS f32x2*)(bend + d) = (f32x2){bendv[0], bendv[1]};
        { float kef[2][8]; unsigned kev[2][4], vv[2][4];
#pragma unroll
          for (int i = 0; i < 8; ++i) { float qdf[2], kdf[2];
#pragma unroll
              for (int y = 0; y < 2; ++y) { const float b = base[y] + lf[y][i]; const float qv = silu_f(y ? __uint_as_float(rq[i] & 0xffff0000u) : __uint_as_float(rq[i] << 16));
                  const float eb = __expf(b), enb = __expf(-b); qdf[y] = qv * eb; kdf[y] = kk[y][i] * enb; kef[y][i] = kk[y][i] * (bendv[y] * enb); }
              *(LAS unsigned*)(qd + (8 * cg + i) * 136 + d) = pk2(qdf[0], qdf[1]); *(LAS unsigned*)(kd + (8 * cg + i) * 136 + d) = pk2(kdf[0], kdf[1]); }
#pragma unroll
          for (int y = 0; y < 2; ++y)
#pragma unroll
              for (int i2 = 0; i2 < 4; ++i2) { kev[y][i2] = pk2(kef[y][2 * i2], kef[y][2 * i2 + 1]);
                  vv[y][i2] = y ? ((rv[2 * i2] >> 16) | (rv[2 * i2 + 1] & 0xffff0000u)) : ((rv[2 * i2] & 0xffffu) | (rv[2 * i2 + 1] << 16)); }
#pragma unroll
          for (int y = 0; y < 2; ++y) { *(LAS u32x4*)(kT + (d + y) * 72 + 8 * cg) = (u32x4){kev[y][0], kev[y][1], kev[y][2], kev[y][3]}; *(LAS u32x4*)(vT + (d + y) * 72 + 8 * cg) = (u32x4){vv[y][0], vv[y][1], vv[y][2], vv[y][3]}; } }
        lds_barrier();
        { const int ct = wave & 3, sp = wave >> 2;
#pragma unroll
          for (int x = 0; x < 2; ++x) { const int st = 2 * sp + x; f32x4 acc = (f32x4){0.f, 0.f, 0.f, 0.f};
#pragma unroll
              for (int ks = 0; ks < 4; ++ks) acc = mfma16(*(const LAS bf16x8*)(kd + (16 * st + r) * 136 + 32 * ks + 8 * q), *(const LAS bf16x8*)(qd + (16 * ct + r) * 136 + 32 * ks + 8 * q), acc);
              const int cc = 16 * ct + r, s0 = 16 * st + 4 * q; float v[4];
#pragma unroll
              for (int y = 0; y < 4; ++y) v[y] = (s0 + y <= cc) ? acc[y] : 0.f;
              u32x2 w; w.x = pk2(v[0], v[1]); w.y = pk2(v[2], v[3]); *(LAS u32x2*)(aL + cc * 72 + s0) = w; } }
        lds_barrier();
        { const int ct = wave & 3, dv0 = 4 * (wave >> 2);
          bf16x8 Ba[2], Bq[4];
#pragma unroll
          for (int kx = 0; kx < 2; ++kx) Ba[kx] = *(const LAS bf16x8*)(aL + (16 * ct + r) * 72 + 32 * kx + 8 * q);
#pragma unroll
          for (int ks = 0; ks < 4; ++ks) Bq[ks] = *(const LAS bf16x8*)(qd + (16 * ct + r) * 136 + 32 * ks + 8 * q);
          const int cpos = 64 * n + 16 * ct + r; const int tok = seq0 + (dir ? (L - 1 - cpos) : cpos);
#pragma unroll
          for (int x = 0; x < 4; ++x) { const int dvt = dv0 + x; f32x4 acc = (f32x4){0.f, 0.f, 0.f, 0.f};
#pragma unroll
              for (int kx = 0; kx < 2; ++kx) acc = mfma16(*(const LAS bf16x8*)(vT + (16 * dvt + r) * 72 + 32 * kx + 8 * q), Ba[kx], acc);
#pragma unroll
              for (int ks = 0; ks < 4; ++ks) acc = mfma16(*(const LAS bf16x8*)(sT + (16 * dvt + r) * 136 + 32 * ks + 8 * q), Bq[ks], acc);
              opend[x] = __builtin_convertvector(acc, f16x4); }
          opend_p = OD + (size_t)tok * 1024 + h * 128 + 16 * dv0 + 4 * q; }
        { bf16x8 Ak[2];
#pragma unroll
          for (int kx = 0; kx < 2; ++kx) Ak[kx] = *(const LAS bf16x8*)(kT + (16 * wave + r) * 72 + 32 * kx + 8 * q);
          const f32x4 dec = *(const LAS f32x4*)(bend + 16 * wave + 4 * q);
#pragma unroll
          for (int dvt = 0; dvt < 8; ++dvt) { f32x4 acc = S[dvt] * dec;
#pragma unroll
              for (int kx = 0; kx < 2; ++kx) acc = mfma16(Ak[kx], *(const LAS bf16x8*)(vT + (16 * dvt + r) * 72 + 32 * kx + 8 * q), acc);
              S[dvt] = acc; } }
        lds_barrier();
#pragma unroll
        for (int dvt = 0; dvt < 8; ++dvt) { u32x2 w; w.x = pk2(S[dvt][0], S[dvt][1]); w.y = pk2(S[dvt][2], S[dvt][3]); *(LAS u32x2*)(sT + (16 * dvt + r) * 136 + 16 * wave + 4 * q) = w; }
#pragma unroll
        for (int i = 0; i < 8; ++i) { rf[i] = nf[i]; rq[i] = nq[i]; rv[i] = nv[i]; }
    }
#pragma unroll
    for (int x = 0; x < 4; ++x) __builtin_nontemporal_store(opend[x], (f16x4*)(opend_p + 16 * x));
    if (Sout) {
#pragma unroll
        for (int dvt = 0; dvt < 8; ++dvt)
#pragma unroll
            for (int x = 0; x < 4; ++x) Sout[(size_t)(16 * wave + 4 * q + x) * 128 + 16 * dvt + r] = S[dvt][x];
    }
    __syncthreads();
}
DEV void hgrn_run(KArgs a, LAS unsigned char* lds, int item) {
    constexpr int NSI = NB_S * 8 * 2;
    const bool smp = item < NSI; const int i2 = smp ? item : item - NSI; const int dir = i2 & 1, h = (i2 >> 1) & 7, b = i2 >> 4;
    if (smp) hgrn_item(a, lds, TP + b * L_S, L_S, h, dir, a->in[I_ST] + ((size_t)(b * 2 + dir) * 8 + h) * 16384, nullptr);
    else hgrn_item(a, lds, b * L_P, L_P, h, dir, nullptr, a->out + OUT_ST + ((size_t)(b * 2 + dir) * 8 + h) * 16384);
}
DEV void phase_hgrn(KArgs a, LAS unsigned char* lds, int bid, int G) {
    constexpr int NSI = NB_S * 8 * 2, NPI = NB_P * 8 * 2;
    if (G > NSI) {
        const int nps = 0;
        if (bid < NSI) { hgrn_run(a, lds, bid); if (bid < nps) hgrn_run(a, lds, NSI + bid); }
        else for (int j = nps + bid - NSI; j < NPI; j += G - NSI) hgrn_run(a, lds, NSI + j);
    } else for (int it = bid; it < NSI + NPI; it += G) hgrn_run(a, lds, it);
}
DEV void phase_hgrn_combine(KArgs a, int bid, int G, int nheavy) {
    constexpr int WL = 4;
    const int lane = tid_l() & 63, wv = tid_l() >> 6, NV = NWAVES * (nheavy + (G - nheavy) * WL);
    const bool heavy = bid < nheavy; const int nvid = heavy ? 1 : WL, vid0 = heavy ? bid * NWAVES + wv : nheavy * NWAVES + ((bid - nheavy) * NWAVES + wv) * WL;
    const _Float16* O0 = (const _Float16*)(a->ws + WS_HFF); const _Float16* O1 = O0 + (size_t)T * 1024; const bf16* P = (const bf16*)(a->ws + WS_P); bf16* MIX = (bf16*)(a->ws + WS_MIX);
    const float* hn = a->in[I_HGNORM];
    for (int vj = 0; vj < nvid; ++vj)
    for (int row = vid0 + vj; row < T; row += NV) {
        const int e0 = 16 * lane; float v[16]; float ss = 0.f;
#pragma unroll
        for (int k = 0; k < 4; ++k) { const f32x4 x = __builtin_convertvector(__builtin_nontemporal_load((const f16x4*)(O0 + (size_t)row * 1024 + e0 + 4 * k)), f32x4) + __builtin_convertvector(__builtin_nontemporal_load((const f16x4*)(O1 + (size_t)row * 1024 + e0 + 4 * k)), f32x4);
#pragma unroll
            for (int i = 0; i < 4; ++i) { v[4 * k + i] = x[i]; ss += x[i] * x[i]; } }
        ss += __shfl_xor(ss, 1); ss += __shfl_xor(ss, 2); ss += __shfl_xor(ss, 4);
        const float rstd = rsqrtf(ss * (1.0f / 128.0f) + 1e-6f);
        const bf16x8 g0 = ld_bf16x8(P + (size_t)row * OD_INP + PO_GH + e0), g1 = ld_bf16x8(P + (size_t)row * OD_INP + PO_GH + e0 + 8);
        float o[16];
#pragma unroll
        for (int i = 0; i < 16; ++i) { const float gz = bf2f((bf16)(i < 8 ? g0[i] : g1[i - 8])); o[i] = v[i] * rstd * hn[(e0 + i) & 127] * silu_f(gz); }
        u32x4 w0, w1; w0.x = pk2(o[0], o[1]); w0.y = pk2(o[2], o[3]); w0.z = pk2(o[4], o[5]); w0.w = pk2(o[6], o[7]); w1.x = pk2(o[8], o[9]); w1.y = pk2(o[10], o[11]); w1.z = pk2(o[12], o[13]); w1.w = pk2(o[14], o[15]);
        *(u32x4*)(MIX + (size_t)row * D + e0) = w0; *(u32x4*)(MIX + (size_t)row * D + e0 + 8) = w1;
    }
}
DEV void phase_attn_mla(KArgs a, int bid, int G) {
    const int lane = tid_l() & 63, gw = bid * NWAVES + (tid_l() >> 6), NGW = G * NWAVES, r = lane & 15, q = lane >> 4;
    const bf16* QM = (const bf16*)(a->ws + WS_QM); const bf16* KN = (const bf16*)(a->ws + WS_KN); const bf16* KRb = (const bf16*)(a->ws + WS_KR); const bf16* VTM = (const bf16*)(a->ws + WS_VTM);
    bf16* MIX = (bf16*)(a->ws + WS_MIX);
    constexpr int NQS = L_S / 16, NQP = L_P / 16, NI_S = NB_S * 8 * NQS, NI_P = NB_P * 8 * NQP;
    const float sc = 0.07216878364870323f * LOG2E;
    for (int it = gw; it < NI_S + NI_P; it += NGW) {
        const bool smp = it < NI_S; const int i2 = smp ? it : it - NI_S; const int NQ = smp ? NQS : NQP, h = i2 & 7, qt = (i2 >> 3) % NQ, b = (i2 >> 3) / NQ;
        const int seq0 = smp ? TP + b * L_S : b * L_P, q0 = 16 * qt;
        const bf16* qrow = QM + (size_t)(seq0 + q0 + r) * 1536 + h * 192;
        bf16x8 Q[6];
#pragma unroll
        for (int ks = 0; ks < 4; ++ks) Q[ks] = ld_bf16x8(qrow + 32 * ks + 8 * q);
#pragma unroll
        for (int ks = 4; ks < 6; ++ks) { const bf16x8 own = ld_bf16x8(qrow + 32 * ks + 8 * q);
            if (smp) { const bf16x8 oth = ld_bf16x8(qrow + 32 * ks + 8 * (q ^ 2)); const int pos = q0 + r; const float pp = (float)(ks == 4 ? (pos / 64) : (pos % 64)); bf16x8 o;
#pragma unroll
                for (int j = 0; j < 8; ++j) { const int dd = (8 * q + j) & 15; const float inv = exp2f(-(float)dd * (13.287712379549449f / 16.0f)); const float ang = pp * inv, cs = fast_cos(ang), sn = fast_sin(ang);
                    const float x = bf2f((bf16)own[j]), y = bf2f((bf16)oth[j]); o[j] = (short)f2bf((q & 2) ? (x * cs + y * sn) : (x * cs - y * sn)); }
                Q[ks] = o; }
            else Q[ks] = own; }
        float m = -1e30f, lsum = 0.f; f32x4 o[8];
#pragma unroll
        for (int dt = 0; dt < 8; ++dt) o[dt] = (f32x4){0.f, 0.f, 0.f, 0.f};
        attn_segment<6, false>(m, lsum, o, Q, KN + (size_t)seq0 * 1024 + h * 128, 1024, KRb + (size_t)seq0 * 64, VTM + (size_t)(h * 128) * TK + seq0, TK, 0, smp ? L_S : L_P, 0, sc, r, q);
        if (smp) { const int c0 = T + b * PAST; attn_segment<6, false>(m, lsum, o, Q, KN + (size_t)c0 * 1024 + h * 128, 1024, KRb + (size_t)c0 * 64, VTM + (size_t)(h * 128) * TK + c0, TK, 0, PAST, 0, sc, r, q); }
        attn_store(o, lsum, MIX + (size_t)(seq0 + q0 + r) * D + 1024 + h * 128, q);
    }
}
DEV void phase_attn_even2(KArgs a, LAS unsigned char* lds, int bid, int G) {
    constexpr int QT = 2, PPB = 2 * 16 * QT;
    const int tid = tid_l(), lane = tid & 63, wave = tid >> 6, r = lane & 15, q = lane >> 4;
    const bf16* QKV = (const bf16*)(a->ws + WS_QKV); const bf16* VTE = (const bf16*)(a->ws + WS_VTE); const bf16* KC = (const bf16*)(a->ws + WS_KC); const bf16* VTC = (const bf16*)(a->ws + WS_VTC);
    bf16* MIX = (bf16*)(a->ws + WS_MIX); const float* sink = a->in[I_SINK];
    constexpr int NBS = L_S / PPB, NBP = L_P / PPB, NI_S = NB_S * 2 * NBS, NI_P = NB_P * 2 * NBP;
    const float sc = 0.08838834764831845f * LOG2E;
    for (int it = bid; it < NI_S + NI_P; it += G) {
        const bool smp = it < NI_S; const int i2 = smp ? it : it - NI_S; const int NBq = smp ? NBS : NBP, qb = i2 % NBq, kvh = (i2 / NBq) & 1, b = (i2 / NBq) >> 1;
        const int g = wave & 3, pg = wave >> 2, head = kvh * 4 + g, seq0 = smp ? TP + b * L_S : b * L_P, L = smp ? L_S : L_P, qw0 = qb * PPB + pg * 16 * QT;
        bf16x8 Q[QT][4];
#pragma unroll
        for (int qi = 0; qi < QT; ++qi) { const bf16* qrow = QKV + (size_t)(seq0 + qw0 + 16 * qi + r) * NQKV + head * 128 + 8 * q;
#pragma unroll
            for (int ks = 0; ks < 4; ++ks) Q[qi][ks] = ld_bf16x8(qrow + 32 * ks); }
        AttnSeg s0, s1;
        s0.K = QKV + (size_t)seq0 * NQKV + 1024 + kvh * 128; s0.KR = nullptr; s0.VT = VTE + (size_t)(kvh * 128) * T + seq0; s0.ldk = NQKV; s0.ldvt = T;
        if (smp) { int k0 = qb * PPB - 128; if (k0 < 0) k0 = 0; k0 &= ~31; int k1 = (qb * PPB + PPB + 128 + 31) & ~31; if (k1 > L) k1 = L; s0.kt0 = k0; s0.ntiles = (k1 - k0) / 32;
            s1.K = KC + (size_t)((b * 2 + kvh) * PAST) * 128; s1.KR = nullptr; s1.VT = VTC + (size_t)((b * 2 + kvh) * 128) * PAST; s1.ldk = 128; s1.ldvt = PAST; s1.ntiles = PAST / 32; s1.kt0 = 0; }
        else { s0.kt0 = 0; s0.ntiles = L / 32; s1 = s0; s1.ntiles = 0; }
        attn_block<128, QT>(lds, s0, s1, Q, sink[head] * LOG2E, 1.0f, true, smp, qw0, sc, MIX + (size_t)(seq0 + qw0) * D + 1024 + head * 128, tid);
    }
}
DEV void phase_attn_mla2(KArgs a, LAS unsigned char* lds, int bid, int G) {
    constexpr int QT = 2, RPB = 8 * 16 * QT;
    const int tid = tid_l(), lane = tid & 63, wave = tid >> 6, r = lane & 15, q = lane >> 4;
    const bf16* QM = (const bf16*)(a->ws + WS_QM); const bf16* KN = (const bf16*)(a->ws + WS_KN); const bf16* KRb = (const bf16*)(a->ws + WS_KR); const bf16* VTM = (const bf16*)(a->ws + WS_VTM);
    bf16* MIX = (bf16*)(a->ws + WS_MIX);
    constexpr int NBS = (L_S + RPB - 1) / RPB, NBP = (L_P + RPB - 1) / RPB, NI_S = NB_S * 8 * NBS, NI_P = NB_P * 8 * NBP;
    const float sc = 0.07216878364870323f * LOG2E;
    for (int it = bid; it < NI_S + NI_P; it += G) {
        const bool smp = it < NI_S; const int i2 = smp ? it : it - NI_S; const int NBq = smp ? NBS : NBP, qb = i2 % NBq, h = (i2 / NBq) & 7, b = (i2 / NBq) >> 3;
        const int seq0 = smp ? TP + b * L_S : b * L_P, L = smp ? L_S : L_P, qw0 = qb * RPB + wave * 16 * QT; const bool active = qw0 < L;
        bf16x8 Q[QT][6];
#pragma unroll
        for (int qi = 0; qi < QT; ++qi) { const int pos = active ? qw0 + 16 * qi + r : r; const bf16* qrow = QM + (size_t)(seq0 + pos) * 1536 + h * 192;
#pragma unroll
            for (int ks = 0; ks < 4; ++ks) Q[qi][ks] = ld_bf16x8(qrow + 32 * ks + 8 * q);
#pragma unroll
            for (int ks = 4; ks < 6; ++ks) { const bf16x8 own = ld_bf16x8(qrow + 32 * ks + 8 * q);
                if (smp) { const bf16x8 oth = ld_bf16x8(qrow + 32 * ks + 8 * (q ^ 2)); const float pp = (float)(ks == 4 ? (pos / 64) : (pos % 64)); bf16x8 o;
#pragma unroll
                    for (int j = 0; j < 8; ++j) { const int dd = (8 * q + j) & 15; const float inv = exp2f(-(float)dd * (13.287712379549449f / 16.0f)); const float ang = pp * inv, cs = fast_cos(ang), sn = fast_sin(ang);
                        const float x = bf2f((bf16)own[j]), y = bf2f((bf16)oth[j]); o[j] = (short)f2bf((q & 2) ? (x * cs + y * sn) : (x * cs - y * sn)); }
                    Q[qi][ks] = o; }
                else Q[qi][ks] = own; } }
        AttnSeg s0, s1;
        s0.K = KN + (size_t)seq0 * 1024 + h * 128; s0.KR = KRb + (size_t)seq0 * 64; s0.VT = VTM + (size_t)(h * 128) * TK + seq0; s0.ldk = 1024; s0.ldvt = TK; s0.kt0 = 0; s0.ntiles = L / 32;
        s1 = s0; s1.ntiles = 0;
        if (smp) { const int c0 = T + b * PAST; s1.K = KN + (size_t)c0 * 1024 + h * 128; s1.KR = KRb + (size_t)c0 * 64; s1.VT = VTM + (size_t)(h * 128) * TK + c0; s1.ntiles = PAST / 32; }
        attn_block<192, QT>(lds, s0, s1, Q, -1e30f, 0.0f, active, false, qw0, sc, MIX + (size_t)(seq0 + (active ? qw0 : 0)) * D + 1024 + h * 128, tid);
    }
}
#ifndef EMU
#define XB_TMO      128
#define XB_XCNT(j)  (256  + 64 * (j))
#define XB_XSUB(j)  (1280 + 64 * (j))
#define XB_XGEN(j)  (2304 + 64 * (j))
#define XB_TOP      3328
#define XB_TOPGEN   3392
#define XCD_BAR_WORDS 3456
#define XB_SPIN_CAP (1u << 18)
__device__ __forceinline__ unsigned xb_ld(unsigned* p)              { return __hip_atomic_load(p, __ATOMIC_RELAXED, __HIP_MEMORY_SCOPE_AGENT); }
__device__ __forceinline__ unsigned xb_add(unsigned* p, unsigned v) { return __hip_atomic_fetch_add(p, v, __ATOMIC_RELAXED, __HIP_MEMORY_SCOPE_AGENT); }
__device__ __forceinline__ unsigned xb_xcc_id() { return (unsigned)__builtin_amdgcn_s_getreg((3 << 11) | 20) & 0xFu; }
#define XB_SPIN(cond, bar) do { unsigned _sp = 0; while (cond) { __builtin_amdgcn_s_sleep(1); \
    if ((++_sp & 255u) == 0u) { if (xb_ld(&(bar)[XB_TMO])) break; if (_sp > XB_SPIN_CAP) { atomicAdd(&(bar)[XB_TMO], 1u); break; } } } } while (0)
struct XcdBarrier { unsigned* bar; unsigned x; volatile LAS unsigned* st; };
__device__ __forceinline__ XcdBarrier xcd_barrier_post(unsigned* bar, volatile LAS unsigned* st) {
    XcdBarrier b; b.bar = bar; b.x = xb_xcc_id(); b.st = st;
    if (threadIdx.x == 0) (void)xb_add(&bar[XB_XCNT(b.x)], 1u);
    return b;
}
__device__ __forceinline__ void xcd_barrier_complete(unsigned* bar, unsigned x, unsigned& nloc, unsigned& nx) {
    const unsigned G = gridDim.x * gridDim.y * gridDim.z;
    unsigned sum, cnt, mine, sp = 0u;
    for (;;) {
        sum = 0u; cnt = 0u; mine = 0u;
#pragma unroll
        for (unsigned j = 0; j < 16; ++j) { const unsigned c = xb_ld(&bar[XB_XCNT(j)]); sum += c; cnt += (c > 0u) ? 1u : 0u; mine = (j == x) ? c : mine; }
        if (sum == G) break;
        __builtin_amdgcn_s_sleep(1);
        if ((++sp & 255u) == 0u) { if (xb_ld(&bar[XB_TMO])) break; if (sp > XB_SPIN_CAP) { atomicAdd(&bar[XB_TMO], 1u); break; } }
    }
    nloc = mine > 0u ? mine : 1u; nx = cnt > 0u ? cnt : 1u;
}
__device__ __forceinline__ void xcd_barrier(const XcdBarrier& b) {
    asm volatile("s_waitcnt vmcnt(0)" ::: "memory");
    __syncthreads();
    if (threadIdx.x == 0) {
        unsigned* bar = b.bar;
        __builtin_amdgcn_s_waitcnt(0);
        unsigned nloc = b.st[0], nx = b.st[1];
        if (nloc == 0u) { xcd_barrier_complete(bar, b.x, nloc, nx); b.st[0] = nloc; b.st[1] = nx; }
        const unsigned old = xb_add(&bar[XB_XSUB(b.x)], 1u);
        const unsigned gen = old / nloc;
        if (old + 1u == (gen + 1u) * nloc) {
            __builtin_amdgcn_fence(__ATOMIC_RELEASE, "agent");
            asm volatile("s_waitcnt vmcnt(0)" ::: "memory");
            const unsigned og = xb_add(&bar[XB_TOP], 1u);
            const unsigned tg = og / nx;
            if (og + 1u == (tg + 1u) * nx) xb_add(&bar[XB_TOPGEN], 1u);
            else XB_SPIN(xb_ld(&bar[XB_TOPGEN]) == tg, bar);
            __builtin_amdgcn_fence(__ATOMIC_ACQUIRE, "agent");
            xb_add(&bar[XB_XGEN(b.x)], 1u);
            asm volatile("s_waitcnt vmcnt(0)" ::: "memory");
        } else {
            XB_SPIN(xb_ld(&bar[XB_XGEN(b.x)]) == gen, bar);
            __builtin_amdgcn_fence(__ATOMIC_ACQUIRE, "agent");
            asm volatile("s_waitcnt vmcnt(0)" ::: "memory");
        }
    }
    __syncthreads();
}
#endif

constexpr int N_PHASES = 3 + 2 * 12;
constexpr int CW_BAR = 4096;
#ifdef EMU
struct XcdBarrier { int dummy; };
DEV void xcd_barrier(const XcdBarrier&) {}
#endif
#ifndef REP_MASK
#define REP_MASK 0ull
#endif
#ifdef EMU
DEV int launder_s(int x) { return x; }
#else
DEV int launder_s(int x) { asm volatile("" : "+s"(x)); return x; }
#endif
#define INP(k) (LO <= (k) && (k) < HI)
#define WSV unsigned char* ws = a->ws; bf16* HN = (bf16*)(ws + WS_HN); bf16* HFF = (bf16*)(ws + WS_HFF); float* OUT0 = (float*)(ws + WS_OUT); float* OUT1 = OUT0 + (size_t)T * D; bf16* MIX = (bf16*)(ws + WS_MIX); (void)HN; (void)HFF; (void)OUT0; (void)OUT1; (void)MIX;
#define PHASE(k, ...) do { if constexpr (INP(k)) { { KArgs a = kargs(); const int bid = launder_s(bid0), G = launder_s(G0); WSV __VA_ARGS__ } if constexpr (((REP_MASK) >> (k)) & 1ull) { xcd_barrier(bar); { KArgs a = kargs(); const int bid = launder_s(bid0), G = launder_s(G0); WSV __VA_ARGS__ } } } } while (0)
#define SEAMP(k) do { if constexpr (INP(k) && INP((k) + 1)) xcd_barrier(bar); } while (0)
template <int LO, int HI, int l, int s>
DEV void ffn_phases(LAS unsigned char* lds, int bid0, int G0, const XcdBarrier& bar) {
    constexpr int p0 = 3 + 12 * l + 9 * s;
    PHASE(p0,
        constexpr int units = (T / 256) * (2 * DFF / 256); constexpr bool hasconv = (p0 == 3 || p0 == 12 || p0 == 15);
        const int Gg = hasconv ? gemm_groups(units, G) : G;
        if (bid < Gg) {
            pg8::Gemm g{D, D, D}; pg8::MultiOrder S; constexpr int ns_ = 1, lda_ = D, ldb_ = D;
            const pg8::SubG g0_ = pg8::SubG{HN, (const bf16*)(ws + WS_WGU + (size_t)(l * 2 + s) * SZ_WGU1), T / 256, 2 * DFF / 256}; S.init(g0_, g0_, g0_, ns_, Gg, bid, lda_, ldb_);
            pg8::EpiSwiGLU E{HFF, DFF};
            pg8::gemm_phase<pg8::EpiSwiGLU, pg8::MultiOrder, true, true>(lds, g, S, E);
        }
        if constexpr (hasconv) { if (Gg == G) conv_work<p0>(a, lds, bid, G); else if (bid >= Gg) conv_work<p0>(a, lds, bid - Gg, G - Gg); }
    ); SEAMP(p0);
    PHASE(p0 + 1,
        constexpr int KH = DFF / 2; pg8::Gemm g{KH, DFF, DFF}; pg8::MultiOrder S; constexpr int ns_ = 2, lda_ = DFF, ldb_ = DFF;
        const bf16* wd = (const bf16*)(ws + WS_WD + (size_t)(l * 2 + s) * SZ_WD1);
        const pg8::SubG g0_ = pg8::SubG{HFF, wd, T / 256, D / 256}, g1_ = pg8::SubG{HFF + KH, wd + KH, T / 256, D / 256}; S.init(g0_, g1_, g0_, ns_, G, bid, lda_, ldb_);
        const pg8::EpiBf16M E = pg8::EpiBf16M::make((bf16*)OUT0, (bf16*)OUT0 + (size_t)T * D, nullptr, D, D, 0);
        pg8::gemm_phase<pg8::EpiBf16M, pg8::MultiOrder, true, true>(lds, g, S, E);
    ); SEAMP(p0 + 1);
    PHASE(p0 + 2,
        constexpr int j = 2 * s; constexpr bool first = (l == 0 && s == 0), last = (l == 1 && s == 1);
        constexpr int nl = (s == 0) ? l : (l == 0 ? 1 : -1), nj = (s == 0) ? 1 : 0;
        phase_residual(a, lds, bid, G, l, j, 0.5f, nl, nj, first, last);
    ); SEAMP(p0 + 2);
}
template <int LO, int HI, int l>
DEV void outproj_phases(LAS unsigned char* lds, int bid0, int G0, const XcdBarrier& bar) {
    constexpr int pb = 3 + 12 * l;
    PHASE(pb + 7,
        pg8::Gemm g{1024, D, D}; pg8::MultiOrder S; constexpr int ns_ = 2, lda_ = D, ldb_ = D;
        const bf16* wo = (const bf16*)(ws + (l == 0 ? WS_WEVOUT : WS_WODOUT));
        const pg8::SubG g0_ = pg8::SubG{MIX, wo, T / 256, D / 256}, g1_ = pg8::SubG{MIX + 1024, wo + 1024, T / 256, D / 256}; S.init(g0_, g1_, g0_, ns_, G, bid, lda_, ldb_);
        const pg8::EpiBf16M E = pg8::EpiBf16M::make((bf16*)OUT0, (bf16*)OUT0 + (size_t)T * D, nullptr, D, D, 0);
        pg8::gemm_phase<pg8::EpiBf16M, pg8::MultiOrder, true, true>(lds, g, S, E);
    ); SEAMP(pb + 7);
    PHASE(pb + 8,  phase_residual(a, lds, bid, G, l, 1, 1.0f, l, 2, false, false); ); SEAMP(pb + 8);
}
template <int LO, int HI>
DEV void even_mixer_phases(LAS unsigned char* lds, int bid0, int G0, const XcdBarrier& bar) {
    constexpr int pb = 3;
    PHASE(pb + 3,
        constexpr int units = (3072 / 256) * (T / 256) + (T / 256) * (NQKV / 256) + (T / 256);
        const int Gg = gemm_groups(units, G);
        if (bid < Gg) {
            const bf16* w = (const bf16*)(ws + WS_WEVIN);
            pg8::Gemm g{D, D, D}; pg8::MultiOrder S; constexpr int ns_ = 3, lda_ = D, ldb_ = D;
            const pg8::SubG g0_ = pg8::SubG{w, HN, 3072 / 256, T / 256}, g1_ = pg8::SubG{HN, w + (size_t)3072 * D, T / 256, NQKV / 256}, g2_ = pg8::SubG{w + (size_t)(3072 + 1280) * D, HN, 1, T / 256}; S.init(g0_, g1_, g2_, ns_, Gg, bid, lda_, ldb_);
            const pg8::EpiBf16M E = pg8::EpiBf16M::make((bf16*)(ws + WS_UT), (bf16*)(ws + WS_QKV), (bf16*)(ws + WS_VTE), T, NQKV, T);
            pg8::gemm_phase<pg8::EpiBf16M, pg8::MultiOrder, true, true>(lds, g, S, E);
        }
        if (Gg == G) conv_work<6>(a, lds, bid, G); else if (bid >= Gg) conv_work<6>(a, lds, bid - Gg, G - Gg);
    ); SEAMP(pb + 3);
    if constexpr (INP(pb + 4)) phase_rope_kvout(kargs(), launder_s(bid0), launder_s(G0));
    PHASE(pb + 4, phase_hyena(a, lds, bid, G); ); SEAMP(pb + 4);
    PHASE(pb + 5,  phase_attn_even2(a, lds, bid, G); phase_ytrans(a, lds, bid, G); );
    if constexpr (INP(pb + 5) && INP(pb + 7)) xcd_barrier(bar);
}
template <int LO, int HI>
DEV void odd_mixer_phases(LAS unsigned char* lds, int bid0, int G0, const XcdBarrier& bar) {
    constexpr int pb = 15;
    PHASE(pb + 3,
        constexpr int units = (T / 256) * (OD_INP / 256); const int Gg = gemm_groups(units, G);
        if (bid < Gg) {
            pg8::Gemm g{D, D, D}; pg8::MultiOrder S; constexpr int ns_ = 1, lda_ = D, ldb_ = D;
            const pg8::SubG g0_ = pg8::SubG{HN, (const bf16*)(ws + WS_WODIN), T / 256, OD_INP / 256}; S.init(g0_, g0_, g0_, ns_, Gg, bid, lda_, ldb_);
            const pg8::EpiBf16M E = pg8::EpiBf16M::make((bf16*)(ws + WS_P), nullptr, nullptr, OD_INP, 0, 0);
            pg8::gemm_phase<pg8::EpiBf16M, pg8::MultiOrder, true, true>(lds, g, S, E);
        }
        if (Gg == G) conv_work<18>(a, lds, bid, G); else if (bid >= Gg) conv_work<18>(a, lds, bid - Gg, G - Gg);
    ); SEAMP(pb + 3);
    PHASE(pb + 4,  phase_mla_prep(a, bid, G); ); SEAMP(pb + 4);
    PHASE(pb + 5,
        constexpr int NSI_ = NB_S * 8 * 2; const bool split = G > NSI_;
        phase_hgrn(a, lds, bid, G);
        if (!split || bid >= NSI_) { const int Gg = split ? G - NSI_ : G, cg = split ? bid - NSI_ : bid;
        { pg8::Gemm g{512, 512, 512}; pg8::MultiOrder S; constexpr int ns_ = 1, lda_ = 512, ldb_ = 512;
          const pg8::SubG g0_ = pg8::SubG{(const bf16*)(ws + WS_QN), (const bf16*)(ws + WS_WQB), T / 256, 1536 / 256}; S.init(g0_, g0_, g0_, ns_, Gg, cg, lda_, ldb_);
          const pg8::EpiBf16M E = pg8::EpiBf16M::make((bf16*)(ws + WS_QM), nullptr, nullptr, 1536, 0, 0);
          pg8::gemm_phase<pg8::EpiBf16M, pg8::MultiOrder, true, true>(lds, g, S, E); }
        { pg8::Gemm g{256, 256, 256}; pg8::MultiOrder S; constexpr int ns_ = 2, lda_ = 256, ldb_ = 256;
          const pg8::SubG g0_ = pg8::SubG{(const bf16*)(ws + WS_CKV), (const bf16*)(ws + WS_WKVK), TK / 256, 4}, g1_ = pg8::SubG{(const bf16*)(ws + WS_WKVV), (const bf16*)(ws + WS_CKV), 4, TK / 256}; S.init(g0_, g1_, g0_, ns_, Gg, cg, lda_, ldb_);
          const pg8::EpiBf16M E = pg8::EpiBf16M::make((bf16*)(ws + WS_KN), (bf16*)(ws + WS_VTM), nullptr, 1024, TK, 0);
          pg8::gemm_phase<pg8::EpiBf16M, pg8::MultiOrder, true, true>(lds, g, S, E); }
        }
    ); SEAMP(pb + 5);
    PHASE(pb + 6,  phase_attn_mla2(a, lds, bid, G); phase_hgrn_combine(a, bid, G, (NB_S * 8 * ((L_S + 255) / 256) + NB_P * 8 * ((L_P + 255) / 256)) % G); ); SEAMP(pb + 6);
}
template <int LO, int HI>
__global__ void __launch_bounds__(NTHR, 2) mk_fwd(Args args) {
#ifdef EMU
    unsigned char* lds = emu_lds_ptr(); XcdBarrier bar{0}; emu_args_p = &args;
#else
    extern __shared__ __attribute__((aligned(16))) unsigned char lds_raw[];
    LAS unsigned char* lds = (LAS unsigned char*)lds_raw;
#endif
        const int bid0 = blockIdx.x, G0 = gridDim.x;
#ifndef EMU
    XcdBarrier bar; bar.bar = (unsigned*)(kargs()->ws + WS_CTL) + CW_BAR; bar.x = 0; bar.st = nullptr;
    if constexpr (HI - LO > 1) {
        { volatile LAS unsigned* misc = (volatile LAS unsigned*)(lds + MISC_OFF); if (threadIdx.x < 32) misc[threadIdx.x] = 0u; }
        __syncthreads();
        bar = xcd_barrier_post((unsigned*)(kargs()->ws + WS_CTL) + CW_BAR, (volatile LAS unsigned*)(lds + MISC_OFF) + 8);
    }
#endif
    PHASE(0,  p0_prologue(a, lds, bid, G); ); SEAMP(0);
    PHASE(1,  p1_mods(a, lds, bid, G); ); SEAMP(1);
    PHASE(2,  phase_norm0(a, bid, G); ); SEAMP(2);
    ffn_phases<LO, HI, 0, 0>(lds, bid0, G0, bar);
    even_mixer_phases<LO, HI>(lds, bid0, G0, bar);
    outproj_phases<LO, HI, 0>(lds, bid0, G0, bar);
    ffn_phases<LO, HI, 0, 1>(lds, bid0, G0, bar);
    ffn_phases<LO, HI, 1, 0>(lds, bid0, G0, bar);
    odd_mixer_phases<LO, HI>(lds, bid0, G0, bar);
    outproj_phases<LO, HI, 1>(lds, bid0, G0, bar);
    ffn_phases<LO, HI, 1, 1>(lds, bid0, G0, bar);
}

#ifndef MK_ONE_LAUNCH
#define MK_ONE_LAUNCH 1
#endif
#ifdef EMU
template <int P> static void emu_run_phases(const Args& a, int grid, int p0, int p1) {
    if constexpr (P < N_PHASES) {
        if (P >= p0 && P < p1 && P != 9) { fprintf(stderr, "[emu] phase %d\n", P); emu_launch(grid, NTHR, LDS_BYTES, [&]() { mk_fwd<P, P + 1>(a); }); }
        emu_run_phases<P + 1>(a, grid, p0, p1);
    }
}
#else
template <int P> static void launch_phases(const Args& a, int grid, hipStream_t stream) {
    if constexpr (P < N_PHASES) {
        if constexpr (P != 9) {
            static bool attr_set = false;
            if (!attr_set) { (void)hipFuncSetAttribute((const void*)mk_fwd<P, P + 1>, hipFuncAttributeMaxDynamicSharedMemorySize, LDS_BYTES); attr_set = true; }
            hipLaunchKernelGGL((mk_fwd<P, P + 1>), dim3(grid), dim3(NTHR), LDS_BYTES, stream, a);
        }
        launch_phases<P + 1>(a, grid, stream);
    }
}
#endif

extern "C" void kernel_launch(void* const* d_in, const int* in_sizes, int n_in, void* d_out, int out_size, void* d_ws, size_t ws_size, hipStream_t stream) {
    static int grid = 0;
    if (grid == 0) {
        if (n_in != 35 || (size_t)out_size != OUT_END || ws_size < WS_END) { fprintf(stderr, "kernel_launch: unexpected problem (n_in %d, out %d vs %zu, ws %zu vs %zu); nothing launched\n", n_in, out_size, (size_t)OUT_END, ws_size, (size_t)WS_END); grid = -1; return; }
#ifdef EMU
        grid = 8; { const char* e = getenv("EMU_GRID"); if (e) grid = atoi(e); }
#else
        int dev = 0, cus = 0, per_cu = 0;
        if (hipGetDevice(&dev) != hipSuccess || hipDeviceGetAttribute(&cus, hipDeviceAttributeMultiprocessorCount, dev) != hipSuccess) { fprintf(stderr, "kernel_launch: device query failed\n"); grid = -1; return; }
#if MK_ONE_LAUNCH
        if (hipFuncSetAttribute((const void*)mk_fwd<0, N_PHASES>, hipFuncAttributeMaxDynamicSharedMemorySize, LDS_BYTES) != hipSuccess) { fprintf(stderr, "kernel_launch: hipFuncSetAttribute failed\n"); grid = -1; return; }
        if (hipOccupancyMaxActiveBlocksPerMultiprocessor(&per_cu, (const void*)mk_fwd<0, N_PHASES>, NTHR, LDS_BYTES) != hipSuccess || per_cu < 1) fprintf(stderr, "kernel_launch: occupancy query says %d blocks per CU\n", per_cu);
        (void)hipGetLastError();
#else
        (void)per_cu;
#endif
        grid = cus;
#endif
    }
    if (grid < 0) return;
    (void)hipMemsetAsync((char*)d_ws + WS_CTL, 0, CTL_BYTES, stream);
    Args a{};
    for (int i = 0; i < 35; ++i) a.in[i] = (const float*)d_in[i];
    a.out = (float*)d_out; a.ws = (unsigned char*)d_ws;
#ifdef EMU
    { int p0 = 0, p1 = N_PHASES; const char* e = getenv("EMU_PH0"); if (e) p0 = atoi(e); e = getenv("EMU_PH1"); if (e) p1 = atoi(e);
      emu_run_phases<0>(a, grid, p0, p1); }
#else
#if MK_ONE_LAUNCH
    hipLaunchKernelGGL((mk_fwd<0, N_PHASES>), dim3(grid), dim3(NTHR), LDS_BYTES, stream, a);
#else
    launch_phases<0>(a, grid, stream);
#endif
    const hipError_t le = hipGetLastError();
    if (le != hipSuccess) fprintf(stderr, "kernel_launch: launch failed: %s\n", hipGetErrorName(le));
#endif
}
```

```cpp
#ifdef EMU
#include "emu.h"
#define LAS
#define GAS
#else
#include <hip/hip_runtime.h>
#define LAS __attribute__((address_space(3)))
#define GAS __attribute__((address_space(1)))
#endif
#include <cstdio>
#include <cstdint>
#include <cmath>

#ifndef CFG_BATCH
#define CFG_BATCH 16
#define CFG_SEQ 256
#define CFG_DEC_BATCH 8
#define CFG_DEC_SEQ 1024
#define CFG_PAST 512
#define CFG_DFF 5632
#endif
#define DEV __device__ __forceinline__

typedef unsigned short bf16;
typedef float f32x4 __attribute__((ext_vector_type(4)));
typedef float f32x2 __attribute__((ext_vector_type(2)));
typedef short bf16x8 __attribute__((ext_vector_type(8)));
typedef short bf16x4 __attribute__((ext_vector_type(4)));
typedef unsigned u32x4 __attribute__((ext_vector_type(4)));
typedef unsigned u32x2 __attribute__((ext_vector_type(2)));
typedef _Float16 f16x4 __attribute__((ext_vector_type(4)));

constexpr int D = 2048, NB_P = CFG_BATCH, L_P = CFG_SEQ, NB_S = CFG_DEC_BATCH, L_S = CFG_DEC_SEQ, PAST = CFG_PAST, DFF = CFG_DFF;
constexpr int TP = NB_P * L_P, TS = NB_S * L_S, T = TP + TS, CTX = NB_S * PAST, TK = T + CTX;
constexpr int EV_IN = 4608, OD_IN = 5952, OD_INP = 6144, NQKV = 1536;
constexpr int NMOD = 9, NGRP = 1 + NB_S, MODW = NMOD * D;
constexpr int GV_KS = 16, GV_KC = D / GV_KS;
constexpr int NWAVES = 8, NTHR = 512;
static_assert(T % 256 == 0 && TK % 256 == 0 && TP % 256 == 0 && DFF % 256 == 0 && (DFF / 2) % 128 == 0, "tile multiples");
static_assert(L_P % 128 == 0 && L_S % 128 == 0 && PAST % 32 == 0 && L_P % 8 == 0, "sequence multiples");

constexpr size_t MiB = 1u << 20;
constexpr size_t al(size_t x) { return (x + MiB - 1) / MiB * MiB; }
constexpr size_t WS_CTL = 0, CTL_BYTES = 1 * MiB;
constexpr size_t WS_WGU = WS_CTL + CTL_BYTES;
constexpr size_t SZ_WGU1 = (size_t)2 * DFF * D * 2;
constexpr size_t WS_WD = WS_WGU + al(4 * SZ_WGU1);
constexpr size_t SZ_WD1 = (size_t)D * DFF * 2;
constexpr size_t WS_WEVIN = WS_WD + al(4 * SZ_WD1);
constexpr size_t WS_WEVOUT = WS_WEVIN + al((size_t)EV_IN * D * 2);
constexpr size_t WS_WODIN = WS_WEVOUT + al((size_t)D * D * 2);
constexpr size_t WS_WODOUT = WS_WODIN + al((size_t)OD_INP * D * 2);
constexpr size_t WS_WQB = WS_WODOUT + al((size_t)D * D * 2);
constexpr size_t WS_WKVK = WS_WQB + al((size_t)1536 * 512 * 2);
constexpr size_t WS_WKVV = WS_WKVK + al((size_t)1024 * 256 * 2);
constexpr size_t WS_X = WS_WKVV + al((size_t)1024 * 256 * 2);
constexpr size_t WS_HN = WS_X + al((size_t)T * D * 4);
constexpr size_t WS_HFF = WS_HN + al((size_t)T * D * 2);
constexpr size_t SZ_HFF = al((size_t)T * DFF * 2) > al((size_t)2 * T * 1024 * 4) ? al((size_t)T * DFF * 2) : al((size_t)2 * T * 1024 * 4);
constexpr size_t WS_OUT = WS_HFF + SZ_HFF;
constexpr size_t SZ_OUT1 = (size_t)T * D * 4;
constexpr size_t WS_QN = WS_OUT;
constexpr size_t WS_CKV = WS_QN + al((size_t)T * 512 * 2);
constexpr size_t WS_KR = WS_CKV + al((size_t)TK * 256 * 2);
constexpr size_t WS_QM = WS_KR + al((size_t)TK * 64 * 2);
constexpr size_t WS_KN = WS_QM + al((size_t)T * 1536 * 2);
constexpr size_t WS_VTM = WS_KN + al((size_t)TK * 1024 * 2);
constexpr size_t MLA_END = WS_VTM + al((size_t)1024 * TK * 2);
constexpr size_t SZ_OUT = (al(2 * SZ_OUT1) > (MLA_END - WS_OUT)) ? al(2 * SZ_OUT1) : (MLA_END - WS_OUT);
constexpr size_t WS_P = WS_OUT + SZ_OUT;
constexpr size_t WS_UT = WS_P;
constexpr size_t WS_QKV = WS_UT + al((size_t)3072 * T * 2);
constexpr size_t WS_VTE = WS_QKV + al((size_t)T * NQKV * 2);
constexpr size_t WS_YT = WS_VTE + al((size_t)256 * T * 2);
constexpr size_t EV_END = WS_YT + al((size_t)1024 * T * 2);
constexpr size_t SZ_P = (al((size_t)T * OD_INP * 2) > (EV_END - WS_P)) ? al((size_t)T * OD_INP * 2) : (EV_END - WS_P);
constexpr size_t WS_MIX = WS_P + SZ_P;
constexpr size_t WS_FILT = WS_MIX + al((size_t)T * D * 2);
constexpr size_t WS_H2 = WS_FILT + al((size_t)4 * (L_P + L_S) * 1024 * 2);
constexpr size_t WS_MODP = WS_H2 + al((size_t)(L_P + L_S) * 64 * 4);
constexpr size_t WS_MODS = WS_MODP + al((size_t)GV_KS * 2 * NGRP * MODW * 4);
constexpr size_t WS_KC = WS_MODS + al((size_t)2 * NGRP * MODW * 4);
constexpr size_t WS_VTC = WS_KC + al((size_t)NB_S * 2 * PAST * 128 * 2);
constexpr size_t WS_END = WS_VTC + al((size_t)NB_S * 2 * PAST * 128 * 2);
#if CFG_BATCH == 16 && CFG_DFF == 5632
static_assert(WS_END <= (size_t)1152 * MiB, "d_ws map exceeds the guaranteed workspace");
#endif

constexpr size_t OUT_Y = 0;
constexpr size_t OUT_K = (size_t)T * D;
constexpr size_t OUT_V = OUT_K + (size_t)NB_P * 2 * L_P * 128;
constexpr size_t OUT_CKV = OUT_V + (size_t)NB_P * 2 * L_P * 128;
constexpr size_t OUT_KR = OUT_CKV + (size_t)NB_P * L_P * 256;
constexpr size_t OUT_ST = OUT_KR + (size_t)NB_P * L_P * 64;
constexpr size_t OUT_END = OUT_ST + (size_t)NB_P * 2 * 8 * 128 * 128;

constexpr int RING_BYTES = 131072, MISC_OFF = RING_BYTES + 320, LDS_BYTES = 147456;

#ifdef EMU
#define SCHED_FENCE() do { } while (0)
#else
#define SCHED_FENCE() __builtin_amdgcn_sched_barrier(0)
#endif
#ifdef EMU
DEV void lds_barrier() { __syncthreads(); }
#else
DEV void lds_barrier() { asm volatile("s_waitcnt lgkmcnt(0)" ::: "memory"); __builtin_amdgcn_s_barrier(); asm volatile("" ::: "memory"); }
#endif
#ifdef EMU
DEV int tid_l() { return (int)threadIdx.x; }
#else
DEV int tid_l() { int t = (int)threadIdx.x; asm volatile("" : "+v"(t)); return t; }
#endif
DEV float bf2f(bf16 v) { return __uint_as_float((unsigned)v << 16); }
DEV unsigned f2bf(float f) { unsigned u = __float_as_uint(f); return (u + 0x7fffu + ((u >> 16) & 1u)) >> 16; }
#ifdef EMU
DEV unsigned pk2(float lo, float hi) { return f2bf(lo) | (f2bf(hi) << 16); }
DEV float fast_exp2(float x) { return exp2f(x); }
#else
DEV unsigned pk2(float lo, float hi) { unsigned r; asm("v_cvt_pk_bf16_f32 %0, %1, %2" : "=v"(r) : "v"(lo), "v"(hi)); return r; }
DEV float fast_exp2(float x) { return __builtin_amdgcn_exp2f(x); }
#endif
#ifdef EMU
DEV float xrow16_max(float x) { x = fmaxf(x, __shfl_xor(x, 16)); return fmaxf(x, __shfl_xor(x, 32)); }
DEV float xrow16_sum(float x) { x += __shfl_xor(x, 16); return x + __shfl_xor(x, 32); }
#else
DEV float xrow16_max(float x) {
    auto s = __builtin_amdgcn_permlane16_swap(__float_as_uint(x), __float_as_uint(x), false, false);
    x = fmaxf(__uint_as_float(s[0]), __uint_as_float(s[1]));
    auto t = __builtin_amdgcn_permlane32_swap(__float_as_uint(x), __float_as_uint(x), false, false);
    return fmaxf(__uint_as_float(t[0]), __uint_as_float(t[1]));
}
DEV float xrow16_sum(float x) {
    auto s = __builtin_amdgcn_permlane16_swap(__float_as_uint(x), __float_as_uint(x), false, false);
    x = __uint_as_float(s[0]) + __uint_as_float(s[1]);
    auto t = __builtin_amdgcn_permlane32_swap(__float_as_uint(x), __float_as_uint(x), false, false);
    return __uint_as_float(t[0]) + __uint_as_float(t[1]);
}
#endif
DEV float wave_sum(float v) {
#pragma unroll
    for (int o = 1; o < 64; o <<= 1) v += __shfl_xor(v, o);
    return v;
}
#ifdef EMU
DEV float fast_rcp(float x) { return 1.0f / x; }
#else
DEV float fast_rcp(float x) { return __builtin_amdgcn_rcpf(x); }
#endif
#ifdef EMU
DEV float fast_sin(float x) { return sinf(x); }
DEV float fast_cos(float x) { return cosf(x); }
#else
DEV float fast_sin(float x) { return __sinf(x); }
DEV float fast_cos(float x) { return __cosf(x); }
#endif
DEV float silu_f(float x) { return x * fast_rcp(1.0f + __expf(-x)); }
DEV float sigmoid_f(float x) { return fast_rcp(1.0f + __expf(-x)); }
DEV int grp_of_row(int row) { return row < TP ? 0 : 1 + (row - TP) / L_S; }
DEV bf16x8 ld_bf16x8(const bf16* p) { return *(const bf16x8*)p; }
DEV bf16x8 lds_bf16x8(const LAS unsigned char* p) { return *(const LAS bf16x8*)p; }
DEV f32x4 mfma16(bf16x8 a, bf16x8 b, f32x4 c) { return __builtin_amdgcn_mfma_f32_16x16x32_bf16(a, b, c, 0, 0, 0); }

namespace pg8 {
constexpr int BM = 256, BK = 64, HALF = 128, HTB = HALF * BK * 2, STAGE_BYTES = 8 * HTB, NXCD = 8, WGM = 4;
__host__ __device__ __forceinline__ int lds_byte(int r, int c) { const int st = (r >> 4) * 2 + (c >> 5), rr = r & 15, cc = c & 31, ob = rr * 64 + cc * 2; return st * 1024 + (ob ^ (((ob >> 9) & 1) << 5)); }
__host__ __device__ __forceinline__ void stage_rc(int b, int& R, int& C) { const int st = b / 1024, sb = b % 1024, swz = sb ^ (((sb >> 9) & 1) << 5); R = (st >> 1) * 16 + swz / 64; C = (st & 1) * 32 + (swz % 64) / 2; }
__host__ __device__ __forceinline__ int perm32(int rho) { const int n = rho >> 4, i = rho & 15; return 8 * (i >> 2) + 4 * n + (i & 3); }

struct Unit { int pm, pn, sub; };
struct Gemm { int K, lda, ldb; };
struct SubG { const bf16* A; const bf16* Bt; int nM, nN; };

struct MultiOrder {
    const char* A0; const char* B0; long dA1, dB1, dA2, dB2; int nM0, nN0, dM1, dN1, dM2, dN2, n0, n1, n2, G, c, lda, ldb;
    DEV void init(const SubG& g0, const SubG& g1, const SubG& g2, int ns, int G_, int c_, int lda_, int ldb_) {
        A0 = (const char*)g0.A; B0 = (const char*)g0.Bt; dA1 = (const char*)g1.A - A0; dB1 = (const char*)g1.Bt - B0; dA2 = (const char*)g2.A - A0; dB2 = (const char*)g2.Bt - B0;
        nM0 = g0.nM; nN0 = g0.nN; dM1 = g1.nM - g0.nM; dN1 = g1.nN - g0.nN; dM2 = g2.nM - g0.nM; dN2 = g2.nN - g0.nN;
        n0 = g0.nM * g0.nN; n1 = ns > 1 ? g1.nM * g1.nN : 0; n2 = ns > 2 ? g2.nM * g2.nN : 0; G = G_; c = c_; lda = lda_; ldb = ldb_;
    }
    DEV bool next(int i, Unit& u) const {
        const long L = (long)i * G + c;
        if (L >= (long)n0 + n1 + n2) return false;
        int l = (int)L; const int sub = (l >= n0 ? 1 : 0) + (l >= n0 + n1 ? 1 : 0);
        l -= (sub >= 1 ? n0 : 0) + (sub >= 2 ? n1 : 0);
        const int nM = nM0 + (sub == 1 ? dM1 : 0) + (sub == 2 ? dM2 : 0), nN = nN0 + (sub == 1 ? dN1 : 0) + (sub == 2 ? dN2 : 0);
        const int nwg = nM * nN; int wgid = l; { const int q = nwg / NXCD, r = nwg % NXCD, xcd = wgid % NXCD, off = wgid / NXCD; wgid = (xcd < r ? xcd * (q + 1) : r * (q + 1) + (xcd - r) * q) + off; }
        const int nig = WGM * nN, gid = wgid / nig, fm = gid * WGM, gsz = (nM - fm) < WGM ? (nM - fm) : WGM;
        u.pm = fm + ((wgid % nig) % gsz); u.pn = (wgid % nig) / gsz; u.sub = sub; return true;
    }
    DEV const char* pa(const Unit& u) const { return A0 + ((u.sub == 1 ? dA1 : 0) + (u.sub == 2 ? dA2 : 0)) + (size_t)u.pm * BM * lda * 2; }
    DEV const char* pb(const Unit& u) const { return B0 + ((u.sub == 1 ? dB1 : 0) + (u.sub == 2 ? dB2 : 0)) + (size_t)u.pn * BM * ldb * 2; }
    DEV void a_ready(const Unit&) const {}
    DEV void done(const Unit&) const {}
};

struct EpiBf16M {
    static constexpr bool PERM = true, AFTER_DRAIN = false;
    bf16* O0; long dO1, dO2; int ldc0, dl1, dl2;
    DEV static EpiBf16M make(bf16* o0, bf16* o1, bf16* o2, int l0, int l1, int l2) { EpiBf16M e; e.O0 = o0; e.dO1 = o1 ? o1 - o0 : 0; e.dO2 = o2 ? o2 - o0 : 0; e.ldc0 = l0; e.dl1 = l1 - l0; e.dl2 = l2 - l0; return e; }
    DEV void operator()(const f32x4 (&acc)[2][2][4][2], const Unit& u, int wr, int wc, int fr, int fq) const {
        bf16* base = O0 + ((u.sub == 1 ? dO1 : 0) + (u.sub == 2 ? dO2 : 0)); const int ldc = ldc0 + (u.sub == 1 ? dl1 : 0) + (u.sub == 2 ? dl2 : 0);
        const int row0 = u.pm * BM + wr * 64 + fr, col0 = u.pn * BM + wc * 32 + 8 * fq;
#pragma unroll
        for (int ai = 0; ai < 2; ++ai)
#pragma unroll
            for (int m = 0; m < 4; ++m) { bf16* rowp = base + (size_t)(row0 + ai * HALF + m * 16) * ldc + col0;
#pragma unroll
                for (int bj = 0; bj < 2; ++bj) { const f32x4 v0 = acc[ai][bj][m][0], v1 = acc[ai][bj][m][1];
                    u32x4 w; w.x = pk2(v0[0], v0[1]); w.y = pk2(v0[2], v0[3]); w.z = pk2(v1[0], v1[1]); w.w = pk2(v1[2], v1[3]);
                    *(u32x4*)(rowp + bj * HALF) = w; } }
    }
};
struct EpiSwiGLU {
    static constexpr bool PERM = true, AFTER_DRAIN = false;
    bf16* O; int ldc;
    DEV void operator()(const f32x4 (&acc)[2][2][4][2], const Unit& u, int wr, int wc, int fr, int fq) const {
        const int row0 = u.pm * BM + wr * 64 + fr, col0 = u.pn * HALF + wc * 32 + 8 * fq;
#pragma unroll
        for (int ai = 0; ai < 2; ++ai)
#pragma unroll
            for (int m = 0; m < 4; ++m) { bf16* rowp = O + (size_t)(row0 + ai * HALF + m * 16) * ldc + col0;
                float h[8];
#pragma unroll
                for (int n = 0; n < 2; ++n)
#pragma unroll
                    for (int i = 0; i < 4; ++i) { const float ag = acc[ai][0][m][n][i], au = acc[ai][1][m][n][i]; h[4 * n + i] = (ag * au) * fast_rcp(1.0f + fast_exp2(ag)); }
                u32x4 w; w.x = pk2(h[0], h[1]); w.y = pk2(h[2], h[3]); w.z = pk2(h[4], h[5]); w.w = pk2(h[6], h[7]);
                *(u32x4*)rowp = w; }
    }
};
struct EpiF32S {
    static constexpr bool PERM = false, AFTER_DRAIN = false;
    float* O0; long dO1; int ldc;
    DEV void operator()(const f32x4 (&acc)[2][2][4][2], const Unit& u, int wr, int wc, int fr, int fq) const {
        float* base = O0 + (u.sub == 1 ? dO1 : 0);
        const int row0 = u.pm * BM + wr * 64 + fr, col0 = u.pn * BM + wc * 32 + 4 * fq;
#pragma unroll
        for (int ai = 0; ai < 2; ++ai)
#pragma unroll
            for (int m = 0; m < 4; ++m) { float* rowp = base + (size_t)(row0 + ai * HALF + m * 16) * ldc + col0;
#pragma unroll
                for (int bj = 0; bj < 2; ++bj)
#pragma unroll
                    for (int n = 0; n < 2; ++n) *(f32x4*)(rowp + bj * HALF + 16 * n) = acc[ai][bj][m][n]; }
    }
};

#ifdef EMU
template <class Epi, class Sched, bool ALIGN_EPI = false, bool SP2 = false>
inline void gemm_phase(unsigned char* lds, const Gemm g, const Sched& S, const Epi& E) {
    static thread_local std::vector<float> tile(256 * 256);
    const int tid = tid_l(), wid = tid >> 6, lane = tid & 63, wr = wid >> 2, wc = wid & 3, fr = lane & 15, fq = lane >> 4;
    Unit cur;
    for (int ui = 0; S.next(ui, cur); ++ui) {
        __syncthreads();
        if (tid == 0) {
            const bf16* A = (const bf16*)S.pa(cur); const bf16* B = (const bf16*)S.pb(cur);
            std::vector<float> af((size_t)256 * g.K), bfv((size_t)256 * g.K);
            for (int r = 0; r < 256; ++r) for (int k = 0; k < g.K; ++k) { af[(size_t)r * g.K + k] = bf2f(A[(size_t)r * g.lda + k]); bfv[(size_t)r * g.K + k] = bf2f(B[(size_t)r * g.ldb + k]); }
            for (int r = 0; r < 256; ++r) for (int c = 0; c < 256; ++c) { const float* a = &af[(size_t)r * g.K]; const float* b = &bfv[(size_t)c * g.K]; float s = 0.f; for (int k = 0; k < g.K; ++k) s += a[k] * b[k]; tile[r * 256 + c] = s; }
        }
        __syncthreads();
        f32x4 acc[2][2][4][2];
        for (int ai = 0; ai < 2; ++ai) for (int bj = 0; bj < 2; ++bj) for (int m = 0; m < 4; ++m) for (int n = 0; n < 2; ++n) for (int i = 0; i < 4; ++i) {
            const int r = 128 * ai + 64 * wr + 16 * m + fr; const int c = 128 * bj + 32 * wc + (Epi::PERM ? (8 * fq + 4 * n + i) : (16 * n + 4 * fq + i));
            acc[ai][bj][m][n][i] = tile[r * 256 + c]; }
        E(acc, cur, wr, wc, fr, fq);
    }
    __syncthreads();
}
#else
template <class Epi, class Sched, bool ALIGN_EPI = false, bool SP2 = false>
__device__ __forceinline__ void gemm_phase(LAS unsigned char* lds, const Gemm g, const Sched& S, const Epi& E) {
    const int tid = tid_l(), wid = __builtin_amdgcn_readfirstlane(tid >> 6), lane = tid & 63, wr = wid >> 2, wc = wid & 3, fr = lane & 15, fq = lane >> 4;
    const int K = g.K, nt = K / BK;
    unsigned voffA[2], voffB[2];
#pragma unroll
    for (int i = 0; i < 2; ++i) { int R, C; stage_rc(tid * 16 + i * 8192, R, C); const int Rb = Epi::PERM ? ((R & ~31) + perm32(R & 31)) : R;
        voffA[i] = (unsigned)(R * g.lda + C) * 2u; voffB[i] = (unsigned)(Rb * g.ldb + C) * 2u; }
    const size_t kstep = (size_t)(BK * 2);
    const size_t hstepA = (size_t)HALF * g.lda * 2, hstepB = (size_t)HALF * g.ldb * 2;
    const unsigned ldsw = (unsigned)wid * 1024u;
    const int aoff = lds_byte(wr * 64 + fr, fq * 8), boff = lds_byte(wc * 32 + fr, fq * 8);
#define PG8_SA(b, h) (((b) * 2 + (h)) * HTB)
#define PG8_SB(b, h) ((4 + (b) * 2 + (h)) * HTB)
#define PG8_STAGE(bufoff, gbase, voff) do { _Pragma("unroll") for (int _i = 0; _i < 2; ++_i) \
        __builtin_amdgcn_global_load_lds((const unsigned*)((const char*)(gbase) + (voff)[_i]), (LAS unsigned*)(lds + (bufoff) + ldsw + _i * 8192), 16, 0, 0); } while (0)
#define PG8_LDA(dst, b, h) do { _Pragma("unroll") for (int m = 0; m < 4; ++m) _Pragma("unroll") for (int k = 0; k < 2; ++k) dst[m][k] = *(const LAS bf16x8*)(lds + PG8_SA(b, h) + aoff + m * 2048 + k * 1024); } while (0)
#define PG8_LDB(dst, b, h) do { _Pragma("unroll") for (int n = 0; n < 2; ++n) _Pragma("unroll") for (int k = 0; k < 2; ++k) dst[n][k] = *(const LAS bf16x8*)(lds + PG8_SB(b, h) + boff + n * 2048 + k * 1024); } while (0)
#define PG8_MMA(ai, bj, At, Bt) do { __builtin_amdgcn_s_setprio(1); _Pragma("unroll") for (int m = 0; m < 4; ++m) _Pragma("unroll") for (int n = 0; n < 2; ++n) _Pragma("unroll") for (int k = 0; k < 2; ++k) \
        acc[ai][bj][m][n] = __builtin_amdgcn_mfma_f32_16x16x32_bf16(Bt[n][k], At[m][k], acc[ai][bj][m][n], 0, 0, 0); __builtin_amdgcn_s_setprio(0); } while (0)
#define PG8_WAIT_V(n) asm volatile("s_waitcnt vmcnt(" #n ")" ::: "memory")
#define PG8_WAIT_L(n) asm volatile("s_waitcnt lgkmcnt(" #n ")" ::: "memory")
#define PG8_BAR __builtin_amdgcn_s_barrier()
#define PG8_SCHED __builtin_amdgcn_sched_barrier(0)
    Unit cur, nxt; int ui = 0;
    if (!S.next(0, cur)) return;
    f32x4 acc[2][2][4][2];
#pragma unroll
    for (int a = 0; a < 2; ++a)
#pragma unroll
        for (int b = 0; b < 2; ++b)
#pragma unroll
            for (int m = 0; m < 4; ++m)
#pragma unroll
                for (int n = 0; n < 2; ++n) acc[a][b][m][n] = (f32x4){0.f, 0.f, 0.f, 0.f};
    bf16x8 At[4][2], B0[2][2], B1[2][2];
    const char* cA = S.pa(cur); const char* cB = S.pb(cur);
    S.a_ready(cur);
    if constexpr (SP2) {
        PG8_STAGE(PG8_SB(0, 0), cB, voffB); PG8_STAGE(PG8_SB(0, 1), cB + hstepB, voffB); PG8_STAGE(PG8_SA(0, 0), cA, voffA); PG8_STAGE(PG8_SA(0, 1), cA + hstepA, voffA);
        if (wr == 1) PG8_BAR;
        PG8_WAIT_V(2); PG8_BAR;
        PG8_STAGE(PG8_SB(1, 0), cB + kstep, voffB); PG8_STAGE(PG8_SA(1, 0), cA + kstep, voffA); PG8_STAGE(PG8_SB(1, 1), cB + hstepB + kstep, voffB);
        PG8_WAIT_V(6); PG8_BAR;
    } else {
        PG8_STAGE(PG8_SB(0, 0), cB, voffB); PG8_STAGE(PG8_SA(0, 0), cA, voffA); PG8_STAGE(PG8_SB(0, 1), cB + hstepB, voffB); PG8_STAGE(PG8_SA(0, 1), cA + hstepA, voffA);
        if (wr == 1) PG8_BAR;
        PG8_WAIT_V(4); PG8_BAR;
        PG8_STAGE(PG8_SB(1, 0), cB + kstep, voffB); PG8_STAGE(PG8_SA(1, 0), cA + kstep, voffA); PG8_STAGE(PG8_SB(1, 1), cB + hstepB + kstep, voffB);
        PG8_WAIT_V(6); PG8_BAR;
    }
    for (;;) {
        const bool has_next = S.next(ui + 1, nxt);
        const char* nA = has_next ? S.pa(nxt) : cA; const char* nB = has_next ? S.pb(nxt) : cB;
        for (int t = 0; t < nt; t += 2) {
            const bool last = (t == nt - 2);
            const char* a1 = cA + (size_t)(t + 1) * kstep;
            const char* a2 = last ? nA : cA + (size_t)(t + 2) * kstep; const char* b2 = last ? nB : cB + (size_t)(t + 2) * kstep;
            const char* a3 = a2 + kstep; const char* b3 = b2 + kstep;
            if (last && has_next) S.a_ready(nxt);
            if constexpr (SP2) {
            PG8_LDB(B0, 0, 0); PG8_LDB(B1, 0, 1); PG8_SCHED; PG8_LDA(At, 0, 0); PG8_STAGE(PG8_SA(1, 1), a1 + hstepA, voffA);
            PG8_WAIT_V(8); PG8_WAIT_L(0); PG8_BAR; PG8_MMA(0, 0, At, B0); PG8_MMA(0, 1, At, B1); PG8_BAR; PG8_SCHED;
            PG8_LDA(At, 0, 1); PG8_STAGE(PG8_SB(0, 0), b2, voffB); PG8_STAGE(PG8_SB(0, 1), b2 + hstepB, voffB); PG8_STAGE(PG8_SA(0, 0), a2, voffA);
            PG8_WAIT_V(8); PG8_WAIT_L(0); PG8_BAR; PG8_MMA(1, 0, At, B0); PG8_MMA(1, 1, At, B1); PG8_BAR; PG8_SCHED;
            PG8_LDB(B0, 1, 0); PG8_LDB(B1, 1, 1); PG8_SCHED; PG8_LDA(At, 1, 0); PG8_STAGE(PG8_SA(0, 1), a2 + hstepA, voffA);
            PG8_WAIT_V(8); PG8_WAIT_L(0); PG8_BAR; PG8_MMA(0, 0, At, B0); PG8_MMA(0, 1, At, B1); PG8_BAR; PG8_SCHED;
            PG8_LDA(At, 1, 1); PG8_STAGE(PG8_SB(1, 0), b3, voffB); PG8_STAGE(PG8_SB(1, 1), b3 + hstepB, voffB); PG8_STAGE(PG8_SA(1, 0), a3, voffA);
            PG8_WAIT_V(8); PG8_WAIT_L(0); PG8_BAR; PG8_MMA(1, 0, At, B0); PG8_MMA(1, 1, At, B1); PG8_BAR; PG8_SCHED;
            } else {
            PG8_LDB(B0, 0, 0); PG8_SCHED; PG8_LDA(At, 0, 0); PG8_STAGE(PG8_SA(1, 1), a1 + hstepA, voffA);
            PG8_WAIT_L(8); PG8_BAR; PG8_WAIT_L(0); PG8_MMA(0, 0, At, B0); PG8_BAR; PG8_SCHED;
            PG8_LDB(B1, 0, 1); PG8_STAGE(PG8_SB(0, 0), b2, voffB);
            PG8_BAR; PG8_WAIT_L(0); PG8_MMA(0, 1, At, B1); PG8_BAR;
            PG8_LDA(At, 0, 1); PG8_STAGE(PG8_SA(0, 0), a2, voffA);
            PG8_BAR; PG8_WAIT_L(0); PG8_MMA(1, 0, At, B0); PG8_BAR; PG8_SCHED;
            PG8_STAGE(PG8_SB(0, 1), b2 + hstepB, voffB);
            PG8_WAIT_V(6); PG8_BAR; PG8_MMA(1, 1, At, B1); PG8_BAR;
            PG8_LDB(B0, 1, 0); PG8_SCHED; PG8_LDA(At, 1, 0); PG8_STAGE(PG8_SA(0, 1), a2 + hstepA, voffA);
            PG8_WAIT_L(8); PG8_BAR; PG8_WAIT_L(0); PG8_MMA(0, 0, At, B0); PG8_BAR; PG8_SCHED;
            PG8_LDB(B1, 1, 1); PG8_STAGE(PG8_SB(1, 0), b3, voffB);
            PG8_BAR; PG8_WAIT_L(0); PG8_MMA(0, 1, At, B1); PG8_BAR;
            PG8_LDA(At, 1, 1); PG8_STAGE(PG8_SA(1, 0), a3, voffA);
            PG8_BAR; PG8_WAIT_L(0); PG8_MMA(1, 0, At, B0); PG8_BAR; PG8_SCHED;
            PG8_STAGE(PG8_SB(1, 1), b3 + hstepB, voffB);
            PG8_WAIT_V(6); PG8_BAR; PG8_MMA(1, 1, At, B1); PG8_BAR;
            }
        }
        if constexpr (ALIGN_EPI) { if (wr == 0) PG8_BAR; }
        if constexpr (!Epi::AFTER_DRAIN) { E(acc, cur, wr, wc, fr, fq); S.done(cur); }
        if (!has_next) break;
#pragma unroll
        for (int a = 0; a < 2; ++a)
#pragma unroll
            for (int b = 0; b < 2; ++b)
#pragma unroll
                for (int m = 0; m < 4; ++m)
#pragma unroll
                    for (int n = 0; n < 2; ++n) acc[a][b][m][n] = (f32x4){0.f, 0.f, 0.f, 0.f};
        cur = nxt; cA = nA; cB = nB; ++ui;
        if constexpr (ALIGN_EPI) { if (wr == 1) PG8_BAR; }
    }
    PG8_WAIT_V(0);
    if constexpr (!ALIGN_EPI) { if (wr == 0) PG8_BAR; }
    PG8_BAR;
#undef PG8_SA
#undef PG8_SB
#undef PG8_STAGE
#undef PG8_LDA
#undef PG8_LDB
#undef PG8_MMA
#undef PG8_WAIT_V
#undef PG8_WAIT_L
#undef PG8_BAR
#undef PG8_SCHED
}
#endif
}
struct Args {
    const float* in[35]; float* out; unsigned char* ws;
    int pad0, pad1;

};
#ifdef EMU
typedef const Args* KArgs;
extern thread_local const Args* emu_args_p;
thread_local const Args* emu_args_p = nullptr;
DEV KArgs kargs() { return emu_args_p; }
#else
typedef const __attribute__((address_space(4))) Args* KArgs;
DEV KArgs kargs() { unsigned long long k = (unsigned long long)__builtin_amdgcn_kernarg_segment_ptr(); asm volatile("" : "+s"(k)); return (KArgs)k; }
#endif
enum { I_XP = 0, I_XS, I_C, I_CCTX, I_CK, I_CV, I_CCKV, I_CKR, I_ST, I_MODW, I_MODB, I_NORMG, I_WG, I_WU, I_WD, I_EVIN, I_EVOUT, I_HCW, I_HCB, I_HW1, I_HB1, I_HW2, I_HB2, I_HW3,
       I_HFREQ, I_HBIAS, I_SINK, I_ODIN, I_ODOUT, I_HGLB, I_HGNORM, I_QNORM, I_WQB, I_KVNORM, I_WKVB };

#ifdef EMU
DEV void wsync() { emu_wave_sync(); }
#else
DEV void wsync() { asm volatile("s_waitcnt lgkmcnt(0)" ::: "memory"); __builtin_amdgcn_wave_barrier(); asm volatile("" ::: "memory"); }
#endif
struct TrJob { const float* src; bf16* dst; int N, ldd; float scale; };
DEV void tr_load(const TrJob& j, f32x4 (&v)[8], int lane) {
#pragma unroll
    for (int i = 0; i < 8; ++i) { const int kk = 8 * i + (lane >> 3); v[i] = __builtin_nontemporal_load((const f32x4*)&j.src[(size_t)kk * j.N + 4 * (lane & 7)]) * j.scale; }
}
DEV void tr_finish(const TrJob& j, const f32x4 (&v)[8], LAS float* scr, int lane) {
    wsync();
#pragma unroll
    for (int i = 0; i < 8; ++i) { const int kk = 8 * i + (lane >> 3);
#pragma unroll
        for (int x = 0; x < 4; ++x) scr[kk * 33 + 4 * (lane & 7) + x] = v[i][x]; }
    wsync();
    const int c = lane & 7;
#pragma unroll
    for (int jj = 0; jj < 4; ++jj) { const int n = (lane >> 3) + 8 * jj; const LAS float* s = scr + (8 * c) * 33 + n;
        u32x4 o; o.x = pk2(s[0 * 33], s[1 * 33]); o.y = pk2(s[2 * 33], s[3 * 33]); o.z = pk2(s[4 * 33], s[5 * 33]); o.w = pk2(s[6 * 33], s[7 * 33]);
        __builtin_nontemporal_store(o, (u32x4*)(j.dst + (size_t)n * j.ldd + 8 * c)); }
}
constexpr int tri(int K, int N, int nb) { return nb * (K / 64) * (N / 32); }
template <int K, int N, int LDD, int MODE>
DEV TrJob tr_job(const float* src, long sstride, bf16* dst, bf16* dst2, long dstride, int r) {
    constexpr int nblk = N / 32, per = (K / 64) * nblk; const int bt = r / per; r -= bt * per;
    const int kb = r / nblk, nb = r % nblk, k0 = 64 * kb, n0 = 32 * nb;
    bf16* WT = dst + (size_t)bt * dstride; int drow0 = n0;
    if (MODE == 1) drow0 = 256 * (n0 / 128) + (n0 % 128);
    else if (MODE == 2) drow0 = 256 * (n0 / 128) + 128 + (n0 % 128);
    else if (MODE == 3) { drow0 = 128 * (n0 / 256) + (n0 % 128); if ((n0 % 256) >= 128) WT = dst2; }
    TrJob j; j.src = src + (size_t)bt * sstride + (size_t)k0 * N + n0; j.dst = WT + (size_t)drow0 * LDD + k0; j.N = N; j.ldd = LDD;
    j.scale = MODE == 1 ? -1.4426950408889634f : (MODE == 2 ? -0.6931471805599453f : 1.0f); return j;
}
constexpr int NW_FFN = 2 * tri(D, DFF, 1) + tri(DFF, D, 1);
DEV TrJob ffn_w_job(KArgs a, int ls, int it) {
    unsigned char* ws = a->ws; constexpr int n1 = tri(D, DFF, 1);
    if (it < n1) return tr_job<D, DFF, D, 1>(a->in[I_WG] + (size_t)ls * D * DFF, 0, (bf16*)(ws + WS_WGU + (size_t)ls * SZ_WGU1), nullptr, 0, it);
    if (it < 2 * n1) return tr_job<D, DFF, D, 2>(a->in[I_WU] + (size_t)ls * D * DFF, 0, (bf16*)(ws + WS_WGU + (size_t)ls * SZ_WGU1), nullptr, 0, it - n1);
    return tr_job<DFF, D, DFF, 0>(a->in[I_WD] + (size_t)ls * D * DFF, 0, (bf16*)(ws + WS_WD + (size_t)ls * SZ_WD1), nullptr, 0, it - 2 * n1);
}
constexpr int NW_EV = tri(D, EV_IN, 1) + tri(D, D, 1) + tri(PAST, 128, NB_S * 2);
DEV TrJob ev_w_job(KArgs a, int it) {
    unsigned char* ws = a->ws; constexpr int n1 = tri(D, EV_IN, 1), n2 = n1 + tri(D, D, 1);
    if (it < n1) return tr_job<D, EV_IN, D, 0>(a->in[I_EVIN], 0, (bf16*)(ws + WS_WEVIN), nullptr, 0, it);
    if (it < n2) return tr_job<D, D, D, 0>(a->in[I_EVOUT], 0, (bf16*)(ws + WS_WEVOUT), nullptr, 0, it - n1);
    return tr_job<PAST, 128, PAST, 0>(a->in[I_CV], (long)PAST * 128, (bf16*)(ws + WS_VTC), nullptr, (long)PAST * 128, it - n2);
}
constexpr int NW_OD = tri(D, OD_IN, 1) + tri(D, D, 1) + tri(512, 1536, 1) + tri(256, 2048, 1);
DEV TrJob od_w_job(KArgs a, int it) {
    unsigned char* ws = a->ws; constexpr int n1 = tri(D, OD_IN, 1), n2 = n1 + tri(D, D, 1), n3 = n2 + tri(512, 1536, 1);
    if (it < n1) return tr_job<D, OD_IN, D, 0>(a->in[I_ODIN], 0, (bf16*)(ws + WS_WODIN), nullptr, 0, it);
    if (it < n2) return tr_job<D, D, D, 0>(a->in[I_ODOUT], 0, (bf16*)(ws + WS_WODOUT), nullptr, 0, it - n1);
    if (it < n3) return tr_job<512, 1536, 512, 0>(a->in[I_WQB], 0, (bf16*)(ws + WS_WQB), nullptr, 0, it - n2);
    return tr_job<256, 2048, 256, 3>(a->in[I_WKVB], 0, (bf16*)(ws + WS_WKVK), (bf16*)(ws + WS_WKVV), 0, it - n3);
}
constexpr int NW_GU = 2 * tri(D, DFF, 1), NW_WD = tri(DFF, D, 1), NW_EVW = tri(D, EV_IN, 1) + tri(D, D, 1), NW_VTC = NW_EV - NW_EVW, NW_ODIN = tri(D, OD_IN, 1), NW_ODR = NW_OD - NW_ODIN;
template <int TL> constexpr int tl_count() { return TL == 0 ? NW_GU + NW_EV : TL == 3 ? NW_WD + NW_FFN : TL == 12 ? NW_FFN + NW_ODR : TL == 15 ? NW_GU + NW_ODIN : NW_WD; }
template <int TL> DEV TrJob tl_job(KArgs a, int it) {
    if constexpr (TL == 0) { if (it < NW_GU) return ffn_w_job(a, 0, it); return ev_w_job(a, it - NW_GU); }
    else if constexpr (TL == 3) { if (it < NW_WD) return ffn_w_job(a, 0, NW_GU + it); return ffn_w_job(a, 1, it - NW_WD); }
    else if constexpr (TL == 12) { if (it < NW_FFN) return ffn_w_job(a, 2, it); return od_w_job(a, NW_ODIN + it - NW_FFN); }
    else if constexpr (TL == 15) { if (it < NW_GU) return ffn_w_job(a, 3, it); return od_w_job(a, it - NW_GU); }
    else return ffn_w_job(a, 3, NW_GU + it);
}
template <int TL> DEV void run_tr_jobs(KArgs a, int gw, int NGW, LAS float* scr, int lane) {
    constexpr int n = tl_count<TL>();
    if (gw >= n) return;
    TrJob j0 = tl_job<TL>(a, gw), j1 = j0, j2 = j0, j3 = j0; f32x4 v0[8], v1[8], v2[8], v3[8]; tr_load(j0, v0, lane);
    if (gw + NGW < n) { j1 = tl_job<TL>(a, gw + NGW); tr_load(j1, v1, lane); }
    if (gw + 2 * NGW < n) { j2 = tl_job<TL>(a, gw + 2 * NGW); tr_load(j2, v2, lane); }
    for (int it = gw; ; it += 4 * NGW) {
        if (it + 3 * NGW < n) { j3 = tl_job<TL>(a, it + 3 * NGW); tr_load(j3, v3, lane); }
        tr_finish(j0, v0, scr, lane);
        if (it + NGW >= n) break;
        if (it + 4 * NGW < n) { j0 = tl_job<TL>(a, it + 4 * NGW); tr_load(j0, v0, lane); }
        tr_finish(j1, v1, scr, lane);
        if (it + 2 * NGW >= n) break;
        if (it + 5 * NGW < n) { j1 = tl_job<TL>(a, it + 5 * NGW); tr_load(j1, v1, lane); }
        tr_finish(j2, v2, scr, lane);
        if (it + 3 * NGW >= n) break;
        if (it + 6 * NGW < n) { j2 = tl_job<TL>(a, it + 6 * NGW); tr_load(j2, v2, lane); }
        tr_finish(j3, v3, scr, lane);
        if (it + 4 * NGW >= n) break;
    }
}
constexpr int NW_GEMV = GV_KS * (MODW / 256);
constexpr int NW_GEMV_A = (GV_KS / 8) * (MODW / 256);
DEV void p0_gemv_item(KArgs a, int l, int it, LAS float* scr, int lane) {
    constexpr int NCB = MODW / 256;
    const int cb = it % NCB, ks = it / NCB;
    const float* c = a->in[I_C]; const float* cctx = a->in[I_CCTX];
    wsync();
    for (int e = lane; e < NGRP * GV_KC; e += 64) { const int g = e / GV_KC, kk = e % GV_KC, k = ks * GV_KC + kk; const float v = (g == 0) ? cctx[k] : c[(size_t)(g - 1) * D + k]; scr[e] = silu_f(v); }
    wsync();
    f32x4 acc[NGRP];
#pragma unroll
    for (int g = 0; g < NGRP; ++g) acc[g] = (f32x4){0.f, 0.f, 0.f, 0.f};
    const float* wp = a->in[I_MODW] + ((size_t)l * D + (size_t)ks * GV_KC) * MODW + cb * 256 + lane * 4;
#pragma unroll 8
    for (int kk = 0; kk < GV_KC; ++kk) { const f32x4 w = __builtin_nontemporal_load((const f32x4*)(wp + (size_t)kk * MODW));
#pragma unroll
        for (int g = 0; g < NGRP; ++g) acc[g] += w * scr[g * GV_KC + kk]; }
    float* po = (float*)(a->ws + WS_MODP) + ((size_t)(ks * 2 + l) * NGRP) * MODW + cb * 256 + lane * 4;
#pragma unroll
    for (int g = 0; g < NGRP; ++g) *(f32x4*)(po + (size_t)g * MODW) = acc[g];
}
DEV void p0_filter_item(KArgs a, int it, LAS float* scr, int lane) {
    const int set = it >= L_P ? 1 : 0, t = set ? it - L_P : it, L = set ? L_S : L_P;
    const float* w1 = a->in[I_HW1]; const float* b1 = a->in[I_HB1]; const float* w2 = a->in[I_HW2]; const float* b2 = a->in[I_HB2]; const float* fr = a->in[I_HFREQ];
    LAS float* z = scr; LAS float* h1 = scr + 64;
    wsync();
    if (lane < 33) { float v;
        if (lane == 0) v = (float)((double)t / (double)(L - 1));
        else { const int i = (lane - 1) & 15; const double fb = 1e-4 + (double)i * ((15.0 - 1e-4) / 15.0); const double w = 2.0 * 3.14159265358979323846 * (double)t / (double)L;
            v = (lane <= 16) ? (float)cos(fb * w) : (float)(-sin(fb * w)); }
        z[lane] = v; }
    wsync();
    { float s = b1[lane];
#pragma unroll 3
      for (int i = 0; i < 33; ++i) s += z[i] * w1[i * 64 + lane]; h1[lane] = sinf(fr[lane] * s); }
    wsync();
    { float s = b2[lane];
#pragma unroll 4
      for (int i = 0; i < 64; ++i) s += h1[i] * w2[i * 64 + lane]; ((float*)(a->ws + WS_H2))[(size_t)it * 64 + lane] = sinf(fr[lane] * s); }
}
DEV void p1_filter_item(KArgs a, int it, LAS float* scr, int lane) {
    const int cb = it & 15, tb = it >> 4; const int it0 = 8 * tb, set = it0 >= L_P ? 1 : 0, t0 = set ? it0 - L_P : it0, L = set ? L_S : L_P;
    const float* w3 = a->in[I_HW3]; const float* H2 = (const float*)(a->ws + WS_H2) + (size_t)it0 * 64;
    wsync();
#pragma unroll
    for (int k = 0; k < 8; ++k) scr[k * 64 + lane] = H2[k * 64 + lane];
    wsync();
    f32x4 acc[8];
#pragma unroll
    for (int k = 0; k < 8; ++k) acc[k] = (f32x4){0.f, 0.f, 0.f, 0.f};
    const float* wp = w3 + cb * 256 + lane * 4;
#pragma unroll 8
    for (int j = 0; j < 64; ++j) { const f32x4 w = *(const f32x4*)(wp + (size_t)j * 4096);
#pragma unroll
        for (int k = 0; k < 8; ++k) acc[k] += w * scr[k * 64 + j]; }
    const int col = cb * 256 + lane * 4, nd = col >> 10, c0 = col & 1023;
    bf16* FT = (bf16*)(a->ws + WS_FILT) + (set ? (size_t)4 * 1024 * L_P : 0);
    const float lo = -3.0701134573253946f, hi = -15.350567286626973f;
#pragma unroll
    for (int i = 0; i < 4; ++i) { const float delta = fabsf(lo + (hi - lo) * ((float)(c0 + i) / 1023.0f)); float v[8];
#pragma unroll
        for (int k = 0; k < 8; ++k) { const float tl = (float)(t0 + k) * (1.0f / (float)(L - 1)); v[k] = acc[k][i] * __expf(-tl * delta); }
        u32x4 o; o.x = pk2(v[0], v[1]); o.y = pk2(v[2], v[3]); o.z = pk2(v[4], v[5]); o.w = pk2(v[6], v[7]);
        *(u32x4*)(FT + ((size_t)(nd * 1024 + c0 + i)) * L + t0) = o; }
}
DEV void p0_prologue(KArgs a, LAS unsigned char* lds, int bid, int G) {
    const int tid = tid_l(), lane = tid & 63, wave = __builtin_amdgcn_readfirstlane(tid >> 6);
    LAS float* scr = (LAS float*)(lds + wave * 16384);
    const int gw = bid * NWAVES + wave, NGW = G * NWAVES;
    for (int it = gw; it < NW_GEMV; it += NGW) p0_gemv_item(a, 0, it, scr, lane);
    run_tr_jobs<0>(a, gw, NGW, scr, lane);
    for (int it = gw; it < L_P + L_S; it += NGW) p0_filter_item(a, it, scr, lane);
    const size_t gt = (size_t)bid * NTHR + tid, NGT = (size_t)G * NTHR;
    { const float* s = a->in[I_CK]; bf16* d = (bf16*)(a->ws + WS_KC); const size_t n = (size_t)NB_S * 2 * PAST * 128 / 4;
      for (size_t i = gt; i < n; i += NGT) { const f32x4 v = *(const f32x4*)(s + 4 * i); u32x2 o; o.x = pk2(v[0], v[1]); o.y = pk2(v[2], v[3]); *(u32x2*)(d + 4 * i) = o; } }
}
DEV void mods_finalize(KArgs a, int l, size_t idx, size_t nthr) {
    const size_t n = (size_t)NGRP * MODW / 4; const float* part = (const float*)(a->ws + WS_MODP); float* mods = (float*)(a->ws + WS_MODS);
    for (size_t i = idx; i < n; i += nthr) { const size_t e = (size_t)l * NGRP * MODW + 4 * i; const int col = (int)((4 * i) % MODW);
        f32x4 s = *(const f32x4*)(a->in[I_MODB] + (size_t)l * MODW + col);
        for (int ks = 0; ks < GV_KS; ++ks) s += *(const f32x4*)(part + (size_t)ks * 2 * NGRP * MODW + e);
        *(f32x4*)(mods + e) = s; }
}
DEV int gemm_groups(int units, int G) { const int r = (units + G - 1) / G; return (units + r - 1) / r; }
template <int ph>
DEV void conv_work(KArgs a, LAS unsigned char* lds, int ib, int nconv) {
    const int tid = tid_l(), lane = tid & 63, wave = __builtin_amdgcn_readfirstlane(tid >> 6);
    LAS float* scr = (LAS float*)(lds + wave * 16384);
    const int gw = ib * NWAVES + wave, NGW = nconv * NWAVES;
    if constexpr (ph == 3) { run_tr_jobs<3>(a, gw, NGW, scr, lane); for (int it = gw; it < NW_GEMV_A; it += NGW) p0_gemv_item(a, 1, it, scr, lane); }
    if constexpr (ph == 6) { for (int it = NW_GEMV_A + gw; it < NW_GEMV; it += NGW) p0_gemv_item(a, 1, it, scr, lane); }
    if constexpr (ph == 12) { mods_finalize(a, 1, (size_t)ib * NTHR + tid, (size_t)nconv * NTHR); run_tr_jobs<12>(a, gw, NGW, scr, lane); }
    if constexpr (ph == 15) run_tr_jobs<15>(a, gw, NGW, scr, lane);
    if constexpr (ph == 18) run_tr_jobs<18>(a, gw, NGW, scr, lane);
}
DEV void p1_mods(KArgs a, LAS unsigned char* lds, int bid, int G) {
    { const int tid = tid_l(), lane = tid & 63, wave = __builtin_amdgcn_readfirstlane(tid >> 6); LAS float* scr = (LAS float*)(lds + wave * 16384);
      for (int it = bid * NWAVES + wave; it < ((L_P + L_S) / 8) * 16; it += G * NWAVES) p1_filter_item(a, it, scr, lane); }
    mods_finalize(a, 0, (size_t)bid * NTHR + tid_l(), (size_t)G * NTHR);
}

DEV const float* modvec(KArgs a, int l, int g, int j) { return (const float*)(a->ws + WS_MODS) + ((size_t)(l * NGRP + g) * NMOD + j) * D; }
DEV void prenorm_store(const f32x4 (&x)[8], const float* gpre, const float* shift, const float* scale, bf16* hrow, int lane) {
    float ss = 0.f;
#pragma unroll
    for (int j = 0; j < 8; ++j) ss += (x[j][0] * x[j][0] + x[j][1] * x[j][1]) + (x[j][2] * x[j][2] + x[j][3] * x[j][3]);
    const float rstd = rsqrtf(wave_sum(ss) * (1.0f / D) + 1e-6f);
#pragma unroll
    for (int j = 0; j < 8; ++j) { const int e = 256 * j + 4 * lane; const f32x4 g = *(const f32x4*)(gpre + e), sh = *(const f32x4*)(shift + e), sc = *(const f32x4*)(scale + e);
        const f32x4 h = x[j] * rstd * g * (1.0f + sc) + sh;
        u32x2 o; o.x = pk2(h[0], h[1]); o.y = pk2(h[2], h[3]); *(u32x2*)(hrow + e) = o; }
}
DEV void phase_norm0(KArgs a, int bid, int G) {
    const int lane = tid_l() & 63, gw = bid * NWAVES + (tid_l() >> 6), NGW = G * NWAVES;
    bf16* HN = (bf16*)(a->ws + WS_HN); const float* ng = a->in[I_NORMG];
    for (int row = gw; row < T; row += NGW) {
        const float* xr = row < TP ? a->in[I_XP] + (size_t)row * D : a->in[I_XS] + (size_t)(row - TP) * D; const int g = grp_of_row(row);
        f32x4 x[8];
#pragma unroll
        for (int j = 0; j < 8; ++j) x[j] = *(const f32x4*)(xr + 256 * j + 4 * lane);
        prenorm_store(x, ng + (size_t)(0 * 6 + 0) * D, modvec(a, 0, g, 0), modvec(a, 0, g, 1), HN + (size_t)row * D, lane);
    }
}
DEV void phase_residual(KArgs a, LAS unsigned char* lds, int bid, int G, int l, int j, float w, int nl, int nj, bool first, bool last) {
    const int tid = tid_l(), lane = tid & 63, wave = tid >> 6;
    LAS float* vec = (LAS float*)lds;
    bf16* HN = (bf16*)(a->ws + WS_HN); const float* ng = a->in[I_NORMG]; _Float16* X = (_Float16*)(a->ws + WS_X);
    const bf16* O0 = (const bf16*)(a->ws + WS_OUT); const bf16* O1 = O0 + (size_t)T * D;
    for (int chunk = bid; chunk < T / 16; chunk += G) {
        const int row0 = 16 * chunk, g = grp_of_row(row0);
        lds_barrier();
        for (int e = tid; e < 5 * D / 4; e += NTHR) { const int v = e / (D / 4), i = 4 * (e % (D / 4)); const float* src;
            if (v == 0) src = modvec(a, l, g, 3 * j + 2); else if (v == 1) src = ng + (size_t)(l * 6 + 2 * j + 1) * D;
            else if (nl < 0) src = ng; else if (v == 2) src = ng + (size_t)(nl * 6 + 2 * nj) * D; else if (v == 3) src = modvec(a, nl, g, 3 * nj); else src = modvec(a, nl, g, 3 * nj + 1);
            *(LAS f32x4*)(vec + v * D + i) = *(const f32x4*)(src + i); }
        lds_barrier();
        u32x2 p0[2][8], p1[2][8]; f32x4 x[2][8]; float ss[2];
#define UNPK_SUM(a_, b_) (f32x4){__uint_as_float((a_).x << 16) + __uint_as_float((b_).x << 16), __uint_as_float((a_).x & 0xffff0000u) + __uint_as_float((b_).x & 0xffff0000u), \
                                 __uint_as_float((a_).y << 16) + __uint_as_float((b_).y << 16), __uint_as_float((a_).y & 0xffff0000u) + __uint_as_float((b_).y & 0xffff0000u)}
#pragma unroll
        for (int rr = 0; rr < 2; ++rr) { const int row = row0 + 2 * wave + rr;
            const float* xr = row < TP ? a->in[I_XP] + (size_t)row * D : a->in[I_XS] + (size_t)(row - TP) * D; const _Float16* xh = X + (size_t)row * D;
#pragma unroll
            for (int k = 0; k < 8; ++k) { const int e = 256 * k + 4 * lane; p0[rr][k] = __builtin_nontemporal_load((const u32x2*)(O0 + (size_t)row * D + e)); p1[rr][k] = __builtin_nontemporal_load((const u32x2*)(O1 + (size_t)row * D + e));
                if (first) x[rr][k] = *(const f32x4*)(xr + e); else x[rr][k] = __builtin_convertvector(__builtin_nontemporal_load((const f16x4*)(xh + e)), f32x4); } }
#pragma unroll
        for (int rr = 0; rr < 2; ++rr) { float s = 0.f;
#pragma unroll
            for (int k = 0; k < 8; ++k) { const f32x4 o = UNPK_SUM(p0[rr][k], p1[rr][k]); s += (o[0] * o[0] + o[1] * o[1]) + (o[2] * o[2] + o[3] * o[3]); }
            ss[rr] = s; }
#pragma unroll
        for (int of = 1; of < 64; of <<= 1) { ss[0] += __shfl_xor(ss[0], of); ss[1] += __shfl_xor(ss[1], of); }
        float s2[2];
#pragma unroll
        for (int rr = 0; rr < 2; ++rr) { const int row = row0 + 2 * wave + rr; const float rstd = rsqrtf(ss[rr] * (1.0f / D) + 1e-6f);
            float* xo = a->out + OUT_Y + (size_t)row * D; _Float16* xoh = X + (size_t)row * D; float s = 0.f;
#pragma unroll
            for (int k = 0; k < 8; ++k) { const int e = 256 * k + 4 * lane; const f32x4 gt = *(const LAS f32x4*)(vec + e), gp = *(const LAS f32x4*)(vec + D + e); const f32x4 o = UNPK_SUM(p0[rr][k], p1[rr][k]);
                x[rr][k] = x[rr][k] + w * gt * (o * rstd * gp);
                if (last) __builtin_nontemporal_store(x[rr][k], (f32x4*)(xo + e)); else __builtin_nontemporal_store(__builtin_convertvector(x[rr][k], f16x4), (f16x4*)(xoh + e));
                s += (x[rr][k][0] * x[rr][k][0] + x[rr][k][1] * x[rr][k][1]) + (x[rr][k][2] * x[rr][k][2] + x[rr][k][3] * x[rr][k][3]); SCHED_FENCE(); }
            s2[rr] = s; }
#undef UNPK_SUM
        if (nl >= 0) {
#pragma unroll
            for (int of = 1; of < 64; of <<= 1) { s2[0] += __shfl_xor(s2[0], of); s2[1] += __shfl_xor(s2[1], of); }
#pragma unroll
            for (int rr = 0; rr < 2; ++rr) { const int row = row0 + 2 * wave + rr; const float rstd = rsqrtf(s2[rr] * (1.0f / D) + 1e-6f);
#pragma unroll
                for (int k = 0; k < 8; ++k) { const int e = 256 * k + 4 * lane; const f32x4 gq = *(const LAS f32x4*)(vec + 2 * D + e), sh = *(const LAS f32x4*)(vec + 3 * D + e), sc = *(const LAS f32x4*)(vec + 4 * D + e);
                    const f32x4 h = x[rr][k] * rstd * gq * (1.0f + sc) + sh; u32x2 ow; ow.x = pk2(h[0], h[1]); ow.y = pk2(h[2], h[3]); *(u32x2*)(HN + (size_t)row * D + e) = ow; SCHED_FENCE(); } }
        }
    }
}
constexpr float LOG2E = 1.4426950408889634f;
DEV void phase_rope_kvout(KArgs a, int bid, int G) {
    const int lane = tid_l() & 63, gw = bid * NWAVES + (tid_l() >> 6), NGW = G * NWAVES;
    bf16* QKV = (bf16*)(a->ws + WS_QKV);
    for (int it = gw; it < TS * 10; it += NGW) {
        const int ts = it / 10, slot = it % 10, pos = ts % L_S; bf16* p = QKV + (size_t)(TP + ts) * NQKV + slot * 128;
        const int half = lane >> 5, dd = lane & 31, d1 = 64 * half + dd;
        const float inv = exp2f(-(float)dd * (13.287712379549449f / 32.0f));
        const float ang = (float)(half ? (pos % 64) : (pos / 64)) * inv; const float cs = fast_cos(ang), sn = fast_sin(ang);
        const float x1 = bf2f(p[d1]), x2 = bf2f(p[d1 + 32]);
        p[d1] = (bf16)f2bf(x1 * cs - x2 * sn); p[d1 + 32] = (bf16)f2bf(x2 * cs + x1 * sn);
    }
    const size_t gt = (size_t)bid * NTHR + tid_l(), NGT = (size_t)G * NTHR; const size_t n = (size_t)NB_P * 2 * L_P * 128;
    for (size_t i = gt; i < 2 * n; i += NGT) { const int isv = i >= n; const size_t o = isv ? i - n : i; const int d = (int)(o % 128), t = (int)((o / 128) % L_P), kvh = (int)((o / ((size_t)128 * L_P)) % 2), b = (int)(o / ((size_t)256 * L_P));
        a->out[(isv ? OUT_V : OUT_K) + o] = bf2f(QKV[(size_t)(b * L_P + t) * NQKV + 1024 + 256 * isv + kvh * 128 + d]); }
}
template <int L, int NB> struct HyRegs { static constexpr int NUC = (3 * NB * L / 8 + NTHR - 1) / NTHR, NFC = (4 * L / 8 + NTHR - 1) / NTHR; u32x4 u[NUC]; u32x4 f[NFC]; float w[3][3], cb[3], hb[2]; };
template <int L, int NB>
DEV void hyena_load(KArgs a, int c, int tok0, const bf16* FT, HyRegs<L, NB>& g, int tid) {
    const bf16* UT = (const bf16*)(a->ws + WS_UT); const float* cw = a->in[I_HCW]; const float* cb = a->in[I_HCB]; const float* hb = a->in[I_HBIAS];
#pragma unroll
    for (int k = 0; k < HyRegs<L, NB>::NUC; ++k) { const int e = tid + NTHR * k; if (e < 3 * NB * L / 8) { const int x = e / (NB * L / 8), i = e % (NB * L / 8), b = i / (L / 8), t8 = i % (L / 8);
        g.u[k] = __builtin_nontemporal_load((const u32x4*)(UT + (size_t)(1024 * x + c) * T + tok0 + b * L + 8 * t8)); } }
#pragma unroll
    for (int k = 0; k < HyRegs<L, NB>::NFC; ++k) { const int e = tid + NTHR * k; if (e < 4 * L / 8) { const int nd = e / (L / 8), t8 = e % (L / 8); g.f[k] = *(const u32x4*)(FT + ((size_t)nd * 1024 + c) * L + 8 * t8); } }
#pragma unroll
    for (int x = 0; x < 3; ++x) { const int ch = 1024 * x + c; g.w[x][0] = cw[ch]; g.w[x][1] = cw[3072 + ch]; g.w[x][2] = cw[2 * 3072 + ch]; g.cb[x] = cb[ch]; }
    g.hb[0] = hb[c]; g.hb[1] = hb[1024 + c];
}
template <int L, int NB>
DEV void hyena_item(KArgs a, LAS unsigned char* lds, int c, int tok0, const HyRegs<L, NB>& g) {
    constexpr int ZP = L + 8, UP = L + 16, NTW = L / 128, NS = L / 32, CS = 2 * L + 32;
    LAS bf16* zin = (LAS bf16*)lds; LAS bf16* z1 = zin + NB * ZP; LAS bf16* R = z1 + NB * ZP; LAS bf16* U = R + 2 * 4 * CS;
    const int tid = tid_l(), lane = tid & 63, wave = tid >> 6, q = lane >> 4, r = lane & 15;
    bf16* YT = (bf16*)(a->ws + WS_YT);
#pragma unroll
    for (int k = 0; k < HyRegs<L, NB>::NUC; ++k) { const int e = tid + NTHR * k; if (e < 3 * NB * L / 8) { const int x = e / (NB * L / 8), i = e % (NB * L / 8), b = i / (L / 8), t8 = i % (L / 8);
        *(LAS u32x4*)(U + (x * NB + b) * UP + 8 + 8 * t8) = g.u[k]; } }
    for (int e = tid; e < 3 * NB * 2; e += NTHR) { const int rowi = e >> 1; U[rowi * UP + ((e & 1) ? 8 + L : 7)] = 0; }
#pragma unroll
    for (int k = 0; k < HyRegs<L, NB>::NFC; ++k) { const int e = tid + NTHR * k; if (e < 4 * L / 8) { const int nd = e / (L / 8), t8 = e % (L / 8), n = nd >> 1, dir = nd & 1; const bf16x8 v = __builtin_bit_cast(bf16x8, g.f[k]);
#pragma unroll
        for (int j = 0; j < 8; ++j) { const int t = 8 * t8 + j; if (dir == 1 && t == 0) continue; const int i = dir ? L + t : L - t;
#pragma unroll
            for (int m = 0; m < 4; ++m) if (i - m >= 0) R[(n * 4 + m) * CS + i - m] = (bf16)v[j]; } } }
    lds_barrier();
    { const float w0 = g.w[0][0], w1 = g.w[0][1], w2 = g.w[0][2], bb = g.cb[0];
      for (int e = tid; e < NB * L / 4; e += NTHR) { const int b = e / (L / 4), t = 4 * (e % (L / 4)); const LAS bf16* u = U + b * UP + 8 + t; float uu[6];
#pragma unroll
          for (int x = 0; x < 6; ++x) uu[x] = bf2f(u[x - 1]);
          u32x2 w; w.x = pk2(bb + w0 * uu[0] + w1 * uu[1] + w2 * uu[2], bb + w0 * uu[1] + w1 * uu[2] + w2 * uu[3]); w.y = pk2(bb + w0 * uu[2] + w1 * uu[3] + w2 * uu[4], bb + w0 * uu[3] + w1 * uu[4] + w2 * uu[5]);
          *(LAS u32x2*)(zin + b * ZP + t) = w; } }
    lds_barrier();
    const int i0 = wave * NTW;
#pragma unroll
    for (int n = 0; n < 2; ++n) {
        const LAS bf16* zi = n == 0 ? zin : z1; const LAS bf16* Rn = R + n * 4 * CS;
        f32x4 acc[NTW];
#pragma unroll
        for (int i = 0; i < NTW; ++i) acc[i] = (f32x4){0.f, 0.f, 0.f, 0.f};
        constexpr int KB = 4, NWV = NTW + 2 * (KB - 1), NKB = NS / KB;
        static_assert(NS % KB == 0, "s-tiles per step");
        const int mshift = (4 - (r & 3)) & 3;
        const LAS bf16* zrow = zi + (r % NB) * ZP + 8 * q; const LAS bf16* Cb = Rn + mshift * CS - mshift + (L - (16 * i0 + r - 8 * q));
#define HY_LOAD(Bf_, Af_, kb_) do { \
            _Pragma("unroll") for (int kk = 0; kk < KB; ++kk) Bf_[kk] = *(const LAS bf16x8*)(zrow + 32 * (KB * (kb_) + kk)); \
            _Pragma("unroll") for (int wv = 0; wv < NWV; ++wv) { const LAS bf16* Cm = Cb + 32 * KB * (kb_) - 16 * (wv - 2 * (KB - 1)); const bf16x4 a0 = *(const volatile LAS bf16x4*)Cm, a1 = *(const volatile LAS bf16x4*)(Cm + 4);     \
                bf16x8 A; A[0] = a0[0]; A[1] = a0[1]; A[2] = a0[2]; A[3] = a0[3]; A[4] = a1[0]; A[5] = a1[1]; A[6] = a1[2]; A[7] = a1[3]; Af_[wv] = A; } } while (0)
#define HY_MMA(Bf_, Af_) do { \
            _Pragma("unroll") for (int kk = 0; kk < KB; ++kk) _Pragma("unroll") for (int ii = 0; ii < NTW; ++ii) acc[ii] = mfma16(Af_[ii - 2 * kk + 2 * (KB - 1)], Bf_[kk], acc[ii]); } while (0)
        bf16x8 Bf0[KB], Af0[NWV], Bf1[KB], Af1[NWV];
        HY_LOAD(Bf0, Af0, 0);
        for (int kb = 0; kb < NKB; kb += 2) {
            if (kb + 1 < NKB) HY_LOAD(Bf1, Af1, kb + 1);
            HY_MMA(Bf0, Af0);
            if (kb + 1 >= NKB) break;
            if (kb + 2 < NKB) HY_LOAD(Bf0, Af0, kb + 2);
            HY_MMA(Bf1, Af1);
        }
#undef HY_LOAD
#undef HY_MMA
        if (r < NB) {
            const float w0 = g.w[n + 1][0], w1 = g.w[n + 1][1], w2 = g.w[n + 1][2], bb = g.cb[n + 1], hbias = g.hb[n];
            const LAS bf16* ug = U + ((n + 1) * NB + r) * UP + 8;
#pragma unroll
            for (int ti = 0; ti < NTW; ++ti) { const int t = 16 * (i0 + ti) + 4 * q; float uu[6];
#pragma unroll
                for (int x = 0; x < 6; ++x) uu[x] = bf2f(ug[t - 1 + x]);
                float o[4];
#pragma unroll
                for (int x = 0; x < 4; ++x) { const float gate = bb + w0 * uu[x] + w1 * uu[x + 1] + w2 * uu[x + 2]; o[x] = gate * (acc[ti][x] + hbias * bf2f(zi[r * ZP + t + x])); }
                u32x2 w; w.x = pk2(o[0], o[1]); w.y = pk2(o[2], o[3]);
                if (n == 0) *(LAS u32x2*)(z1 + r * ZP + t) = w; else __builtin_nontemporal_store(w, (u32x2*)(YT + (size_t)c * T + tok0 + r * L + t)); }
        }
        lds_barrier();
    }
}
template <int L, int NB>
DEV void hyena_run(KArgs a, LAS unsigned char* lds, int first, int last, int G, int cbase, int tok0, const bf16* FT) {
    if (first >= last) return;
    const int tid = tid_l();
    HyRegs<L, NB> cur; hyena_load<L, NB>(a, first - cbase, tok0, FT, cur, tid);
    for (int it = first; it < last; it += G) {
        HyRegs<L, NB> nx = cur; const int nxt = it + G;
        if (nxt < last) hyena_load<L, NB>(a, nxt - cbase, tok0, FT, nx, tid);
        hyena_item<L, NB>(a, lds, it - cbase, tok0, cur);
        cur = nx;
    }
}
DEV void phase_hyena(KArgs a, LAS unsigned char* lds, int bid, int G) {
    const bf16* fp = (const bf16*)(a->ws + WS_FILT); const bf16* fs = fp + (size_t)4 * 1024 * L_P;
    hyena_run<L_S, NB_S>(a, lds, bid, 1024, G, 0, TP, fs);
    const int firstp = bid + ((1024 - bid + G - 1) / G) * G;
    hyena_run<L_P, NB_P>(a, lds, firstp, 2048, G, 1024, 0, fp);
    __syncthreads();
}

template <int NKS, bool WIN>
DEV void attn_segment(float& m, float& lsum, f32x4 (&o)[8], const bf16x8 (&Q)[NKS], const bf16* K, int ldk, const bf16* KR, const bf16* VT, int ldvt, int k0, int k1, int qpos, float sc, int r, int q) {
    for (int kt = k0; kt < k1; kt += 32) {
        f32x4 s[2];
#pragma unroll
        for (int tl = 0; tl < 2; ++tl) { s[tl] = (f32x4){0.f, 0.f, 0.f, 0.f}; const bf16* krow = K + (size_t)(kt + 16 * tl + r) * ldk + 8 * q;
#pragma unroll
            for (int ks = 0; ks < 4; ++ks) s[tl] = mfma16(ld_bf16x8(krow + 32 * ks), Q[ks], s[tl]);
            if constexpr (NKS > 4) { const bf16* kr = KR + (size_t)(kt + 16 * tl + r) * 64 + 8 * q;
#pragma unroll
                for (int ks = 4; ks < NKS; ++ks) s[tl] = mfma16(ld_bf16x8(kr + 32 * (ks - 4)), Q[ks], s[tl]); } }
        float p[8]; float tmax = -1e30f;
#pragma unroll
        for (int tl = 0; tl < 2; ++tl)
#pragma unroll
            for (int x = 0; x < 4; ++x) { float v = s[tl][x] * sc; if (WIN) { const int dlt = kt + 16 * tl + 4 * q + x - qpos; if (dlt > 128 || dlt < -128) v = -1e30f; } p[4 * tl + x] = v; tmax = fmaxf(tmax, v); }
        tmax = fmaxf(tmax, __shfl_xor(tmax, 16)); tmax = fmaxf(tmax, __shfl_xor(tmax, 32));
        const float mnew = fmaxf(m, tmax), alpha = exp2f(m - mnew); float psum = 0.f;
#pragma unroll
        for (int x = 0; x < 8; ++x) { p[x] = exp2f(p[x] - mnew); psum += p[x]; }
        lsum = lsum * alpha + psum; m = mnew;
        bf16x8 P;
#pragma unroll
        for (int x = 0; x < 8; ++x) P[x] = (short)f2bf(p[x]);
#pragma unroll
        for (int dt = 0; dt < 8; ++dt) { const bf16* vp = VT + (size_t)(16 * dt + r) * ldvt + kt + 4 * q; const bf16x4 v0 = *(const bf16x4*)vp, v1 = *(const bf16x4*)(vp + 16);
            bf16x8 V; V[0] = v0[0]; V[1] = v0[1]; V[2] = v0[2]; V[3] = v0[3]; V[4] = v1[0]; V[5] = v1[1]; V[6] = v1[2]; V[7] = v1[3];
            o[dt] = mfma16(V, P, o[dt] * alpha); }
    }
}
DEV void attn_store(const f32x4 (&o)[8], float lsum, bf16* orow  , int q) {
    lsum = xrow16_sum(lsum); const float inv = fast_rcp(lsum);
#pragma unroll
    for (int dt = 0; dt < 8; ++dt) { u32x2 w; w.x = pk2(o[dt][0] * inv, o[dt][1] * inv); w.y = pk2(o[dt][2] * inv, o[dt][3] * inv); *(u32x2*)(orow + 16 * dt + 4 * q) = w; }
}
DEV void phase_attn_even(KArgs a, int bid, int G) {
    const int lane = tid_l() & 63, gw = bid * NWAVES + (tid_l() >> 6), NGW = G * NWAVES, r = lane & 15, q = lane >> 4;
    const bf16* QKV = (const bf16*)(a->ws + WS_QKV); const bf16* VTE = (const bf16*)(a->ws + WS_VTE); const bf16* KC = (const bf16*)(a->ws + WS_KC); const bf16* VTC = (const bf16*)(a->ws + WS_VTC);
    bf16* MIX = (bf16*)(a->ws + WS_MIX); const float* sink = a->in[I_SINK];
    constexpr int NQS = L_S / 16, NQP = L_P / 16, NI_S = NB_S * 2 * NQS * 4, NI_P = NB_P * 2 * NQP * 4;
    const float sc = 0.08838834764831845f * LOG2E;
    for (int it = gw; it < NI_S + NI_P; it += NGW) {
        const bool smp = it < NI_S; const int i2 = smp ? it : it - NI_S; const int g = i2 & 3, NQ = smp ? NQS : NQP, qt = (i2 >> 2) % NQ, bk = (i2 >> 2) / NQ, kvh = bk & 1, b = bk >> 1;
        const int head = kvh * 4 + g, seq0 = smp ? TP + b * L_S : b * L_P, q0 = 16 * qt;
        const bf16* qrow = QKV + (size_t)(seq0 + q0 + r) * NQKV + head * 128 + 8 * q;
        bf16x8 Q[4];
#pragma unroll
        for (int ks = 0; ks < 4; ++ks) Q[ks] = ld_bf16x8(qrow + 32 * ks);
        float m = sink[head] * LOG2E, lsum = (q == 0) ? 1.0f : 0.0f; f32x4 o[8];
#pragma unroll
        for (int dt = 0; dt < 8; ++dt) o[dt] = (f32x4){0.f, 0.f, 0.f, 0.f};
        const bf16* K = QKV + (size_t)seq0 * NQKV + 1024 + kvh * 128; const bf16* VT = VTE + (size_t)(kvh * 128) * T + seq0;
        if (smp) {
            int k0 = q0 - 128; if (k0 < 0) k0 = 0; k0 &= ~31; int k1 = (q0 + 16 + 128 + 31) & ~31; if (k1 > L_S) k1 = L_S;
            attn_segment<4, true>(m, lsum, o, Q, K, NQKV, nullptr, VT, T, k0, k1, q0 + r, sc, r, q);
            attn_segment<4, false>(m, lsum, o, Q, KC + (size_t)((b * 2 + kvh) * PAST) * 128, 128, nullptr, VTC + (size_t)((b * 2 + kvh) * 128) * PAST, PAST, 0, PAST, 0, sc, r, q);
        } else attn_segment<4, false>(m, lsum, o, Q, K, NQKV, nullptr, VT, T, 0, L_P, 0, sc, r, q);
        attn_store(o, lsum, MIX + (size_t)(seq0 + q0 + r) * D + 1024 + head * 128, q);
    }
}
DEV void phase_ytrans(KArgs a, LAS unsigned char* lds, int bid, int G) {
    const int lane = tid_l() & 63, wave = tid_l() >> 6, gw = bid * NWAVES + wave, NGW = G * NWAVES;
    LAS bf16* scr = (LAS bf16*)(lds + wave * 16384); constexpr int PT = 36;
    const bf16* YT = (const bf16*)(a->ws + WS_YT); bf16* MIX = (bf16*)(a->ws + WS_MIX);
    for (int it = gw; it < 32 * (T / 64); it += NGW) { const int c0 = 32 * (it % 32), t0 = 64 * (it / 32);
        wsync();
#pragma unroll
        for (int rr = 0; rr < 8; ++rr) { const int c = 4 * rr + (lane >> 4), tk = (lane & 15) * 4; const bf16x4 v = *(const bf16x4*)(YT + (size_t)(c0 + c) * T + t0 + tk);
#pragma unroll
            for (int x = 0; x < 4; ++x) scr[(tk + x) * PT + c] = (bf16)v[x]; }
        wsync();
#pragma unroll
        for (int rr = 0; rr < 8; ++rr) { const int tk = 8 * rr + (lane >> 3), cc = (lane & 7) * 4; *(u32x2*)(MIX + (size_t)(t0 + tk) * D + c0 + cc) = *(const LAS u32x2*)(scr + tk * PT + cc); }
    }
}
#ifdef EMU
DEV bool ANY_LANE(bool p) { int v = p ? 1 : 0; for (int o = 1; o < 64; o <<= 1) v |= __shfl_xor(v, o); return v != 0; }
#else
DEV bool ANY_LANE(bool p) { return __builtin_amdgcn_ballot_w64(p) != 0ull; }
#endif
struct AttnSeg { const bf16* K; const bf16* KR; const bf16* VT; int ldk, ldvt, ntiles, kt0; };
template <int DQK> struct AttnLds { static constexpr int KP = DQK + 8, KB = 32 * KP * 2, VB = 128 * 40 * 2, BUF = KB + VB; };
template <int DQK>
DEV void attn_tile_load(const AttnSeg& s, int kt, u32x4 (&kreg)[2], u32x4& vreg, int tid) {
    constexpr int CPR = DQK / 8;
#pragma unroll
    for (int i = 0; i < 2; ++i) { const int c = tid + 512 * i; if (c < 32 * CPR) { const int key = c / CPR, part = c % CPR;
        const bf16* p = (part < 16) ? s.K + (size_t)(kt + key) * s.ldk + part * 8 : s.KR + (size_t)(kt + key) * 64 + (part - 16) * 8; kreg[i] = *(const u32x4*)p; } }
    { const int dv = tid >> 2, kc = tid & 3; vreg = *(const u32x4*)(s.VT + (size_t)dv * s.ldvt + kt + 8 * kc); }
}
template <int DQK>
DEV void attn_tile_store(LAS unsigned char* buf, const u32x4 (&kreg)[2], const u32x4& vreg, int tid) {
    constexpr int CPR = DQK / 8, KP = AttnLds<DQK>::KP;
#pragma unroll
    for (int i = 0; i < 2; ++i) { const int c = tid + 512 * i; if (c < 32 * CPR) { const int key = c / CPR, part = c % CPR; *(LAS u32x4*)(buf + (key * KP + part * 8) * 2) = kreg[i]; } }
    { const int dv = tid >> 2, kc = tid & 3; LAS unsigned char* vb = buf + AttnLds<DQK>::KB + dv * 80;
      const int k4a = 2 * kc, k4b = 2 * kc + 1;
      *(LAS u32x2*)(vb + (8 * (k4a & 3) + 4 * (k4a >> 2)) * 2) = (u32x2){vreg.x, vreg.y}; *(LAS u32x2*)(vb + (8 * (k4b & 3) + 4 * (k4b >> 2)) * 2) = (u32x2){vreg.z, vreg.w}; }
}
template <int DQK, int QT>
DEV void attn_block(LAS unsigned char* lds, const AttnSeg& s0, const AttnSeg& s1, const bf16x8 (&Q)[QT][DQK / 32], float m0, float l0, bool active, bool win, int qw0, float sc,
                    bf16* orow0  , int tid) {
    constexpr int NKS = DQK / 32, KP = AttnLds<DQK>::KP, BUF = AttnLds<DQK>::BUF;
    const int lane = tid & 63, r = lane & 15, q = lane >> 4;
    float m[QT], ls[QT]; f32x4 o[QT][8];
#pragma unroll
    for (int qi = 0; qi < QT; ++qi) { m[qi] = m0; ls[qi] = (q == 0) ? l0 : 0.f;
#pragma unroll
        for (int dt = 0; dt < 8; ++dt) o[qi][dt] = (f32x4){0.f, 0.f, 0.f, 0.f}; }
    const int nt = s0.ntiles + s1.ntiles;
    u32x4 kreg[2]; u32x4 vreg;
    __syncthreads();
    attn_tile_load<DQK>(s0, s0.kt0, kreg, vreg, tid);
    attn_tile_store<DQK>(lds, kreg, vreg, tid);
    __syncthreads();
    for (int ti = 0; ti < nt; ++ti) {
        LAS unsigned char* cur = lds + (ti & 1) * BUF; LAS unsigned char* nxt = lds + ((ti + 1) & 1) * BUF;
        const bool has_next = ti + 1 < nt;
        if (has_next) { const int tn = ti + 1; if (tn < s0.ntiles) attn_tile_load<DQK>(s0, s0.kt0 + 32 * tn, kreg, vreg, tid); else attn_tile_load<DQK>(s1, s1.kt0 + 32 * (tn - s0.ntiles), kreg, vreg, tid); }
        const bool seg0 = ti < s0.ntiles; const int kt = seg0 ? s0.kt0 + 32 * ti : s1.kt0 + 32 * (ti - s0.ntiles);
        const bool wmask = win && seg0;
        bool doit = active;
        if (wmask) doit = doit && (kt + 31 >= qw0 - 128) && (kt <= qw0 + 16 * QT - 1 + 128);
        if (doit) {
            f32x4 sacc[QT][2];
#pragma unroll
            for (int tl = 0; tl < 2; ++tl) { bf16x8 Kf[NKS];
#pragma unroll
                for (int ks = 0; ks < NKS; ++ks) Kf[ks] = *(const LAS bf16x8*)(cur + ((16 * tl + r) * KP + 32 * ks + 8 * q) * 2);
#pragma unroll
                for (int qi = 0; qi < QT; ++qi) { sacc[qi][tl] = (f32x4){0.f, 0.f, 0.f, 0.f};
#pragma unroll
                    for (int ks = 0; ks < NKS; ++ks) sacc[qi][tl] = mfma16(Kf[ks], Q[qi][ks], sacc[qi][tl]); } }
            bf16x8 P[QT]; float alpha[QT]; bool moved = false;
#pragma unroll
            for (int qi = 0; qi < QT; ++qi) {
                const f32x4 (&s)[2] = sacc[qi];
                float p[8]; float tmax = -1e30f; const int qpos = qw0 + 16 * qi + r;
#pragma unroll
                for (int tl = 0; tl < 2; ++tl)
#pragma unroll
                    for (int x = 0; x < 4; ++x) { float v = s[tl][x]; if (wmask) { const int dlt = kt + 16 * tl + 4 * q + x - qpos; if (dlt > 128 || dlt < -128) v = -1e30f; } p[4 * tl + x] = v; tmax = fmaxf(tmax, v); }
                tmax = xrow16_max(tmax);
                const float mnew = fmaxf(m[qi], tmax * sc); alpha[qi] = fast_exp2(m[qi] - mnew); moved = moved || (mnew > m[qi]); float psum = 0.f;
#pragma unroll
                for (int x = 0; x < 8; ++x) { p[x] = fast_exp2(__builtin_fmaf(p[x], sc, -mnew)); psum += p[x]; }
                ls[qi] = ls[qi] * alpha[qi] + psum; m[qi] = mnew;
                { u32x4 pw; pw.x = pk2(p[0], p[1]); pw.y = pk2(p[2], p[3]); pw.z = pk2(p[4], p[5]); pw.w = pk2(p[6], p[7]); P[qi] = __builtin_bit_cast(bf16x8, pw); }
            }
            if (ANY_LANE(moved)) {
#pragma unroll
                for (int qi = 0; qi < QT; ++qi)
#pragma unroll
                    for (int dt = 0; dt < 8; ++dt) o[qi][dt] = o[qi][dt] * alpha[qi];
            }
#pragma unroll
            for (int dt = 0; dt < 8; ++dt) { const bf16x8 V = *(const LAS bf16x8*)(cur + AttnLds<DQK>::KB + (16 * dt + r) * 80 + 16 * q);
#pragma unroll
                for (int qi = 0; qi < QT; ++qi) o[qi][dt] = mfma16(V, P[qi], o[qi][dt]);
                SCHED_FENCE(); }
        }
        if (has_next) attn_tile_store<DQK>(nxt, kreg, vreg, tid);
        __syncthreads();
    }
    if (active) {
#pragma unroll
        for (int qi = 0; qi < QT; ++qi) attn_store(o[qi], ls[qi], orow0 + (size_t)(16 * qi + r) * D, q);
    }
}
constexpr int PO_QH = 0, PO_FF = 1024, PO_FB = 2048, PO_IH = 3072, PO_GH = 4096, PO_QL = 5120, PO_KVL = 5632, PO_KRP = 5888;
DEV void phase_mla_prep(KArgs a, int bid, int G) {
    const int lane = tid_l() & 63, gw = bid * NWAVES + (tid_l() >> 6), NGW = G * NWAVES;
    const bf16* P = (const bf16*)(a->ws + WS_P); bf16* QN = (bf16*)(a->ws + WS_QN); bf16* CKV = (bf16*)(a->ws + WS_CKV); bf16* KR = (bf16*)(a->ws + WS_KR);
    const float* qn = a->in[I_QNORM]; const float* kvn = a->in[I_KVNORM];
    for (int row = gw; row < T; row += NGW) {
        const bf16* pr = P + (size_t)row * OD_INP;
        { float v[8]; float ss = 0.f; const bf16x8 x = ld_bf16x8(pr + PO_QL + 8 * lane);
#pragma unroll
          for (int i = 0; i < 8; ++i) { v[i] = bf2f((bf16)x[i]); ss += v[i] * v[i]; }
          const float rstd = rsqrtf(wave_sum(ss) * (1.0f / 512.0f) + 1e-6f); u32x4 o;
          o.x = pk2(v[0] * rstd * qn[8 * lane + 0], v[1] * rstd * qn[8 * lane + 1]); o.y = pk2(v[2] * rstd * qn[8 * lane + 2], v[3] * rstd * qn[8 * lane + 3]);
          o.z = pk2(v[4] * rstd * qn[8 * lane + 4], v[5] * rstd * qn[8 * lane + 5]); o.w = pk2(v[6] * rstd * qn[8 * lane + 6], v[7] * rstd * qn[8 * lane + 7]);
          *(u32x4*)(QN + (size_t)row * 512 + 8 * lane) = o; }
        { float v[4]; float ss = 0.f; const bf16x4 x = *(const bf16x4*)(pr + PO_KVL + 4 * lane);
#pragma unroll
          for (int i = 0; i < 4; ++i) { v[i] = bf2f((bf16)x[i]); ss += v[i] * v[i]; }
          const float rstd = rsqrtf(wave_sum(ss) * (1.0f / 256.0f) + 1e-6f);
#pragma unroll
          for (int i = 0; i < 4; ++i) v[i] = v[i] * rstd * kvn[4 * lane + i];
          u32x2 o; o.x = pk2(v[0], v[1]); o.y = pk2(v[2], v[3]); *(u32x2*)(CKV + (size_t)row * 256 + 4 * lane) = o;
          if (row < TP) *(f32x4*)(a->out + OUT_CKV + (size_t)row * 256 + 4 * lane) = (f32x4){v[0], v[1], v[2], v[3]}; }
        { const float x = bf2f(pr[PO_KRP + lane]);
          if (row < TP) { KR[(size_t)row * 64 + lane] = pr[PO_KRP + lane]; a->out[OUT_KR + (size_t)row * 64 + lane] = x; }
          else { const int pos = (row - TP) % L_S, half = lane >> 5, dd = lane & 15, hi = (lane >> 4) & 1;
              const float inv = exp2f(-(float)dd * (13.287712379549449f / 16.0f)); const float ang = (float)(half ? (pos % 64) : (pos / 64)) * inv; const float cs = fast_cos(ang), sn = fast_sin(ang);
              const float other = __shfl_xor(x, 16);
              const float y = hi ? (x * cs + other * sn) : (x * cs - other * sn);
              KR[(size_t)row * 64 + lane] = (bf16)f2bf(y); } }
    }
    const size_t gt = (size_t)bid * NTHR + tid_l(), NGT = (size_t)G * NTHR;
    { const float* s = a->in[I_CCKV]; bf16* d = (bf16*)(a->ws + WS_CKV) + (size_t)T * 256; const size_t n = (size_t)CTX * 256 / 4;
      for (size_t i = gt; i < n; i += NGT) { const f32x4 v = *(const f32x4*)(s + 4 * i); u32x2 o; o.x = pk2(v[0], v[1]); o.y = pk2(v[2], v[3]); *(u32x2*)(d + 4 * i) = o; } }
    { const float* s = a->in[I_CKR]; bf16* d = (bf16*)(a->ws + WS_KR) + (size_t)T * 64; const size_t n = (size_t)CTX * 64 / 4;
      for (size_t i = gt; i < n; i += NGT) { const f32x4 v = *(const f32x4*)(s + 4 * i); u32x2 o; o.x = pk2(v[0], v[1]); o.y = pk2(v[2], v[3]); *(u32x2*)(d + 4 * i) = o; } }
}

constexpr int HG_QD = 0, HG_KD = HG_QD + 64 * 136 * 2, HG_KT = HG_KD + 64 * 136 * 2, HG_VT = HG_KT + 128 * 72 * 2, HG_AL = HG_VT + 128 * 72 * 2, HG_ST = HG_AL + 64 * 72 * 2,
              HG_TOT = HG_ST + 128 * 136 * 2, HG_BEND = HG_TOT + 8 * 128 * 4, HG_END = HG_BEND + 128 * 4;
static_assert(HG_END <= RING_BYTES, "HGRN LDS");
DEV void hgrn_load(const bf16* P, int seq0, int L, int dir, int n, int cg, int colf, int colq, int colv, unsigned (&rf)[8], unsigned (&rq)[8], unsigned (&rv)[8]) {
#pragma unroll
    for (int i = 0; i < 8; ++i) { const int cpos = 64 * n + 8 * cg + i; const int tok = seq0 + (dir ? (L - 1 - cpos) : cpos); const bf16* p = P + (size_t)tok * OD_INP;
        rf[i] = *(const unsigned*)(p + colf); rq[i] = *(const unsigned*)(p + colq); rv[i] = *(const unsigned*)(p + colv); }
}
DEV void hgrn_item(KArgs a, LAS unsigned char* lds, int seq0, int L, int h, int dir, const float* S0  , float* Sout  ) {
    const int tid = tid_l(), lane = tid & 63, wave = tid >> 6, q = lane >> 4, r = lane & 15;
    LAS bf16* qd = (LAS bf16*)(lds + HG_QD); LAS bf16* kd = (LAS bf16*)(lds + HG_KD); LAS bf16* kT = (LAS bf16*)(lds + HG_KT); LAS bf16* vT = (LAS bf16*)(lds + HG_VT);
    LAS bf16* aL = (LAS bf16*)(lds + HG_AL); LAS bf16* sT = (LAS bf16*)(lds + HG_ST); LAS float* tot = (LAS float*)(lds + HG_TOT); LAS float* bend = (LAS float*)(lds + HG_BEND);
    const bf16* P = (const bf16*)(a->ws + WS_P); _Float16* OD = (_Float16*)(a->ws + WS_HFF) + (size_t)dir * T * 1024;
    const int d = 2 * (tid & 63), cg = tid >> 6;
    float lb[2];
#pragma unroll
    for (int y = 0; y < 2; ++y) lb[y] = sigmoid_f(a->in[I_HGLB][(size_t)(1 * 2 + dir) * 1024 + h * 128 + d + y] - a->in[I_HGLB][(size_t)(0 * 2 + dir) * 1024 + h * 128 + d + y]);
    const int colf = (dir ? PO_FB : PO_FF) + h * 128 + d, colq = PO_QH + h * 128 + d, colv = PO_IH + h * 128 + d;
    f32x4 S[8];
#pragma unroll
    for (int dvt = 0; dvt < 8; ++dvt) S[dvt] = (f32x4){0.f, 0.f, 0.f, 0.f};
    if (S0) {
#pragma unroll
        for (int dvt = 0; dvt < 8; ++dvt)
#pragma unroll
            for (int x = 0; x < 4; ++x) S[dvt][x] = S0[(size_t)(16 * wave + 4 * q + x) * 128 + 16 * dvt + r]; }
#pragma unroll
    for (int dvt = 0; dvt < 8; ++dvt) {
        u32x2 w; w.x = pk2(S[dvt][0], S[dvt][1]); w.y = pk2(S[dvt][2], S[dvt][3]); *(LAS u32x2*)(sT + (16 * dvt + r) * 136 + 16 * wave + 4 * q) = w; }
    const int nch = L / 64;
    unsigned rf[8], rq[8], rv[8];
    hgrn_load(P, seq0, L, dir, 0, cg, colf, colq, colv, rf, rq, rv);
    f16x4 opend[4]; _Float16* opend_p = OD;
#pragma unroll
    for (int x = 0; x < 4; ++x) opend[x] = (f16x4){0, 0, 0, 0};
    for (int n = 0; n < nch; ++n) {
        if (n > 0) {
#pragma unroll
            for (int x = 0; x < 4; ++x) __builtin_nontemporal_store(opend[x], (f16x4*)(opend_p + 16 * x)); }
        unsigned nf[8], nq[8], nv[8];
        if (n + 1 < nch) hgrn_load(P, seq0, L, dir, n + 1, cg, colf, colq, colv, nf, nq, nv);
        float lf[2][8], kk[2][8], run[2] = {0.f, 0.f};
#pragma unroll
        for (int i = 0; i < 8; ++i)
#pragma unroll
            for (int y = 0; y < 2; ++y) { const float fz = y ? __uint_as_float(rf[i] & 0xffff0000u) : __uint_as_float(rf[i] << 16); const float f = lb[y] + (1.0f - lb[y]) * sigmoid_f(fz);
                kk[y][i] = 1.0f - f; run[y] += __logf(f); lf[y][i] = run[y]; }
        *(LAS f32x2*)(tot + cg * 128 + d) = (f32x2){run[0], run[1]};
        lds_barrier();
        float base[2] = {0.f, 0.f}, be[2] = {0.f, 0.f};
#pragma unroll
        for (int x = 0; x < 8; ++x) { const f32x2 tv = *(const LAS f32x2*)(tot + x * 128 + d); if (x < cg) { base[0] += tv[0]; base[1] += tv[1]; } be[0] += tv[0]; be[1] += tv[1]; }
        const float bendv[2] = {__expf(be[0]), __expf(be[1])};
        if (cg == 0) *(LAS f32x2*)(bend + d) = (f32x2){bendv[0], bendv[1]};
        { float kef[2][8]; unsigned kev[2][4], vv[2][4];
#pragma unroll
          for (int i = 0; i < 8; ++i) { float qdf[2], kdf[2];
#pragma unroll
              for (int y = 0; y < 2; ++y) { const float b = base[y] + lf[y][i]; const float qv = silu_f(y ? __uint_as_float(rq[i] & 0xffff0000u) : __uint_as_float(rq[i] << 16));
                  const float eb = __expf(b), enb = __expf(-b); qdf[y] = qv * eb; kdf[y] = kk[y][i] * enb; kef[y][i] = kk[y][i] * (bendv[y] * enb); }
              *(LAS unsigned*)(qd + (8 * cg + i) * 136 + d) = pk2(qdf[0], qdf[1]); *(LAS unsigned*)(kd + (8 * cg + i) * 136 + d) = pk2(kdf[0], kdf[1]); }
#pragma unroll
          for (int y = 0; y < 2; ++y)
#pragma unroll
              for (int i2 = 0; i2 < 4; ++i2) { kev[y][i2] = pk2(kef[y][2 * i2], kef[y][2 * i2 + 1]);
                  vv[y][i2] = y ? ((rv[2 * i2] >> 16) | (rv[2 * i2 + 1] & 0xffff0000u)) : ((rv[2 * i2] & 0xffffu) | (rv[2 * i2 + 1] << 16)); }
#pragma unroll
          for (int y = 0; y < 2; ++y) { *(LAS u32x4*)(kT + (d + y) * 72 + 8 * cg) = (u32x4){kev[y][0], kev[y][1], kev[y][2], kev[y][3]}; *(LAS u32x4*)(vT + (d + y) * 72 + 8 * cg) = (u32x4){vv[y][0], vv[y][1], vv[y][2], vv[y][3]}; } }
        lds_barrier();
        { const int ct = wave & 3, sp = wave >> 2;
#pragma unroll
          for (int x = 0; x < 2; ++x) { const int st = 2 * sp + x; f32x4 acc = (f32x4){0.f, 0.f, 0.f, 0.f};
#pragma unroll
              for (int ks = 0; ks < 4; ++ks) acc = mfma16(*(const LAS bf16x8*)(kd + (16 * st + r) * 136 + 32 * ks + 8 * q), *(const LAS bf16x8*)(qd + (16 * ct + r) * 136 + 32 * ks + 8 * q), acc);
              const int cc = 16 * ct + r, s0 = 16 * st + 4 * q; float v[4];
#pragma unroll
              for (int y = 0; y < 4; ++y) v[y] = (s0 + y <= cc) ? acc[y] : 0.f;
              u32x2 w; w.x = pk2(v[0], v[1]); w.y = pk2(v[2], v[3]); *(LAS u32x2*)(aL + cc * 72 + s0) = w; } }
        lds_barrier();
        { const int ct = wave & 3, dv0 = 4 * (wave >> 2);
          bf16x8 Ba[2], Bq[4];
#pragma unroll
          for (int kx = 0; kx < 2; ++kx) Ba[kx] = *(const LAS bf16x8*)(aL + (16 * ct + r) * 72 + 32 * kx + 8 * q);
#pragma unroll
          for (int ks = 0; ks < 4; ++ks) Bq[ks] = *(const LAS bf16x8*)(qd + (16 * ct + r) * 136 + 32 * ks + 8 * q);
          const int cpos = 64 * n + 16 * ct + r; const int tok = seq0 + (dir ? (L - 1 - cpos) : cpos);
#pragma unroll
          for (int x = 0; x < 4; ++x) { const int dvt = dv0 + x; f32x4 acc = (f32x4){0.f, 0.f, 0.f, 0.f};
#pragma unroll
              for (int kx = 0; kx < 2; ++kx) acc = mfma16(*(const LAS bf16x8*)(vT + (16 * dvt + r) * 72 + 32 * kx + 8 * q), Ba[kx], acc);
#pragma unroll
              for (int ks = 0; ks < 4; ++ks) acc = mfma16(*(const LAS bf16x8*)(sT + (16 * dvt + r) * 136 + 32 * ks + 8 * q), Bq[ks], acc);
              opend[x] = __builtin_convertvector(acc, f16x4); }
          opend_p = OD + (size_t)tok * 1024 + h * 128 + 16 * dv0 + 4 * q; }
        { bf16x8 Ak[2];
#pragma unroll
          for (int kx = 0; kx < 2; ++kx) Ak[kx] = *(const LAS bf16x8*)(kT + (16 * wave + r) * 72 + 32 * kx + 8 * q);
          const f32x4 dec = *(const LAS f32x4*)(bend + 16 * wave + 4 * q);
#pragma unroll
          for (int dvt = 0; dvt < 8; ++dvt) { f32x4 acc = S[dvt] * dec;
#pragma unroll
              for (int kx = 0; kx < 2; ++kx) acc = mfma16(Ak[kx], *(const LAS bf16x8*)(vT + (16 * dvt + r) * 72 + 32 * kx + 8 * q), acc);
              S[dvt] = acc; } }
        lds_barrier();
#pragma unroll
        for (int dvt = 0; dvt < 8; ++dvt) { u32x2 w; w.x = pk2(S[dvt][0], S[dvt][1]); w.y = pk2(S[dvt][2], S[dvt][3]); *(LAS u32x2*)(sT + (16 * dvt + r) * 136 + 16 * wave + 4 * q) = w; }
#pragma unroll
        for (int i = 0; i < 8; ++i) { rf[i] = nf[i]; rq[i] = nq[i]; rv[i] = nv[i]; }
    }
#pragma unroll
    for (int x = 0; x < 4; ++x) __builtin_nontemporal_store(opend[x], (f16x4*)(opend_p + 16 * x));
    if (Sout) {
#pragma unroll
        for (int dvt = 0; dvt < 8; ++dvt)
#pragma unroll
            for (int x = 0; x < 4; ++x) Sout[(size_t)(16 * wave + 4 * q + x) * 128 + 16 * dvt + r] = S[dvt][x];
    }
    __syncthreads();
}
DEV void hgrn_run(KArgs a, LAS unsigned char* lds, int item) {
    constexpr int NSI = NB_S * 8 * 2;
    const bool smp = item < NSI; const int i2 = smp ? item : item - NSI; const int dir = i2 & 1, h = (i2 >> 1) & 7, b = i2 >> 4;
    if (smp) hgrn_item(a, lds, TP + b * L_S, L_S, h, dir, a->in[I_ST] + ((size_t)(b * 2 + dir) * 8 + h) * 16384, nullptr);
    else hgrn_item(a, lds, b * L_P, L_P, h, dir, nullptr, a->out + OUT_ST + ((size_t)(b * 2 + dir) * 8 + h) * 16384);
}
DEV void phase_hgrn(KArgs a, LAS unsigned char* lds, int bid, int G) {
    constexpr int NSI = NB_S * 8 * 2, NPI = NB_P * 8 * 2;
    if (G > NSI) {
        const int nps = 0;
        if (bid < NSI) { hgrn_run(a, lds, bid); if (bid < nps) hgrn_run(a, lds, NSI + bid); }
        else for (int j = nps + bid - NSI; j < NPI; j += G - NSI) hgrn_run(a, lds, NSI + j);
    } else for (int it = bid; it < NSI + NPI; it += G) hgrn_run(a, lds, it);
}
typedef _Float16 f16x8 __attribute__((ext_vector_type(8)));
typedef float f32x8 __attribute__((ext_vector_type(8)));
DEV void phase_hgrn_combine(KArgs a, int bid, int G) {
    constexpr int RB = 3;
    const int lane = tid_l() & 63, gw = bid * NWAVES + (tid_l() >> 6), NGW = G * NWAVES;
    const _Float16* O0 = (const _Float16*)(a->ws + WS_HFF); const _Float16* O1 = O0 + (size_t)T * 1024; const bf16* P = (const bf16*)(a->ws + WS_P); bf16* MIX = (bf16*)(a->ws + WS_MIX);
    const float* hn = a->in[I_HGNORM];
    const int e0 = 16 * lane;
    float hnv[16];
#pragma unroll
    for (int i = 0; i < 16; ++i) hnv[i] = hn[(e0 + i) & 127];
    for (int row0 = gw; row0 < T; row0 += RB * NGW) {
        u32x4 xa[RB][2], xb[RB][2]; bf16x8 gg[RB][2];
#pragma unroll
        for (int j = 0; j < RB; ++j) { const int row = row0 + j * NGW;
            if (row < T) {
#pragma unroll
                for (int k = 0; k < 2; ++k) { xa[j][k] = __builtin_nontemporal_load((const u32x4*)(O0 + (size_t)row * 1024 + e0 + 8 * k)); xb[j][k] = __builtin_nontemporal_load((const u32x4*)(O1 + (size_t)row * 1024 + e0 + 8 * k));
                    gg[j][k] = ld_bf16x8(P + (size_t)row * OD_INP + PO_GH + e0 + 8 * k); } } }
#pragma unroll
        for (int j = 0; j < RB; ++j) { const int row = row0 + j * NGW;
            if (row < T) {
                float v[16]; float ss = 0.f;
#pragma unroll
                for (int k = 0; k < 2; ++k) { const f32x8 x = __builtin_convertvector(__builtin_bit_cast(f16x8, xa[j][k]), f32x8) + __builtin_convertvector(__builtin_bit_cast(f16x8, xb[j][k]), f32x8);
#pragma unroll
                    for (int i = 0; i < 8; ++i) { v[8 * k + i] = x[i]; ss += x[i] * x[i]; } }
                ss += __shfl_xor(ss, 1); ss += __shfl_xor(ss, 2); ss += __shfl_xor(ss, 4);
                const float rstd = rsqrtf(ss * (1.0f / 128.0f) + 1e-6f);
                float o[16];
#pragma unroll
                for (int i = 0; i < 16; ++i) { const float gz = bf2f((bf16)gg[j][i >> 3][i & 7]); o[i] = v[i] * rstd * hnv[i] * silu_f(gz); }
                u32x4 w0, w1; w0.x = pk2(o[0], o[1]); w0.y = pk2(o[2], o[3]); w0.z = pk2(o[4], o[5]); w0.w = pk2(o[6], o[7]); w1.x = pk2(o[8], o[9]); w1.y = pk2(o[10], o[11]); w1.z = pk2(o[12], o[13]); w1.w = pk2(o[14], o[15]);
                *(u32x4*)(MIX + (size_t)row * D + e0) = w0; *(u32x4*)(MIX + (size_t)row * D + e0 + 8) = w1; } }
    }
}
DEV void phase_attn_mla(KArgs a, int bid, int G) {
    const int lane = tid_l() & 63, gw = bid * NWAVES + (tid_l() >> 6), NGW = G * NWAVES, r = lane & 15, q = lane >> 4;
    const bf16* QM = (const bf16*)(a->ws + WS_QM); const bf16* KN = (const bf16*)(a->ws + WS_KN); const bf16* KRb = (const bf16*)(a->ws + WS_KR); const bf16* VTM = (const bf16*)(a->ws + WS_VTM);
    bf16* MIX = (bf16*)(a->ws + WS_MIX);
    constexpr int NQS = L_S / 16, NQP = L_P / 16, NI_S = NB_S * 8 * NQS, NI_P = NB_P * 8 * NQP;
    const float sc = 0.07216878364870323f * LOG2E;
    for (int it = gw; it < NI_S + NI_P; it += NGW) {
        const bool smp = it < NI_S; const int i2 = smp ? it : it - NI_S; const int NQ = smp ? NQS : NQP, h = i2 & 7, qt = (i2 >> 3) % NQ, b = (i2 >> 3) / NQ;
        const int seq0 = smp ? TP + b * L_S : b * L_P, q0 = 16 * qt;
        const bf16* qrow = QM + (size_t)(seq0 + q0 + r) * 1536 + h * 192;
        bf16x8 Q[6];
#pragma unroll
        for (int ks = 0; ks < 4; ++ks) Q[ks] = ld_bf16x8(qrow + 32 * ks + 8 * q);
#pragma unroll
        for (int ks = 4; ks < 6; ++ks) { const bf16x8 own = ld_bf16x8(qrow + 32 * ks + 8 * q);
            if (smp) { const bf16x8 oth = ld_bf16x8(qrow + 32 * ks + 8 * (q ^ 2)); const int pos = q0 + r; const float pp = (float)(ks == 4 ? (pos / 64) : (pos % 64)); bf16x8 o;
#pragma unroll
                for (int j = 0; j < 8; ++j) { const int dd = (8 * q + j) & 15; const float inv = exp2f(-(float)dd * (13.287712379549449f / 16.0f)); const float ang = pp * inv, cs = fast_cos(ang), sn = fast_sin(ang);
                    const float x = bf2f((bf16)own[j]), y = bf2f((bf16)oth[j]); o[j] = (short)f2bf((q & 2) ? (x * cs + y * sn) : (x * cs - y * sn)); }
                Q[ks] = o; }
            else Q[ks] = own; }
        float m = -1e30f, lsum = 0.f; f32x4 o[8];
#pragma unroll
        for (int dt = 0; dt < 8; ++dt) o[dt] = (f32x4){0.f, 0.f, 0.f, 0.f};
        attn_segment<6, false>(m, lsum, o, Q, KN + (size_t)seq0 * 1024 + h * 128, 1024, KRb + (size_t)seq0 * 64, VTM + (size_t)(h * 128) * TK + seq0, TK, 0, smp ? L_S : L_P, 0, sc, r, q);
        if (smp) { const int c0 = T + b * PAST; attn_segment<6, false>(m, lsum, o, Q, KN + (size_t)c0 * 1024 + h * 128, 1024, KRb + (size_t)c0 * 64, VTM + (size_t)(h * 128) * TK + c0, TK, 0, PAST, 0, sc, r, q); }
        attn_store(o, lsum, MIX + (size_t)(seq0 + q0 + r) * D + 1024 + h * 128, q);
    }
}
DEV void phase_attn_even2(KArgs a, LAS unsigned char* lds, int bid, int G) {
    constexpr int QT = 2, PPB = 2 * 16 * QT;
    const int tid = tid_l(), lane = tid & 63, wave = tid >> 6, r = lane & 15, q = lane >> 4;
    const bf16* QKV = (const bf16*)(a->ws + WS_QKV); const bf16* VTE = (const bf16*)(a->ws + WS_VTE); const bf16* KC = (const bf16*)(a->ws + WS_KC); const bf16* VTC = (const bf16*)(a->ws + WS_VTC);
    bf16* MIX = (bf16*)(a->ws + WS_MIX); const float* sink = a->in[I_SINK];
    constexpr int NBS = L_S / PPB, NBP = L_P / PPB, NI_S = NB_S * 2 * NBS, NI_P = NB_P * 2 * NBP;
    const float sc = 0.08838834764831845f * LOG2E;
    for (int it = bid; it < NI_S + NI_P; it += G) {
        const bool smp = it < NI_S; const int i2 = smp ? it : it - NI_S; const int NBq = smp ? NBS : NBP, qb = i2 % NBq, kvh = (i2 / NBq) & 1, b = (i2 / NBq) >> 1;
        const int g = wave & 3, pg = wave >> 2, head = kvh * 4 + g, seq0 = smp ? TP + b * L_S : b * L_P, L = smp ? L_S : L_P, qw0 = qb * PPB + pg * 16 * QT;
        bf16x8 Q[QT][4];
#pragma unroll
        for (int qi = 0; qi < QT; ++qi) { const bf16* qrow = QKV + (size_t)(seq0 + qw0 + 16 * qi + r) * NQKV + head * 128 + 8 * q;
#pragma unroll
            for (int ks = 0; ks < 4; ++ks) Q[qi][ks] = ld_bf16x8(qrow + 32 * ks); }
        AttnSeg s0, s1;
        s0.K = QKV + (size_t)seq0 * NQKV + 1024 + kvh * 128; s0.KR = nullptr; s0.VT = VTE + (size_t)(kvh * 128) * T + seq0; s0.ldk = NQKV; s0.ldvt = T;
        if (smp) { int k0 = qb * PPB - 128; if (k0 < 0) k0 = 0; k0 &= ~31; int k1 = (qb * PPB + PPB + 128 + 31) & ~31; if (k1 > L) k1 = L; s0.kt0 = k0; s0.ntiles = (k1 - k0) / 32;
            s1.K = KC + (size_t)((b * 2 + kvh) * PAST) * 128; s1.KR = nullptr; s1.VT = VTC + (size_t)((b * 2 + kvh) * 128) * PAST; s1.ldk = 128; s1.ldvt = PAST; s1.ntiles = PAST / 32; s1.kt0 = 0; }
        else { s0.kt0 = 0; s0.ntiles = L / 32; s1 = s0; s1.ntiles = 0; }
        attn_block<128, QT>(lds, s0, s1, Q, sink[head] * LOG2E, 1.0f, true, smp, qw0, sc, MIX + (size_t)(seq0 + qw0) * D + 1024 + head * 128, tid);
    }
}
DEV void phase_attn_mla2(KArgs a, LAS unsigned char* lds, int bid, int G) {
    constexpr int QT = 2, RPB = 8 * 16 * QT;
    const int tid = tid_l(), lane = tid & 63, wave = tid >> 6, r = lane & 15, q = lane >> 4;
    const bf16* QM = (const bf16*)(a->ws + WS_QM); const bf16* KN = (const bf16*)(a->ws + WS_KN); const bf16* KRb = (const bf16*)(a->ws + WS_KR); const bf16* VTM = (const bf16*)(a->ws + WS_VTM);
    bf16* MIX = (bf16*)(a->ws + WS_MIX);
    constexpr int NBS = (L_S + RPB - 1) / RPB, NBP = (L_P + RPB - 1) / RPB, NI_S = NB_S * 8 * NBS, NI_P = NB_P * 8 * NBP;
    const float sc = 0.07216878364870323f * LOG2E;
    for (int it = bid; it < NI_S + NI_P; it += G) {
        const bool smp = it < NI_S; const int i2 = smp ? it : it - NI_S; const int NBq = smp ? NBS : NBP, qb = i2 % NBq, h = (i2 / NBq) & 7, b = (i2 / NBq) >> 3;
        const int seq0 = smp ? TP + b * L_S : b * L_P, L = smp ? L_S : L_P, qw0 = qb * RPB + wave * 16 * QT; const bool active = qw0 < L;
        bf16x8 Q[QT][6];
#pragma unroll
        for (int qi = 0; qi < QT; ++qi) { const int pos = active ? qw0 + 16 * qi + r : r; const bf16* qrow = QM + (size_t)(seq0 + pos) * 1536 + h * 192;
#pragma unroll
            for (int ks = 0; ks < 4; ++ks) Q[qi][ks] = ld_bf16x8(qrow + 32 * ks + 8 * q);
#pragma unroll
            for (int ks = 4; ks < 6; ++ks) { const bf16x8 own = ld_bf16x8(qrow + 32 * ks + 8 * q);
                if (smp) { const bf16x8 oth = ld_bf16x8(qrow + 32 * ks + 8 * (q ^ 2)); const float pp = (float)(ks == 4 ? (pos / 64) : (pos % 64)); bf16x8 o;
#pragma unroll
                    for (int j = 0; j < 8; ++j) { const int dd = (8 * q + j) & 15; const float inv = exp2f(-(float)dd * (13.287712379549449f / 16.0f)); const float ang = pp * inv, cs = fast_cos(ang), sn = fast_sin(ang);
                        const float x = bf2f((bf16)own[j]), y = bf2f((bf16)oth[j]); o[j] = (short)f2bf((q & 2) ? (x * cs + y * sn) : (x * cs - y * sn)); }
                    Q[qi][ks] = o; }
                else Q[qi][ks] = own; } }
        AttnSeg s0, s1;
        s0.K = KN + (size_t)seq0 * 1024 + h * 128; s0.KR = KRb + (size_t)seq0 * 64; s0.VT = VTM + (size_t)(h * 128) * TK + seq0; s0.ldk = 1024; s0.ldvt = TK; s0.kt0 = 0; s0.ntiles = L / 32;
        s1 = s0; s1.ntiles = 0;
        if (smp) { const int c0 = T + b * PAST; s1.K = KN + (size_t)c0 * 1024 + h * 128; s1.KR = KRb + (size_t)c0 * 64; s1.VT = VTM + (size_t)(h * 128) * TK + c0; s1.ntiles = PAST / 32; }
        attn_block<192, QT>(lds, s0, s1, Q, -1e30f, 0.0f, active, false, qw0, sc, MIX + (size_t)(seq0 + (active ? qw0 : 0)) * D + 1024 + h * 128, tid);
    }
}
#ifndef EMU
#define XB_TMO      128
#define XB_XCNT(j)  (256  + 64 * (j))
#define XB_XSUB(j)  (1280 + 64 * (j))
#define XB_XGEN(j)  (2304 + 64 * (j))
#define XB_TOP      3328
#define XB_TOPGEN   3392
#define XCD_BAR_WORDS 3456
#define XB_SPIN_CAP (1u << 18)
__device__ __forceinline__ unsigned xb_ld(unsigned* p)              { return __hip_atomic_load(p, __ATOMIC_RELAXED, __HIP_MEMORY_SCOPE_AGENT); }
__device__ __forceinline__ unsigned xb_add(unsigned* p, unsigned v) { return __hip_atomic_fetch_add(p, v, __ATOMIC_RELAXED, __HIP_MEMORY_SCOPE_AGENT); }
__device__ __forceinline__ unsigned xb_xcc_id() { return (unsigned)__builtin_amdgcn_s_getreg((3 << 11) | 20) & 0xFu; }
#define XB_SPIN(cond, bar) do { unsigned _sp = 0; while (cond) { __builtin_amdgcn_s_sleep(1); \
    if ((++_sp & 255u) == 0u) { if (xb_ld(&(bar)[XB_TMO])) break; if (_sp > XB_SPIN_CAP) { atomicAdd(&(bar)[XB_TMO], 1u); break; } } } } while (0)
struct XcdBarrier { unsigned* bar; unsigned x; volatile LAS unsigned* st; };
__device__ __forceinline__ XcdBarrier xcd_barrier_post(unsigned* bar, volatile LAS unsigned* st) {
    XcdBarrier b; b.bar = bar; b.x = xb_xcc_id(); b.st = st;
    if (threadIdx.x == 0) (void)xb_add(&bar[XB_XCNT(b.x)], 1u);
    return b;
}
__device__ __forceinline__ void xcd_barrier_complete(unsigned* bar, unsigned x, unsigned& nloc, unsigned& nx) {
    const unsigned G = gridDim.x * gridDim.y * gridDim.z;
    unsigned sum, cnt, mine, sp = 0u;
    for (;;) {
        sum = 0u; cnt = 0u; mine = 0u;
#pragma unroll
        for (unsigned j = 0; j < 16; ++j) { const unsigned c = xb_ld(&bar[XB_XCNT(j)]); sum += c; cnt += (c > 0u) ? 1u : 0u; mine = (j == x) ? c : mine; }
        if (sum == G) break;
        __builtin_amdgcn_s_sleep(1);
        if ((++sp & 255u) == 0u) { if (xb_ld(&bar[XB_TMO])) break; if (sp > XB_SPIN_CAP) { atomicAdd(&bar[XB_TMO], 1u); break; } }
    }
    nloc = mine > 0u ? mine : 1u; nx = cnt > 0u ? cnt : 1u;
}
__device__ __forceinline__ void xcd_barrier(const XcdBarrier& b) {
    asm volatile("s_waitcnt vmcnt(0)" ::: "memory");
    __syncthreads();
    if (threadIdx.x == 0) {
        unsigned* bar = b.bar;
        __builtin_amdgcn_s_waitcnt(0);
        unsigned nloc = b.st[0], nx = b.st[1];
        if (nloc == 0u) { xcd_barrier_complete(bar, b.x, nloc, nx); b.st[0] = nloc; b.st[1] = nx; }
        const unsigned old = xb_add(&bar[XB_XSUB(b.x)], 1u);
        const unsigned gen = old / nloc;
        if (old + 1u == (gen + 1u) * nloc) {
            __builtin_amdgcn_fence(__ATOMIC_RELEASE, "agent");
            asm volatile("s_waitcnt vmcnt(0)" ::: "memory");
            const unsigned og = xb_add(&bar[XB_TOP], 1u);
            const unsigned tg = og / nx;
            if (og + 1u == (tg + 1u) * nx) xb_add(&bar[XB_TOPGEN], 1u);
            else XB_SPIN(xb_ld(&bar[XB_TOPGEN]) == tg, bar);
            __builtin_amdgcn_fence(__ATOMIC_ACQUIRE, "agent");
            xb_add(&bar[XB_XGEN(b.x)], 1u);
            asm volatile("s_waitcnt vmcnt(0)" ::: "memory");
        } else {
            XB_SPIN(xb_ld(&bar[XB_XGEN(b.x)]) == gen, bar);
            __builtin_amdgcn_fence(__ATOMIC_ACQUIRE, "agent");
            asm volatile("s_waitcnt vmcnt(0)" ::: "memory");
        }
    }
    __syncthreads();
}
#endif

constexpr int N_PHASES = 3 + 2 * 12;
constexpr int CW_BAR = 4096;
#ifdef EMU
struct XcdBarrier { int dummy; };
DEV void xcd_barrier(const XcdBarrier&) {}
#endif
#ifndef REP_MASK
#define REP_MASK 0ull
#endif
#ifdef EMU
DEV int launder_s(int x) { return x; }
#else
DEV int launder_s(int x) { asm volatile("" : "+s"(x)); return x; }
#endif
#define INP(k) (LO <= (k) && (k) < HI)
#define WSV unsigned char* ws = a->ws; bf16* HN = (bf16*)(ws + WS_HN); bf16* HFF = (bf16*)(ws + WS_HFF); float* OUT0 = (float*)(ws + WS_OUT); float* OUT1 = OUT0 + (size_t)T * D; bf16* MIX = (bf16*)(ws + WS_MIX); (void)HN; (void)HFF; (void)OUT0; (void)OUT1; (void)MIX;
#define PHASE(k, ...) do { if constexpr (INP(k)) { { KArgs a = kargs(); const int bid = launder_s(bid0), G = launder_s(G0); WSV __VA_ARGS__ } if constexpr (((REP_MASK) >> (k)) & 1ull) { xcd_barrier(bar); { KArgs a = kargs(); const int bid = launder_s(bid0), G = launder_s(G0); WSV __VA_ARGS__ } } } } while (0)
#define SEAMP(k) do { if constexpr (INP(k) && INP((k) + 1)) xcd_barrier(bar); } while (0)
template <int LO, int HI, int l, int s>
DEV void ffn_phases(LAS unsigned char* lds, int bid0, int G0, const XcdBarrier& bar) {
    constexpr int p0 = 3 + 12 * l + 9 * s;
    PHASE(p0,
        constexpr int units = (T / 256) * (2 * DFF / 256); constexpr bool hasconv = (p0 == 3 || p0 == 12 || p0 == 15);
        const int Gg = hasconv ? gemm_groups(units, G) : G;
        if (bid < Gg) {
            pg8::Gemm g{D, D, D}; pg8::MultiOrder S; constexpr int ns_ = 1, lda_ = D, ldb_ = D;
            const pg8::SubG g0_ = pg8::SubG{HN, (const bf16*)(ws + WS_WGU + (size_t)(l * 2 + s) * SZ_WGU1), T / 256, 2 * DFF / 256}; S.init(g0_, g0_, g0_, ns_, Gg, bid, lda_, ldb_);
            pg8::EpiSwiGLU E{HFF, DFF};
            pg8::gemm_phase<pg8::EpiSwiGLU, pg8::MultiOrder, true, true>(lds, g, S, E);
        }
        if constexpr (hasconv) { if (Gg == G) conv_work<p0>(a, lds, bid, G); else if (bid >= Gg) conv_work<p0>(a, lds, bid - Gg, G - Gg); }
    ); SEAMP(p0);
    PHASE(p0 + 1,
        constexpr int KH = DFF / 2; pg8::Gemm g{KH, DFF, DFF}; pg8::MultiOrder S; constexpr int ns_ = 2, lda_ = DFF, ldb_ = DFF;
        const bf16* wd = (const bf16*)(ws + WS_WD + (size_t)(l * 2 + s) * SZ_WD1);
        const pg8::SubG g0_ = pg8::SubG{HFF, wd, T / 256, D / 256}, g1_ = pg8::SubG{HFF + KH, wd + KH, T / 256, D / 256}; S.init(g0_, g1_, g0_, ns_, G, bid, lda_, ldb_);
        const pg8::EpiBf16M E = pg8::EpiBf16M::make((bf16*)OUT0, (bf16*)OUT0 + (size_t)T * D, nullptr, D, D, 0);
        pg8::gemm_phase<pg8::EpiBf16M, pg8::MultiOrder, true, true>(lds, g, S, E);
    ); SEAMP(p0 + 1);
    PHASE(p0 + 2,
        constexpr int j = 2 * s; constexpr bool first = (l == 0 && s == 0), last = (l == 1 && s == 1);
        constexpr int nl = (s == 0) ? l : (l == 0 ? 1 : -1), nj = (s == 0) ? 1 : 0;
        phase_residual(a, lds, bid, G, l, j, 0.5f, nl, nj, first, last);
    ); SEAMP(p0 + 2);
}
template <int LO, int HI, int l>
DEV void outproj_phases(LAS unsigned char* lds, int bid0, int G0, const XcdBarrier& bar) {
    constexpr int pb = 3 + 12 * l;
    PHASE(pb + 7,
        pg8::Gemm g{1024, D, D}; pg8::MultiOrder S; constexpr int ns_ = 2, lda_ = D, ldb_ = D;
        const bf16* wo = (const bf16*)(ws + (l == 0 ? WS_WEVOUT : WS_WODOUT));
        const pg8::SubG g0_ = pg8::SubG{MIX, wo, T / 256, D / 256}, g1_ = pg8::SubG{MIX + 1024, wo + 1024, T / 256, D / 256}; S.init(g0_, g1_, g0_, ns_, G, bid, lda_, ldb_);
        const pg8::EpiBf16M E = pg8::EpiBf16M::make((bf16*)OUT0, (bf16*)OUT0 + (size_t)T * D, nullptr, D, D, 0);
        pg8::gemm_phase<pg8::EpiBf16M, pg8::MultiOrder, true, true>(lds, g, S, E);
    ); SEAMP(pb + 7);
    PHASE(pb + 8,  phase_residual(a, lds, bid, G, l, 1, 1.0f, l, 2, false, false); ); SEAMP(pb + 8);
}
template <int LO, int HI>
DEV void even_mixer_phases(LAS unsigned char* lds, int bid0, int G0, const XcdBarrier& bar) {
    constexpr int pb = 3;
    PHASE(pb + 3,
        constexpr int units = (3072 / 256) * (T / 256) + (T / 256) * (NQKV / 256) + (T / 256);
        const int Gg = gemm_groups(units, G);
        if (bid < Gg) {
            const bf16* w = (const bf16*)(ws + WS_WEVIN);
            pg8::Gemm g{D, D, D}; pg8::MultiOrder S; constexpr int ns_ = 3, lda_ = D, ldb_ = D;
            const pg8::SubG g0_ = pg8::SubG{w, HN, 3072 / 256, T / 256}, g1_ = pg8::SubG{HN, w + (size_t)3072 * D, T / 256, NQKV / 256}, g2_ = pg8::SubG{w + (size_t)(3072 + 1280) * D, HN, 1, T / 256}; S.init(g0_, g1_, g2_, ns_, Gg, bid, lda_, ldb_);
            const pg8::EpiBf16M E = pg8::EpiBf16M::make((bf16*)(ws + WS_UT), (bf16*)(ws + WS_QKV), (bf16*)(ws + WS_VTE), T, NQKV, T);
            pg8::gemm_phase<pg8::EpiBf16M, pg8::MultiOrder, true, true>(lds, g, S, E);
        }
        if (Gg == G) conv_work<6>(a, lds, bid, G); else if (bid >= Gg) conv_work<6>(a, lds, bid - Gg, G - Gg);
    ); SEAMP(pb + 3);
    if constexpr (INP(pb + 4)) phase_rope_kvout(kargs(), launder_s(bid0), launder_s(G0));
    PHASE(pb + 4, phase_hyena(a, lds, bid, G); ); SEAMP(pb + 4);
    PHASE(pb + 5,  phase_attn_even2(a, lds, bid, G); phase_ytrans(a, lds, bid, G); );
    if constexpr (INP(pb + 5) && INP(pb + 7)) xcd_barrier(bar);
}
template <int LO, int HI>
DEV void odd_mixer_phases(LAS unsigned char* lds, int bid0, int G0, const XcdBarrier& bar) {
    constexpr int pb = 15;
    PHASE(pb + 3,
        constexpr int units = (T / 256) * (OD_INP / 256); const int Gg = gemm_groups(units, G);
        if (bid < Gg) {
            pg8::Gemm g{D, D, D}; pg8::MultiOrder S; constexpr int ns_ = 1, lda_ = D, ldb_ = D;
            const pg8::SubG g0_ = pg8::SubG{HN, (const bf16*)(ws + WS_WODIN), T / 256, OD_INP / 256}; S.init(g0_, g0_, g0_, ns_, Gg, bid, lda_, ldb_);
            const pg8::EpiBf16M E = pg8::EpiBf16M::make((bf16*)(ws + WS_P), nullptr, nullptr, OD_INP, 0, 0);
            pg8::gemm_phase<pg8::EpiBf16M, pg8::MultiOrder, true, true>(lds, g, S, E);
        }
        if (Gg == G) conv_work<18>(a, lds, bid, G); else if (bid >= Gg) conv_work<18>(a, lds, bid - Gg, G - Gg);
    ); SEAMP(pb + 3);
    PHASE(pb + 4,  phase_mla_prep(a, bid, G); ); SEAMP(pb + 4);
    PHASE(pb + 5,
        constexpr int NSI_ = NB_S * 8 * 2; const bool split = G > NSI_;
        phase_hgrn(a, lds, bid, G);
        if (!split || bid >= NSI_) { const int Gg = split ? G - NSI_ : G, cg = split ? bid - NSI_ : bid;
        { pg8::Gemm g{512, 512, 512}; pg8::MultiOrder S; constexpr int ns_ = 1, lda_ = 512, ldb_ = 512;
          const pg8::SubG g0_ = pg8::SubG{(const bf16*)(ws + WS_QN), (const bf16*)(ws + WS_WQB), T / 256, 1536 / 256}; S.init(g0_, g0_, g0_, ns_, Gg, cg, lda_, ldb_);
          const pg8::EpiBf16M E = pg8::EpiBf16M::make((bf16*)(ws + WS_QM), nullptr, nullptr, 1536, 0, 0);
          pg8::gemm_phase<pg8::EpiBf16M, pg8::MultiOrder, true, true>(lds, g, S, E); }
        { pg8::Gemm g{256, 256, 256}; pg8::MultiOrder S; constexpr int ns_ = 2, lda_ = 256, ldb_ = 256;
          const pg8::SubG g0_ = pg8::SubG{(const bf16*)(ws + WS_CKV), (const bf16*)(ws + WS_WKVK), TK / 256, 4}, g1_ = pg8::SubG{(const bf16*)(ws + WS_WKVV), (const bf16*)(ws + WS_CKV), 4, TK / 256}; S.init(g0_, g1_, g0_, ns_, Gg, cg, lda_, ldb_);
          const pg8::EpiBf16M E = pg8::EpiBf16M::make((bf16*)(ws + WS_KN), (bf16*)(ws + WS_VTM), nullptr, 1024, TK, 0);
          pg8::gemm_phase<pg8::EpiBf16M, pg8::MultiOrder, true, true>(lds, g, S, E); }
        }
    ); SEAMP(pb + 5);
    PHASE(pb + 6,  phase_attn_mla2(a, lds, bid, G); phase_hgrn_combine(a, bid, G); ); SEAMP(pb + 6);
}
template <int LO, int HI>
__global__ void __launch_bounds__(NTHR, 2) mk_fwd(Args args) {
#ifdef EMU
    unsigned char* lds = emu_lds_ptr(); XcdBarrier bar{0}; emu_args_p = &args;
#else
    extern __shared__ __attribute__((aligned(16))) unsigned char lds_raw[];
    LAS unsigned char* lds = (LAS unsigned char*)lds_raw;
#endif
        const int bid0 = blockIdx.x, G0 = gridDim.x;
#ifndef EMU
    XcdBarrier bar; bar.bar = (unsigned*)(kargs()->ws + WS_CTL) + CW_BAR; bar.x = 0; bar.st = nullptr;
    if constexpr (HI - LO > 1) {
        { volatile LAS unsigned* misc = (volatile LAS unsigned*)(lds + MISC_OFF); if (threadIdx.x < 32) misc[threadIdx.x] = 0u; }
        __syncthreads();
        bar = xcd_barrier_post((unsigned*)(kargs()->ws + WS_CTL) + CW_BAR, (volatile LAS unsigned*)(lds + MISC_OFF) + 8);
    }
#endif
    PHASE(0,  p0_prologue(a, lds, bid, G); ); SEAMP(0);
    PHASE(1,  p1_mods(a, lds, bid, G); ); SEAMP(1);
    PHASE(2,  phase_norm0(a, bid, G); ); SEAMP(2);
    ffn_phases<LO, HI, 0, 0>(lds, bid0, G0, bar);
    even_mixer_phases<LO, HI>(lds, bid0, G0, bar);
    outproj_phases<LO, HI, 0>(lds, bid0, G0, bar);
    ffn_phases<LO, HI, 0, 1>(lds, bid0, G0, bar);
    ffn_phases<LO, HI, 1, 0>(lds, bid0, G0, bar);
    odd_mixer_phases<LO, HI>(lds, bid0, G0, bar);
    outproj_phases<LO, HI, 1>(lds, bid0, G0, bar);
    ffn_phases<LO, HI, 1, 1>(lds, bid0, G0, bar);
}

#ifndef MK_ONE_LAUNCH
#define MK_ONE_LAUNCH 1
#endif
#ifdef EMU
template <int P> static void emu_run_phases(const Args& a, int grid, int p0, int p1) {
    if constexpr (P < N_PHASES) {
        if (P >= p0 && P < p1 && P != 9) { fprintf(stderr, "[emu] phase %d\n", P); emu_launch(grid, NTHR, LDS_BYTES, [&]() { mk_fwd<P, P + 1>(a); }); }
        emu_run_phases<P + 1>(a, grid, p0, p1);
    }
}
#else
template <int P> static void launch_phases(const Args& a, int grid, hipStream_t stream) {
    if constexpr (P < N_PHASES) {
        if constexpr (P != 9) {
            static bool attr_set = false;
            if (!attr_set) { (void)hipFuncSetAttribute((const void*)mk_fwd<P, P + 1>, hipFuncAttributeMaxDynamicSharedMemorySize, LDS_BYTES); attr_set = true; }
            hipLaunchKernelGGL((mk_fwd<P, P + 1>), dim3(grid), dim3(NTHR), LDS_BYTES, stream, a);
        }
        launch_phases<P + 1>(a, grid, stream);
    }
}
#endif

extern "C" void kernel_launch(void* const* d_in, const int* in_sizes, int n_in, void* d_out, int out_size, void* d_ws, size_t ws_size, hipStream_t stream) {
    static int grid = 0;
    if (grid == 0) {
        if (n_in != 35 || (size_t)out_size != OUT_END || ws_size < WS_END) { fprintf(stderr, "kernel_launch: unexpected problem (n_in %d, out %d vs %zu, ws %zu vs %zu); nothing launched\n", n_in, out_size, (size_t)OUT_END, ws_size, (size_t)WS_END); grid = -1; return; }
#ifdef EMU
        grid = 8; { const char* e = getenv("EMU_GRID"); if (e) grid = atoi(e); }
#else
        int dev = 0, cus = 0, per_cu = 0;
        if (hipGetDevice(&dev) != hipSuccess || hipDeviceGetAttribute(&cus, hipDeviceAttributeMultiprocessorCount, dev) != hipSuccess) { fprintf(stderr, "kernel_launch: device query failed\n"); grid = -1; return; }
#if MK_ONE_LAUNCH
        if (hipFuncSetAttribute((const void*)mk_fwd<0, N_PHASES>, hipFuncAttributeMaxDynamicSharedMemorySize, LDS_BYTES) != hipSuccess) { fprintf(stderr, "kernel_launch: hipFuncSetAttribute failed\n"); grid = -1; return; }
        if (hipOccupancyMaxActiveBlocksPerMultiprocessor(&per_cu, (const void*)mk_fwd<0, N_PHASES>, NTHR, LDS_BYTES) != hipSuccess || per_cu < 1) fprintf(stderr, "kernel_launch: occupancy query says %d blocks per CU\n", per_cu);
        (void)hipGetLastError();
#else
        (void)per_cu;
#endif
        grid = cus;
#endif
    }
    if (grid < 0) return;
    (void)hipMemsetAsync((char*)d_ws + WS_CTL, 0, CTL_BYTES, stream);
    Args a{};
    for (int i = 0; i < 35; ++i) a.in[i] = (const float*)d_in[i];
    a.out = (float*)d_out; a.ws = (unsigned char*)d_ws;
#ifdef EMU
    { int p0 = 0, p1 = N_PHASES; const char* e = getenv("EMU_PH0"); if (e) p0 = atoi(e); e = getenv("EMU_PH1"); if (e) p1 = atoi(e);
      emu_run_phases<0>(a, grid, p0, p1); }
#else
#if MK_ONE_LAUNCH
    hipLaunchKernelGGL((mk_fwd<0, N_PHASES>), dim3(grid), dim3(NTHR), LDS_BYTES, stream, a);
#else
    launch_phases<0>(a, grid, stream);
#endif
    const hipError_t le = hipGetLastError();
    if (le != hipSuccess) fprintf(stderr, "kernel_launch: launch failed: %s\n", hipGetErrorName(le));
#endif
}
```

```cpp
#ifdef EMU
#include "emu.h"
#define LAS
#define GAS
#else
#include <hip/hip_runtime.h>
#define LAS __attribute__((address_space(3)))
#define GAS __attribute__((address_space(1)))
#endif
#include <cstdio>
#include <cstdint>
#include <cmath>

#ifndef CFG_BATCH
#define CFG_BATCH 16
#define CFG_SEQ 256
#define CFG_DEC_BATCH 8
#define CFG_DEC_SEQ 1024
#define CFG_PAST 512
#define CFG_DFF 5632
#endif
#define DEV __device__ __forceinline__

typedef unsigned short bf16;
typedef float f32x4 __attribute__((ext_vector_type(4)));
typedef float f32x2 __attribute__((ext_vector_type(2)));
typedef short bf16x8 __attribute__((ext_vector_type(8)));
typedef short bf16x4 __attribute__((ext_vector_type(4)));
typedef unsigned u32x4 __attribute__((ext_vector_type(4)));
typedef unsigned u32x2 __attribute__((ext_vector_type(2)));
typedef _Float16 f16x4 __attribute__((ext_vector_type(4)));

constexpr int D = 2048, NB_P = CFG_BATCH, L_P = CFG_SEQ, NB_S = CFG_DEC_BATCH, L_S = CFG_DEC_SEQ, PAST = CFG_PAST, DFF = CFG_DFF;
constexpr int TP = NB_P * L_P, TS = NB_S * L_S, T = TP + TS, CTX = NB_S * PAST, TK = T + CTX;
constexpr int EV_IN = 4608, OD_IN = 5952, OD_INP = 6144, NQKV = 1536;
constexpr int NMOD = 9, NGRP = 1 + NB_S, MODW = NMOD * D;
constexpr int GV_KS = 16, GV_KC = D / GV_KS;
constexpr int NWAVES = 8, NTHR = 512;
static_assert(T % 256 == 0 && TK % 256 == 0 && TP % 256 == 0 && DFF % 256 == 0 && (DFF / 2) % 128 == 0, "tile multiples");
static_assert(L_P % 128 == 0 && L_S % 128 == 0 && PAST % 32 == 0 && L_P % 8 == 0, "sequence multiples");

constexpr size_t MiB = 1u << 20;
constexpr size_t al(size_t x) { return (x + MiB - 1) / MiB * MiB; }
constexpr size_t WS_CTL = 0, CTL_BYTES = 1 * MiB;
constexpr size_t WS_WGU = WS_CTL + CTL_BYTES;
constexpr size_t SZ_WGU1 = (size_t)2 * DFF * D * 2;
constexpr size_t WS_WD = WS_WGU + al(4 * SZ_WGU1);
constexpr size_t SZ_WD1 = (size_t)D * DFF * 2;
constexpr size_t WS_WEVIN = WS_WD + al(4 * SZ_WD1);
constexpr size_t WS_WEVOUT = WS_WEVIN + al((size_t)EV_IN * D * 2);
constexpr size_t WS_WODIN = WS_WEVOUT + al((size_t)D * D * 2);
constexpr size_t WS_WODOUT = WS_WODIN + al((size_t)OD_INP * D * 2);
constexpr size_t WS_WQB = WS_WODOUT + al((size_t)D * D * 2);
constexpr size_t WS_WKVK = WS_WQB + al((size_t)1536 * 512 * 2);
constexpr size_t WS_WKVV = WS_WKVK + al((size_t)1024 * 256 * 2);
constexpr size_t WS_X = WS_WKVV + al((size_t)1024 * 256 * 2);
constexpr size_t WS_HN = WS_X + al((size_t)T * D * 4);
constexpr size_t WS_HFF = WS_HN + al((size_t)T * D * 2);
constexpr size_t SZ_HFF = al((size_t)T * DFF * 2) > al((size_t)2 * T * 1024 * 4) ? al((size_t)T * DFF * 2) : al((size_t)2 * T * 1024 * 4);
constexpr size_t WS_OUT = WS_HFF + SZ_HFF;
constexpr size_t SZ_OUT1 = (size_t)T * D * 4;
constexpr size_t WS_QN = WS_OUT;
constexpr size_t WS_CKV = WS_QN + al((size_t)T * 512 * 2);
constexpr size_t WS_KR = WS_CKV + al((size_t)TK * 256 * 2);
constexpr size_t WS_QM = WS_KR + al((size_t)TK * 64 * 2);
constexpr size_t WS_KN = WS_QM + al((size_t)T * 1536 * 2);
constexpr size_t WS_VTM = WS_KN + al((size_t)TK * 1024 * 2);
constexpr size_t MLA_END = WS_VTM + al((size_t)1024 * TK * 2);
constexpr size_t SZ_OUT = (al(2 * SZ_OUT1) > (MLA_END - WS_OUT)) ? al(2 * SZ_OUT1) : (MLA_END - WS_OUT);
constexpr size_t WS_P = WS_OUT + SZ_OUT;
constexpr size_t WS_UT = WS_P;
constexpr size_t WS_QKV = WS_UT + al((size_t)3072 * T * 2);
constexpr size_t WS_VTE = WS_QKV + al((size_t)T * NQKV * 2);
constexpr size_t WS_YT = WS_VTE + al((size_t)256 * T * 2);
constexpr size_t EV_END = WS_YT + al((size_t)1024 * T * 2);
constexpr size_t SZ_P = (al((size_t)T * OD_INP * 2) > (EV_END - WS_P)) ? al((size_t)T * OD_INP * 2) : (EV_END - WS_P);
constexpr size_t WS_MIX = WS_P + SZ_P;
constexpr size_t WS_FILT = WS_MIX + al((size_t)T * D * 2);
constexpr size_t WS_H2 = WS_FILT + al((size_t)4 * (L_P + L_S) * 1024 * 2);
constexpr size_t WS_MODP = WS_H2 + al((size_t)(L_P + L_S) * 64 * 4);
constexpr size_t WS_MODS = WS_MODP + al((size_t)GV_KS * 2 * NGRP * MODW * 4);
constexpr size_t WS_KC = WS_MODS + al((size_t)2 * NGRP * MODW * 4);
constexpr size_t WS_VTC = WS_KC + al((size_t)NB_S * 2 * PAST * 128 * 2);
constexpr size_t WS_END = WS_VTC + al((size_t)NB_S * 2 * PAST * 128 * 2);
#if CFG_BATCH == 16 && CFG_DFF == 5632
static_assert(WS_END <= (size_t)1152 * MiB, "d_ws map exceeds the guaranteed workspace");
#endif

constexpr size_t OUT_Y = 0;
constexpr size_t OUT_K = (size_t)T * D;
constexpr size_t OUT_V = OUT_K + (size_t)NB_P * 2 * L_P * 128;
constexpr size_t OUT_CKV = OUT_V + (size_t)NB_P * 2 * L_P * 128;
constexpr size_t OUT_KR = OUT_CKV + (size_t)NB_P * L_P * 256;
constexpr size_t OUT_ST = OUT_KR + (size_t)NB_P * L_P * 64;
constexpr size_t OUT_END = OUT_ST + (size_t)NB_P * 2 * 8 * 128 * 128;

constexpr int RING_BYTES = 131072, MISC_OFF = RING_BYTES + 320, LDS_BYTES = 147456;

#ifdef EMU
#define SCHED_FENCE() do { } while (0)
#else
#define SCHED_FENCE() __builtin_amdgcn_sched_barrier(0)
#endif
#ifdef EMU
DEV void lds_barrier() { __syncthreads(); }
#else
DEV void lds_barrier() { asm volatile("s_waitcnt lgkmcnt(0)" ::: "memory"); __builtin_amdgcn_s_barrier(); asm volatile("" ::: "memory"); }
#endif
#ifdef EMU
DEV int tid_l() { return (int)threadIdx.x; }
#else
DEV int tid_l() { int t = (int)threadIdx.x; asm volatile("" : "+v"(t)); return t; }
#endif
DEV float bf2f(bf16 v) { return __uint_as_float((unsigned)v << 16); }
DEV unsigned f2bf(float f) { unsigned u = __float_as_uint(f); return (u + 0x7fffu + ((u >> 16) & 1u)) >> 16; }
#ifdef EMU
DEV unsigned pk2(float lo, float hi) { return f2bf(lo) | (f2bf(hi) << 16); }
DEV float fast_exp2(float x) { return exp2f(x); }
#else
DEV unsigned pk2(float lo, float hi) { unsigned r; asm("v_cvt_pk_bf16_f32 %0, %1, %2" : "=v"(r) : "v"(lo), "v"(hi)); return r; }
DEV float fast_exp2(float x) { return __builtin_amdgcn_exp2f(x); }
#endif
#ifdef EMU
DEV float xrow16_max(float x) { x = fmaxf(x, __shfl_xor(x, 16)); return fmaxf(x, __shfl_xor(x, 32)); }
DEV float xrow16_sum(float x) { x += __shfl_xor(x, 16); return x + __shfl_xor(x, 32); }
#else
DEV float xrow16_max(float x) {
    auto s = __builtin_amdgcn_permlane16_swap(__float_as_uint(x), __float_as_uint(x), false, false);
    x = fmaxf(__uint_as_float(s[0]), __uint_as_float(s[1]));
    auto t = __builtin_amdgcn_permlane32_swap(__float_as_uint(x), __float_as_uint(x), false, false);
    return fmaxf(__uint_as_float(t[0]), __uint_as_float(t[1]));
}
DEV float xrow16_sum(float x) {
    auto s = __builtin_amdgcn_permlane16_swap(__float_as_uint(x), __float_as_uint(x), false, false);
    x = __uint_as_float(s[0]) + __uint_as_float(s[1]);
    auto t = __builtin_amdgcn_permlane32_swap(__float_as_uint(x), __float_as_uint(x), false, false);
    return __uint_as_float(t[0]) + __uint_as_float(t[1]);
}
#endif
DEV float wave_sum(float v) {
#pragma unroll
    for (int o = 1; o < 64; o <<= 1) v += __shfl_xor(v, o);
    return v;
}
#ifdef EMU
DEV float fast_rcp(float x) { return 1.0f / x; }
#else
DEV float fast_rcp(float x) { return __builtin_amdgcn_rcpf(x); }
#endif
#ifdef EMU
DEV float fast_sin(float x) { return sinf(x); }
DEV float fast_cos(float x) { return cosf(x); }
#else
DEV float fast_sin(float x) { return __sinf(x); }
DEV float fast_cos(float x) { return __cosf(x); }
#endif
DEV float silu_f(float x) { return x * fast_rcp(1.0f + __expf(-x)); }
DEV float sigmoid_f(float x) { return fast_rcp(1.0f + __expf(-x)); }
DEV int grp_of_row(int row) { return row < TP ? 0 : 1 + (row - TP) / L_S; }
DEV bf16x8 ld_bf16x8(const bf16* p) { return *(const bf16x8*)p; }
DEV bf16x8 lds_bf16x8(const LAS unsigned char* p) { return *(const LAS bf16x8*)p; }
DEV f32x4 mfma16(bf16x8 a, bf16x8 b, f32x4 c) { return __builtin_amdgcn_mfma_f32_16x16x32_bf16(a, b, c, 0, 0, 0); }

namespace pg8 {
constexpr int BM = 256, BK = 64, HALF = 128, HTB = HALF * BK * 2, STAGE_BYTES = 8 * HTB, NXCD = 8, WGM = 4;
__host__ __device__ __forceinline__ int lds_byte(int r, int c) { const int st = (r >> 4) * 2 + (c >> 5), rr = r & 15, cc = c & 31, ob = rr * 64 + cc * 2; return st * 1024 + (ob ^ (((ob >> 9) & 1) << 5)); }
__host__ __device__ __forceinline__ void stage_rc(int b, int& R, int& C) { const int st = b / 1024, sb = b % 1024, swz = sb ^ (((sb >> 9) & 1) << 5); R = (st >> 1) * 16 + swz / 64; C = (st & 1) * 32 + (swz % 64) / 2; }
__host__ __device__ __forceinline__ int perm32(int rho) { const int n = rho >> 4, i = rho & 15; return 8 * (i >> 2) + 4 * n + (i & 3); }

struct Unit { int pm, pn, sub; };
struct Gemm { int K, lda, ldb; };
struct SubG { const bf16* A; const bf16* Bt; int nM, nN; };

struct MultiOrder {
    const char* A0; const char* B0; long dA1, dB1, dA2, dB2; int nM0, nN0, dM1, dN1, dM2, dN2, n0, n1, n2, G, c, lda, ldb;
    DEV void init(const SubG& g0, const SubG& g1, const SubG& g2, int ns, int G_, int c_, int lda_, int ldb_) {
        A0 = (const char*)g0.A; B0 = (const char*)g0.Bt; dA1 = (const char*)g1.A - A0; dB1 = (const char*)g1.Bt - B0; dA2 = (const char*)g2.A - A0; dB2 = (const char*)g2.Bt - B0;
        nM0 = g0.nM; nN0 = g0.nN; dM1 = g1.nM - g0.nM; dN1 = g1.nN - g0.nN; dM2 = g2.nM - g0.nM; dN2 = g2.nN - g0.nN;
        n0 = g0.nM * g0.nN; n1 = ns > 1 ? g1.nM * g1.nN : 0; n2 = ns > 2 ? g2.nM * g2.nN : 0; G = G_; c = c_; lda = lda_; ldb = ldb_;
    }
    DEV bool next(int i, Unit& u) const {
        const long L = (long)i * G + c;
        if (L >= (long)n0 + n1 + n2) return false;
        int l = (int)L; const int sub = (l >= n0 ? 1 : 0) + (l >= n0 + n1 ? 1 : 0);
        l -= (sub >= 1 ? n0 : 0) + (sub >= 2 ? n1 : 0);
        const int nM = nM0 + (sub == 1 ? dM1 : 0) + (sub == 2 ? dM2 : 0), nN = nN0 + (sub == 1 ? dN1 : 0) + (sub == 2 ? dN2 : 0);
        const int nwg = nM * nN; int wgid = l; { const int q = nwg / NXCD, r = nwg % NXCD, xcd = wgid % NXCD, off = wgid / NXCD; wgid = (xcd < r ? xcd * (q + 1) : r * (q + 1) + (xcd - r) * q) + off; }
        const int nig = WGM * nN, gid = wgid / nig, fm = gid * WGM, gsz = (nM - fm) < WGM ? (nM - fm) : WGM;
        u.pm = fm + ((wgid % nig) % gsz); u.pn = (wgid % nig) / gsz; u.sub = sub; return true;
    }
    DEV const char* pa(const Unit& u) const { return A0 + ((u.sub == 1 ? dA1 : 0) + (u.sub == 2 ? dA2 : 0)) + (size_t)u.pm * BM * lda * 2; }
    DEV const char* pb(const Unit& u) const { return B0 + ((u.sub == 1 ? dB1 : 0) + (u.sub == 2 ? dB2 : 0)) + (size_t)u.pn * BM * ldb * 2; }
    DEV void a_ready(const Unit&) const {}
    DEV void done(const Unit&) const {}
};

struct EpiBf16M {
    static constexpr bool PERM = true, AFTER_DRAIN = false;
    bf16* O0; long dO1, dO2; int ldc0, dl1, dl2;
    DEV static EpiBf16M make(bf16* o0, bf16* o1, bf16* o2, int l0, int l1, int l2) { EpiBf16M e; e.O0 = o0; e.dO1 = o1 ? o1 - o0 : 0; e.dO2 = o2 ? o2 - o0 : 0; e.ldc0 = l0; e.dl1 = l1 - l0; e.dl2 = l2 - l0; return e; }
    DEV void operator()(const f32x4 (&acc)[2][2][4][2], const Unit& u, int wr, int wc, int fr, int fq) const {
        bf16* base = O0 + ((u.sub == 1 ? dO1 : 0) + (u.sub == 2 ? dO2 : 0)); const int ldc = ldc0 + (u.sub == 1 ? dl1 : 0) + (u.sub == 2 ? dl2 : 0);
        const int row0 = u.pm * BM + wr * 64 + fr, col0 = u.pn * BM + wc * 32 + 8 * fq;
#pragma unroll
        for (int ai = 0; ai < 2; ++ai)
#pragma unroll
            for (int m = 0; m < 4; ++m) { bf16* rowp = base + (size_t)(row0 + ai * HALF + m * 16) * ldc + col0;
#pragma unroll
                for (int bj = 0; bj < 2; ++bj) { const f32x4 v0 = acc[ai][bj][m][0], v1 = acc[ai][bj][m][1];
                    u32x4 w; w.x = pk2(v0[0], v0[1]); w.y = pk2(v0[2], v0[3]); w.z = pk2(v1[0], v1[1]); w.w = pk2(v1[2], v1[3]);
                    *(u32x4*)(rowp + bj * HALF) = w; } }
    }
};
struct EpiSwiGLU {
    static constexpr bool PERM = true, AFTER_DRAIN = false;
    bf16* O; int ldc;
    DEV void operator()(const f32x4 (&acc)[2][2][4][2], const Unit& u, int wr, int wc, int fr, int fq) const {
        const int row0 = u.pm * BM + wr * 64 + fr, col0 = u.pn * HALF + wc * 32 + 8 * fq;
#pragma unroll
        for (int ai = 0; ai < 2; ++ai)
#pragma unroll
            for (int m = 0; m < 4; ++m) { bf16* rowp = O + (size_t)(row0 + ai * HALF + m * 16) * ldc + col0;
                float h[8];
#pragma unroll
                for (int n = 0; n < 2; ++n)
#pragma unroll
                    for (int i = 0; i < 4; ++i) { const float ag = acc[ai][0][m][n][i], au = acc[ai][1][m][n][i]; h[4 * n + i] = (ag * au) * fast_rcp(1.0f + fast_exp2(ag)); }
                u32x4 w; w.x = pk2(h[0], h[1]); w.y = pk2(h[2], h[3]); w.z = pk2(h[4], h[5]); w.w = pk2(h[6], h[7]);
                *(u32x4*)rowp = w; }
    }
};
struct EpiF32S {
    static constexpr bool PERM = false, AFTER_DRAIN = false;
    float* O0; long dO1; int ldc;
    DEV void operator()(const f32x4 (&acc)[2][2][4][2], const Unit& u, int wr, int wc, int fr, int fq) const {
        float* base = O0 + (u.sub == 1 ? dO1 : 0);
        const int row0 = u.pm * BM + wr * 64 + fr, col0 = u.pn * BM + wc * 32 + 4 * fq;
#pragma unroll
        for (int ai = 0; ai < 2; ++ai)
#pragma unroll
            for (int m = 0; m < 4; ++m) { float* rowp = base + (size_t)(row0 + ai * HALF + m * 16) * ldc + col0;
#pragma unroll
                for (int bj = 0; bj < 2; ++bj)
#pragma unroll
                    for (int n = 0; n < 2; ++n) *(f32x4*)(rowp + bj * HALF + 16 * n) = acc[ai][bj][m][n]; }
    }
};

#ifdef EMU
template <class Epi, class Sched, bool ALIGN_EPI = false, bool SP2 = false>
inline void gemm_phase(unsigned char* lds, const Gemm g, const Sched& S, const Epi& E) {
    static thread_local std::vector<float> tile(256 * 256);
    const int tid = tid_l(), wid = tid >> 6, lane = tid & 63, wr = wid >> 2, wc = wid & 3, fr = lane & 15, fq = lane >> 4;
    Unit cur;
    for (int ui = 0; S.next(ui, cur); ++ui) {
        __syncthreads();
        if (tid == 0) {
            const bf16* A = (const bf16*)S.pa(cur); const bf16* B = (const bf16*)S.pb(cur);
            std::vector<float> af((size_t)256 * g.K), bfv((size_t)256 * g.K);
            for (int r = 0; r < 256; ++r) for (int k = 0; k < g.K; ++k) { af[(size_t)r * g.K + k] = bf2f(A[(size_t)r * g.lda + k]); bfv[(size_t)r * g.K + k] = bf2f(B[(size_t)r * g.ldb + k]); }
            for (int r = 0; r < 256; ++r) for (int c = 0; c < 256; ++c) { const float* a = &af[(size_t)r * g.K]; const float* b = &bfv[(size_t)c * g.K]; float s = 0.f; for (int k = 0; k < g.K; ++k) s += a[k] * b[k]; tile[r * 256 + c] = s; }
        }
        __syncthreads();
        f32x4 acc[2][2][4][2];
        for (int ai = 0; ai < 2; ++ai) for (int bj = 0; bj < 2; ++bj) for (int m = 0; m < 4; ++m) for (int n = 0; n < 2; ++n) for (int i = 0; i < 4; ++i) {
            const int r = 128 * ai + 64 * wr + 16 * m + fr; const int c = 128 * bj + 32 * wc + (Epi::PERM ? (8 * fq + 4 * n + i) : (16 * n + 4 * fq + i));
            acc[ai][bj][m][n][i] = tile[r * 256 + c]; }
        E(acc, cur, wr, wc, fr, fq);
    }
    __syncthreads();
}
#else
template <class Epi, class Sched, bool ALIGN_EPI = false, bool SP2 = false>
__device__ __forceinline__ void gemm_phase(LAS unsigned char* lds, const Gemm g, const Sched& S, const Epi& E) {
    const int tid = tid_l(), wid = __builtin_amdgcn_readfirstlane(tid >> 6), lane = tid & 63, wr = wid >> 2, wc = wid & 3, fr = lane & 15, fq = lane >> 4;
    const int K = g.K, nt = K / BK;
    unsigned voffA[2], voffB[2];
#pragma unroll
    for (int i = 0; i < 2; ++i) { int R, C; stage_rc(tid * 16 + i * 8192, R, C); const int Rb = Epi::PERM ? ((R & ~31) + perm32(R & 31)) : R;
        voffA[i] = (unsigned)(R * g.lda + C) * 2u; voffB[i] = (unsigned)(Rb * g.ldb + C) * 2u; }
    const size_t kstep = (size_t)(BK * 2);
    const size_t hstepA = (size_t)HALF * g.lda * 2, hstepB = (size_t)HALF * g.ldb * 2;
    const unsigned ldsw = (unsigned)wid * 1024u;
    const int aoff = lds_byte(wr * 64 + fr, fq * 8), boff = lds_byte(wc * 32 + fr, fq * 8);
#define PG8_SA(b, h) (((b) * 2 + (h)) * HTB)
#define PG8_SB(b, h) ((4 + (b) * 2 + (h)) * HTB)
#define PG8_STAGE(bufoff, gbase, voff) do { _Pragma("unroll") for (int _i = 0; _i < 2; ++_i) \
        __builtin_amdgcn_global_load_lds((const unsigned*)((const char*)(gbase) + (voff)[_i]), (LAS unsigned*)(lds + (bufoff) + ldsw + _i * 8192), 16, 0, 0); } while (0)
#define PG8_LDA(dst, b, h) do { _Pragma("unroll") for (int m = 0; m < 4; ++m) _Pragma("unroll") for (int k = 0; k < 2; ++k) dst[m][k] = *(const LAS bf16x8*)(lds + PG8_SA(b, h) + aoff + m * 2048 + k * 1024); } while (0)
#define PG8_LDB(dst, b, h) do { _Pragma("unroll") for (int n = 0; n < 2; ++n) _Pragma("unroll") for (int k = 0; k < 2; ++k) dst[n][k] = *(const LAS bf16x8*)(lds + PG8_SB(b, h) + boff + n * 2048 + k * 1024); } while (0)
#define PG8_MMA(ai, bj, At, Bt) do { __builtin_amdgcn_s_setprio(1); _Pragma("unroll") for (int m = 0; m < 4; ++m) _Pragma("unroll") for (int n = 0; n < 2; ++n) _Pragma("unroll") for (int k = 0; k < 2; ++k) \
        acc[ai][bj][m][n] = __builtin_amdgcn_mfma_f32_16x16x32_bf16(Bt[n][k], At[m][k], acc[ai][bj][m][n], 0, 0, 0); __builtin_amdgcn_s_setprio(0); } while (0)
#define PG8_WAIT_V(n) asm volatile("s_waitcnt vmcnt(" #n ")" ::: "memory")
#define PG8_WAIT_L(n) asm volatile("s_waitcnt lgkmcnt(" #n ")" ::: "memory")
#define PG8_BAR __builtin_amdgcn_s_barrier()
#define PG8_SCHED __builtin_amdgcn_sched_barrier(0)
    Unit cur, nxt; int ui = 0;
    if (!S.next(0, cur)) return;
    f32x4 acc[2][2][4][2];
#pragma unroll
    for (int a = 0; a < 2; ++a)
#pragma unroll
        for (int b = 0; b < 2; ++b)
#pragma unroll
            for (int m = 0; m < 4; ++m)
#pragma unroll
                for (int n = 0; n < 2; ++n) acc[a][b][m][n] = (f32x4){0.f, 0.f, 0.f, 0.f};
    bf16x8 At[4][2], B0[2][2], B1[2][2];
    const char* cA = S.pa(cur); const char* cB = S.pb(cur);
    S.a_ready(cur);
    if constexpr (SP2) {
        PG8_STAGE(PG8_SB(0, 0), cB, voffB); PG8_STAGE(PG8_SB(0, 1), cB + hstepB, voffB); PG8_STAGE(PG8_SA(0, 0), cA, voffA); PG8_STAGE(PG8_SA(0, 1), cA + hstepA, voffA);
        if (wr == 1) PG8_BAR;
        PG8_WAIT_V(2); PG8_BAR;
        PG8_STAGE(PG8_SB(1, 0), cB + kstep, voffB); PG8_STAGE(PG8_SA(1, 0), cA + kstep, voffA); PG8_STAGE(PG8_SB(1, 1), cB + hstepB + kstep, voffB);
        PG8_WAIT_V(6); PG8_BAR;
    } else {
        PG8_STAGE(PG8_SB(0, 0), cB, voffB); PG8_STAGE(PG8_SA(0, 0), cA, voffA); PG8_STAGE(PG8_SB(0, 1), cB + hstepB, voffB); PG8_STAGE(PG8_SA(0, 1), cA + hstepA, voffA);
        if (wr == 1) PG8_BAR;
        PG8_WAIT_V(4); PG8_BAR;
        PG8_STAGE(PG8_SB(1, 0), cB + kstep, voffB); PG8_STAGE(PG8_SA(1, 0), cA + kstep, voffA); PG8_STAGE(PG8_SB(1, 1), cB + hstepB + kstep, voffB);
        PG8_WAIT_V(6); PG8_BAR;
    }
    for (;;) {
        const bool has_next = S.next(ui + 1, nxt);
        const char* nA = has_next ? S.pa(nxt) : cA; const char* nB = has_next ? S.pb(nxt) : cB;
        for (int t = 0; t < nt; t += 2) {
            const bool last = (t == nt - 2);
            const char* a1 = cA + (size_t)(t + 1) * kstep;
            const char* a2 = last ? nA : cA + (size_t)(t + 2) * kstep; const char* b2 = last ? nB : cB + (size_t)(t + 2) * kstep;
            const char* a3 = a2 + kstep; const char* b3 = b2 + kstep;
            if (last && has_next) S.a_ready(nxt);
            if constexpr (SP2) {
            PG8_LDB(B0, 0, 0); PG8_LDB(B1, 0, 1); PG8_SCHED; PG8_LDA(At, 0, 0); PG8_STAGE(PG8_SA(1, 1), a1 + hstepA, voffA);
            PG8_WAIT_V(8); PG8_WAIT_L(0); PG8_BAR; PG8_MMA(0, 0, At, B0); PG8_MMA(0, 1, At, B1); PG8_BAR; PG8_SCHED;
            PG8_LDA(At, 0, 1); PG8_STAGE(PG8_SB(0, 0), b2, voffB); PG8_STAGE(PG8_SB(0, 1), b2 + hstepB, voffB); PG8_STAGE(PG8_SA(0, 0), a2, voffA);
            PG8_WAIT_V(8); PG8_WAIT_L(0); PG8_BAR; PG8_MMA(1, 0, At, B0); PG8_MMA(1, 1, At, B1); PG8_BAR; PG8_SCHED;
            PG8_LDB(B0, 1, 0); PG8_LDB(B1, 1, 1); PG8_SCHED; PG8_LDA(At, 1, 0); PG8_STAGE(PG8_SA(0, 1), a2 + hstepA, voffA);
            PG8_WAIT_V(8); PG8_WAIT_L(0); PG8_BAR; PG8_MMA(0, 0, At, B0); PG8_MMA(0, 1, At, B1); PG8_BAR; PG8_SCHED;
            PG8_LDA(At, 1, 1); PG8_STAGE(PG8_SB(1, 0), b3, voffB); PG8_STAGE(PG8_SB(1, 1), b3 + hstepB, voffB); PG8_STAGE(PG8_SA(1, 0), a3, voffA);
            PG8_WAIT_V(8); PG8_WAIT_L(0); PG8_BAR; PG8_MMA(1, 0, At, B0); PG8_MMA(1, 1, At, B1); PG8_BAR; PG8_SCHED;
            } else {
            PG8_LDB(B0, 0, 0); PG8_SCHED; PG8_LDA(At, 0, 0); PG8_STAGE(PG8_SA(1, 1), a1 + hstepA, voffA);
            PG8_WAIT_L(8); PG8_BAR; PG8_WAIT_L(0); PG8_MMA(0, 0, At, B0); PG8_BAR; PG8_SCHED;
            PG8_LDB(B1, 0, 1); PG8_STAGE(PG8_SB(0, 0), b2, voffB);
            PG8_BAR; PG8_WAIT_L(0); PG8_MMA(0, 1, At, B1); PG8_BAR;
            PG8_LDA(At, 0, 1); PG8_STAGE(PG8_SA(0, 0), a2, voffA);
            PG8_BAR; PG8_WAIT_L(0); PG8_MMA(1, 0, At, B0); PG8_BAR; PG8_SCHED;
            PG8_STAGE(PG8_SB(0, 1), b2 + hstepB, voffB);
            PG8_WAIT_V(6); PG8_BAR; PG8_MMA(1, 1, At, B1); PG8_BAR;
            PG8_LDB(B0, 1, 0); PG8_SCHED; PG8_LDA(At, 1, 0); PG8_STAGE(PG8_SA(0, 1), a2 + hstepA, voffA);
            PG8_WAIT_L(8); PG8_BAR; PG8_WAIT_L(0); PG8_MMA(0, 0, At, B0); PG8_BAR; PG8_SCHED;
            PG8_LDB(B1, 1, 1); PG8_STAGE(PG8_SB(1, 0), b3, voffB);
            PG8_BAR; PG8_WAIT_L(0); PG8_MMA(0, 1, At, B1); PG8_BAR;
            PG8_LDA(At, 1, 1); PG8_STAGE(PG8_SA(1, 0), a3, voffA);
            PG8_BAR; PG8_WAIT_L(0); PG8_MMA(1, 0, At, B0); PG8_BAR; PG8_SCHED;
            PG8_STAGE(PG8_SB(1, 1), b3 + hstepB, voffB);
            PG8_WAIT_V(6); PG8_BAR; PG8_MMA(1, 1, At, B1); PG8_BAR;
            }
        }
        if constexpr (ALIGN_EPI) { if (wr == 0) PG8_BAR; }
        if constexpr (!Epi::AFTER_DRAIN) { E(acc, cur, wr, wc, fr, fq); S.done(cur); }
        if (!has_next) break;
#pragma unroll
        for (int a = 0; a < 2; ++a)
#pragma unroll
            for (int b = 0; b < 2; ++b)
#pragma unroll
                for (int m = 0; m < 4; ++m)
#pragma unroll
                    for (int n = 0; n < 2; ++n) acc[a][b][m][n] = (f32x4){0.f, 0.f, 0.f, 0.f};
        cur = nxt; cA = nA; cB = nB; ++ui;
        if constexpr (ALIGN_EPI) { if (wr == 1) PG8_BAR; }
    }
    PG8_WAIT_V(0);
    if constexpr (!ALIGN_EPI) { if (wr == 0) PG8_BAR; }
    PG8_BAR;
#undef PG8_SA
#undef PG8_SB
#undef PG8_STAGE
#undef PG8_LDA
#undef PG8_LDB
#undef PG8_MMA
#undef PG8_WAIT_V
#undef PG8_WAIT_L
#undef PG8_BAR
#undef PG8_SCHED
}
#endif
}
struct Args {
    const float* in[35]; float* out; unsigned char* ws;
    int pad0, pad1;

};
#ifdef EMU
typedef const Args* KArgs;
extern thread_local const Args* emu_args_p;
thread_local const Args* emu_args_p = nullptr;
DEV KArgs kargs() { return emu_args_p; }
#else
typedef const __attribute__((address_space(4))) Args* KArgs;
DEV KArgs kargs() { unsigned long long k = (unsigned long long)__builtin_amdgcn_kernarg_segment_ptr(); asm volatile("" : "+s"(k)); return (KArgs)k; }
#endif
enum { I_XP = 0, I_XS, I_C, I_CCTX, I_CK, I_CV, I_CCKV, I_CKR, I_ST, I_MODW, I_MODB, I_NORMG, I_WG, I_WU, I_WD, I_EVIN, I_EVOUT, I_HCW, I_HCB, I_HW1, I_HB1, I_HW2, I_HB2, I_HW3,
       I_HFREQ, I_HBIAS, I_SINK, I_ODIN, I_ODOUT, I_HGLB, I_HGNORM, I_QNORM, I_WQB, I_KVNORM, I_WKVB };

#ifdef EMU
DEV void wsync() { emu_wave_sync(); }
#else
DEV void wsync() { asm volatile("s_waitcnt lgkmcnt(0)" ::: "memory"); __builtin_amdgcn_wave_barrier(); asm volatile("" ::: "memory"); }
#endif
struct TrJob { const float* src; bf16* dst; int N, ldd; float scale; };
DEV void tr_load(const TrJob& j, f32x4 (&v)[8], int lane) {
#pragma unroll
    for (int i = 0; i < 8; ++i) { const int kk = 8 * i + (lane >> 3); v[i] = __builtin_nontemporal_load((const f32x4*)&j.src[(size_t)kk * j.N + 4 * (lane & 7)]) * j.scale; }
}
DEV void tr_finish(const TrJob& j, const f32x4 (&v)[8], LAS float* scr, int lane) {
    wsync();
#pragma unroll
    for (int i = 0; i < 8; ++i) { const int kk = 8 * i + (lane >> 3);
#pragma unroll
        for (int x = 0; x < 4; ++x) scr[kk * 33 + 4 * (lane & 7) + x] = v[i][x]; }
    wsync();
    const int c = lane & 7;
#pragma unroll
    for (int jj = 0; jj < 4; ++jj) { const int n = (lane >> 3) + 8 * jj; const LAS float* s = scr + (8 * c) * 33 + n;
        u32x4 o; o.x = pk2(s[0 * 33], s[1 * 33]); o.y = pk2(s[2 * 33], s[3 * 33]); o.z = pk2(s[4 * 33], s[5 * 33]); o.w = pk2(s[6 * 33], s[7 * 33]);
        __builtin_nontemporal_store(o, (u32x4*)(j.dst + (size_t)n * j.ldd + 8 * c)); }
}
constexpr int tri(int K, int N, int nb) { return nb * (K / 64) * (N / 32); }
template <int K, int N, int LDD, int MODE>
DEV TrJob tr_job(const float* src, long sstride, bf16* dst, bf16* dst2, long dstride, int r) {
    constexpr int nblk = N / 32, per = (K / 64) * nblk; const int bt = r / per; r -= bt * per;
    const int kb = r / nblk, nb = r % nblk, k0 = 64 * kb, n0 = 32 * nb;
    bf16* WT = dst + (size_t)bt * dstride; int drow0 = n0;
    if (MODE == 1) drow0 = 256 * (n0 / 128) + (n0 % 128);
    else if (MODE == 2) drow0 = 256 * (n0 / 128) + 128 + (n0 % 128);
    else if (MODE == 3) { drow0 = 128 * (n0 / 256) + (n0 % 128); if ((n0 % 256) >= 128) WT = dst2; }
    TrJob j; j.src = src + (size_t)bt * sstride + (size_t)k0 * N + n0; j.dst = WT + (size_t)drow0 * LDD + k0; j.N = N; j.ldd = LDD;
    j.scale = MODE == 1 ? -1.4426950408889634f : (MODE == 2 ? -0.6931471805599453f : 1.0f); return j;
}
constexpr int NW_FFN = 2 * tri(D, DFF, 1) + tri(DFF, D, 1);
DEV TrJob ffn_w_job(KArgs a, int ls, int it) {
    unsigned char* ws = a->ws; constexpr int n1 = tri(D, DFF, 1);
    if (it < n1) return tr_job<D, DFF, D, 1>(a->in[I_WG] + (size_t)ls * D * DFF, 0, (bf16*)(ws + WS_WGU + (size_t)ls * SZ_WGU1), nullptr, 0, it);
    if (it < 2 * n1) return tr_job<D, DFF, D, 2>(a->in[I_WU] + (size_t)ls * D * DFF, 0, (bf16*)(ws + WS_WGU + (size_t)ls * SZ_WGU1), nullptr, 0, it - n1);
    return tr_job<DFF, D, DFF, 0>(a->in[I_WD] + (size_t)ls * D * DFF, 0, (bf16*)(ws + WS_WD + (size_t)ls * SZ_WD1), nullptr, 0, it - 2 * n1);
}
constexpr int NW_EV = tri(D, EV_IN, 1) + tri(D, D, 1) + tri(PAST, 128, NB_S * 2);
DEV TrJob ev_w_job(KArgs a, int it) {
    unsigned char* ws = a->ws; constexpr int n1 = tri(D, EV_IN, 1), n2 = n1 + tri(D, D, 1);
    if (it < n1) return tr_job<D, EV_IN, D, 0>(a->in[I_EVIN], 0, (bf16*)(ws + WS_WEVIN), nullptr, 0, it);
    if (it < n2) return tr_job<D, D, D, 0>(a->in[I_EVOUT], 0, (bf16*)(ws + WS_WEVOUT), nullptr, 0, it - n1);
    return tr_job<PAST, 128, PAST, 0>(a->in[I_CV], (long)PAST * 128, (bf16*)(ws + WS_VTC), nullptr, (long)PAST * 128, it - n2);
}
constexpr int NW_OD = tri(D, OD_IN, 1) + tri(D, D, 1) + tri(512, 1536, 1) + tri(256, 2048, 1);
DEV TrJob od_w_job(KArgs a, int it) {
    unsigned char* ws = a->ws; constexpr int n1 = tri(D, OD_IN, 1), n2 = n1 + tri(D, D, 1), n3 = n2 + tri(512, 1536, 1);
    if (it < n1) return tr_job<D, OD_IN, D, 0>(a->in[I_ODIN], 0, (bf16*)(ws + WS_WODIN), nullptr, 0, it);
    if (it < n2) return tr_job<D, D, D, 0>(a->in[I_ODOUT], 0, (bf16*)(ws + WS_WODOUT), nullptr, 0, it - n1);
    if (it < n3) return tr_job<512, 1536, 512, 0>(a->in[I_WQB], 0, (bf16*)(ws + WS_WQB), nullptr, 0, it - n2);
    return tr_job<256, 2048, 256, 3>(a->in[I_WKVB], 0, (bf16*)(ws + WS_WKVK), (bf16*)(ws + WS_WKVV), 0, it - n3);
}
constexpr int NW_GU = 2 * tri(D, DFF, 1), NW_WD = tri(DFF, D, 1), NW_EVW = tri(D, EV_IN, 1) + tri(D, D, 1), NW_VTC = NW_EV - NW_EVW, NW_ODIN = tri(D, OD_IN, 1), NW_ODR = NW_OD - NW_ODIN;
template <int TL> constexpr int tl_count() { return TL == 0 ? NW_GU + NW_EV : TL == 3 ? NW_WD + NW_FFN : TL == 12 ? NW_FFN + NW_ODR : TL == 15 ? NW_GU + NW_ODIN : NW_WD; }
template <int TL> DEV TrJob tl_job(KArgs a, int it) {
    if constexpr (TL == 0) { if (it < NW_GU) return ffn_w_job(a, 0, it); return ev_w_job(a, it - NW_GU); }
    else if constexpr (TL == 3) { if (it < NW_WD) return ffn_w_job(a, 0, NW_GU + it); return ffn_w_job(a, 1, it - NW_WD); }
    else if constexpr (TL == 12) { if (it < NW_FFN) return ffn_w_job(a, 2, it); return od_w_job(a, NW_ODIN + it - NW_FFN); }
    else if constexpr (TL == 15) { if (it < NW_GU) return ffn_w_job(a, 3, it); return od_w_job(a, it - NW_GU); }
    else return ffn_w_job(a, 3, NW_GU + it);
}
template <int TL> DEV void run_tr_jobs(KArgs a, int gw, int NGW, LAS float* scr, int lane) {
    constexpr int n = tl_count<TL>();
    if (gw >= n) return;
    TrJob j0 = tl_job<TL>(a, gw), j1 = j0, j2 = j0, j3 = j0; f32x4 v0[8], v1[8], v2[8], v3[8]; tr_load(j0, v0, lane);
    if (gw + NGW < n) { j1 = tl_job<TL>(a, gw + NGW); tr_load(j1, v1, lane); }
    if (gw + 2 * NGW < n) { j2 = tl_job<TL>(a, gw + 2 * NGW); tr_load(j2, v2, lane); }
    for (int it = gw; ; it += 4 * NGW) {
        if (it + 3 * NGW < n) { j3 = tl_job<TL>(a, it + 3 * NGW); tr_load(j3, v3, lane); }
        tr_finish(j0, v0, scr, lane);
        if (it + NGW >= n) break;
        if (it + 4 * NGW < n) { j0 = tl_job<TL>(a, it + 4 * NGW); tr_load(j0, v0, lane); }
        tr_finish(j1, v1, scr, lane);
        if (it + 2 * NGW >= n) break;
        if (it + 5 * NGW < n) { j1 = tl_job<TL>(a, it + 5 * NGW); tr_load(j1, v1, lane); }
        tr_finish(j2, v2, scr, lane);
        if (it + 3 * NGW >= n) break;
        if (it + 6 * NGW < n) { j2 = tl_job<TL>(a, it + 6 * NGW); tr_load(j2, v2, lane); }
        tr_finish(j3, v3, scr, lane);
        if (it + 4 * NGW >= n) break;
    }
}
constexpr int NW_GEMV = GV_KS * (MODW / 256);
constexpr int NW_GEMV_A = (GV_KS / 8) * (MODW / 256);
DEV void p0_gemv_item(KArgs a, int l, int it, LAS float* scr, int lane) {
    constexpr int NCB = MODW / 256;
    const int cb = it % NCB, ks = it / NCB;
    const float* c = a->in[I_C]; const float* cctx = a->in[I_CCTX];
    wsync();
    for (int e = lane; e < NGRP * GV_KC; e += 64) { const int g = e / GV_KC, kk = e % GV_KC, k = ks * GV_KC + kk; const float v = (g == 0) ? cctx[k] : c[(size_t)(g - 1) * D + k]; scr[e] = silu_f(v); }
    wsync();
    f32x4 acc[NGRP];
#pragma unroll
    for (int g = 0; g < NGRP; ++g) acc[g] = (f32x4){0.f, 0.f, 0.f, 0.f};
    const float* wp = a->in[I_MODW] + ((size_t)l * D + (size_t)ks * GV_KC) * MODW + cb * 256 + lane * 4;
#pragma unroll 8
    for (int kk = 0; kk < GV_KC; ++kk) { const f32x4 w = __builtin_nontemporal_load((const f32x4*)(wp + (size_t)kk * MODW));
#pragma unroll
        for (int g = 0; g < NGRP; ++g) acc[g] += w * scr[g * GV_KC + kk]; }
    float* po = (float*)(a->ws + WS_MODP) + ((size_t)(ks * 2 + l) * NGRP) * MODW + cb * 256 + lane * 4;
#pragma unroll
    for (int g = 0; g < NGRP; ++g) *(f32x4*)(po + (size_t)g * MODW) = acc[g];
}
DEV void p0_filter_item(KArgs a, int it, LAS float* scr, int lane) {
    const int set = it >= L_P ? 1 : 0, t = set ? it - L_P : it, L = set ? L_S : L_P;
    const float* w1 = a->in[I_HW1]; const float* b1 = a->in[I_HB1]; const float* w2 = a->in[I_HW2]; const float* b2 = a->in[I_HB2]; const float* fr = a->in[I_HFREQ];
    LAS float* z = scr; LAS float* h1 = scr + 64;
    wsync();
    if (lane < 33) { float v;
        if (lane == 0) v = (float)((double)t / (double)(L - 1));
        else { const int i = (lane - 1) & 15; const double fb = 1e-4 + (double)i * ((15.0 - 1e-4) / 15.0); const double w = 2.0 * 3.14159265358979323846 * (double)t / (double)L;
            v = (lane <= 16) ? (float)cos(fb * w) : (float)(-sin(fb * w)); }
        z[lane] = v; }
    wsync();
    { float s = b1[lane];
#pragma unroll 3
      for (int i = 0; i < 33; ++i) s += z[i] * w1[i * 64 + lane]; h1[lane] = sinf(fr[lane] * s); }
    wsync();
    { float s = b2[lane];
#pragma unroll 4
      for (int i = 0; i < 64; ++i) s += h1[i] * w2[i * 64 + lane]; ((float*)(a->ws + WS_H2))[(size_t)it * 64 + lane] = sinf(fr[lane] * s); }
}
DEV void p1_filter_item(KArgs a, int it, LAS float* scr, int lane) {
    const int cb = it & 15, tb = it >> 4; const int it0 = 8 * tb, set = it0 >= L_P ? 1 : 0, t0 = set ? it0 - L_P : it0, L = set ? L_S : L_P;
    const float* w3 = a->in[I_HW3]; const float* H2 = (const float*)(a->ws + WS_H2) + (size_t)it0 * 64;
    wsync();
#pragma unroll
    for (int k = 0; k < 8; ++k) scr[k * 64 + lane] = H2[k * 64 + lane];
    wsync();
    f32x4 acc[8];
#pragma unroll
    for (int k = 0; k < 8; ++k) acc[k] = (f32x4){0.f, 0.f, 0.f, 0.f};
    const float* wp = w3 + cb * 256 + lane * 4;
#pragma unroll 8
    for (int j = 0; j < 64; ++j) { const f32x4 w = *(const f32x4*)(wp + (size_t)j * 4096);
#pragma unroll
        for (int k = 0; k < 8; ++k) acc[k] += w * scr[k * 64 + j]; }
    const int col = cb * 256 + lane * 4, nd = col >> 10, c0 = col & 1023;
    bf16* FT = (bf16*)(a->ws + WS_FILT) + (set ? (size_t)4 * 1024 * L_P : 0);
    const float lo = -3.0701134573253946f, hi = -15.350567286626973f;
#pragma unroll
    for (int i = 0; i < 4; ++i) { const float delta = fabsf(lo + (hi - lo) * ((float)(c0 + i) / 1023.0f)); float v[8];
#pragma unroll
        for (int k = 0; k < 8; ++k) { const float tl = (float)(t0 + k) * (1.0f / (float)(L - 1)); v[k] = acc[k][i] * __expf(-tl * delta); }
        u32x4 o; o.x = pk2(v[0], v[1]); o.y = pk2(v[2], v[3]); o.z = pk2(v[4], v[5]); o.w = pk2(v[6], v[7]);
        *(u32x4*)(FT + ((size_t)(nd * 1024 + c0 + i)) * L + t0) = o; }
}
DEV void p0_prologue(KArgs a, LAS unsigned char* lds, int bid, int G) {
    const int tid = tid_l(), lane = tid & 63, wave = __builtin_amdgcn_readfirstlane(tid >> 6);
    LAS float* scr = (LAS float*)(lds + wave * 16384);
    const int gw = bid * NWAVES + wave, NGW = G * NWAVES;
    for (int it = gw; it < NW_GEMV; it += NGW) p0_gemv_item(a, 0, it, scr, lane);
    run_tr_jobs<0>(a, gw, NGW, scr, lane);
    for (int it = gw; it < L_P + L_S; it += NGW) p0_filter_item(a, it, scr, lane);
    const size_t gt = (size_t)bid * NTHR + tid, NGT = (size_t)G * NTHR;
    { const float* s = a->in[I_CK]; bf16* d = (bf16*)(a->ws + WS_KC); const size_t n = (size_t)NB_S * 2 * PAST * 128 / 4;
      for (size_t i = gt; i < n; i += NGT) { const f32x4 v = *(const f32x4*)(s + 4 * i); u32x2 o; o.x = pk2(v[0], v[1]); o.y = pk2(v[2], v[3]); *(u32x2*)(d + 4 * i) = o; } }
}
DEV void mods_finalize(KArgs a, int l, size_t idx, size_t nthr) {
    const size_t n = (size_t)NGRP * MODW / 4; const float* part = (const float*)(a->ws + WS_MODP); float* mods = (float*)(a->ws + WS_MODS);
    for (size_t i = idx; i < n; i += nthr) { const size_t e = (size_t)l * NGRP * MODW + 4 * i; const int col = (int)((4 * i) % MODW);
        f32x4 s = *(const f32x4*)(a->in[I_MODB] + (size_t)l * MODW + col);
        for (int ks = 0; ks < GV_KS; ++ks) s += *(const f32x4*)(part + (size_t)ks * 2 * NGRP * MODW + e);
        *(f32x4*)(mods + e) = s; }
}
DEV int gemm_groups(int units, int G) { const int r = (units + G - 1) / G; return (units + r - 1) / r; }
template <int ph>
DEV void conv_work(KArgs a, LAS unsigned char* lds, int ib, int nconv) {
    const int tid = tid_l(), lane = tid & 63, wave = __builtin_amdgcn_readfirstlane(tid >> 6);
    LAS float* scr = (LAS float*)(lds + wave * 16384);
    const int gw = ib * NWAVES + wave, NGW = nconv * NWAVES;
    if constexpr (ph == 3) { run_tr_jobs<3>(a, gw, NGW, scr, lane); for (int it = gw; it < NW_GEMV_A; it += NGW) p0_gemv_item(a, 1, it, scr, lane); }
    if constexpr (ph == 6) { for (int it = NW_GEMV_A + gw; it < NW_GEMV; it += NGW) p0_gemv_item(a, 1, it, scr, lane); }
    if constexpr (ph == 12) { mods_finalize(a, 1, (size_t)ib * NTHR + tid, (size_t)nconv * NTHR); run_tr_jobs<12>(a, gw, NGW, scr, lane); }
    if constexpr (ph == 15) run_tr_jobs<15>(a, gw, NGW, scr, lane);
    if constexpr (ph == 18) run_tr_jobs<18>(a, gw, NGW, scr, lane);
}
DEV void p1_mods(KArgs a, LAS unsigned char* lds, int bid, int G) {
    { const int tid = tid_l(), lane = tid & 63, wave = __builtin_amdgcn_readfirstlane(tid >> 6); LAS float* scr = (LAS float*)(lds + wave * 16384);
      for (int it = bid * NWAVES + wave; it < ((L_P + L_S) / 8) * 16; it += G * NWAVES) p1_filter_item(a, it, scr, lane); }
    mods_finalize(a, 0, (size_t)bid * NTHR + tid_l(), (size_t)G * NTHR);
}

DEV const float* modvec(KArgs a, int l, int g, int j) { return (const float*)(a->ws + WS_MODS) + ((size_t)(l * NGRP + g) * NMOD + j) * D; }
DEV void prenorm_store(const f32x4 (&x)[8], const float* gpre, const float* shift, const float* scale, bf16* hrow, int lane) {
    float ss = 0.f;
#pragma unroll
    for (int j = 0; j < 8; ++j) ss += (x[j][0] * x[j][0] + x[j][1] * x[j][1]) + (x[j][2] * x[j][2] + x[j][3] * x[j][3]);
    const float rstd = rsqrtf(wave_sum(ss) * (1.0f / D) + 1e-6f);
#pragma unroll
    for (int j = 0; j < 8; ++j) { const int e = 256 * j + 4 * lane; const f32x4 g = *(const f32x4*)(gpre + e), sh = *(const f32x4*)(shift + e), sc = *(const f32x4*)(scale + e);
        const f32x4 h = x[j] * rstd * g * (1.0f + sc) + sh;
        u32x2 o; o.x = pk2(h[0], h[1]); o.y = pk2(h[2], h[3]); *(u32x2*)(hrow + e) = o; }
}
DEV void phase_norm0(KArgs a, int bid, int G) {
    const int lane = tid_l() & 63, gw = bid * NWAVES + (tid_l() >> 6), NGW = G * NWAVES;
    bf16* HN = (bf16*)(a->ws + WS_HN); const float* ng = a->in[I_NORMG];
    for (int row = gw; row < T; row += NGW) {
        const float* xr = row < TP ? a->in[I_XP] + (size_t)row * D : a->in[I_XS] + (size_t)(row - TP) * D; const int g = grp_of_row(row);
        f32x4 x[8];
#pragma unroll
        for (int j = 0; j < 8; ++j) x[j] = *(const f32x4*)(xr + 256 * j + 4 * lane);
        prenorm_store(x, ng + (size_t)(0 * 6 + 0) * D, modvec(a, 0, g, 0), modvec(a, 0, g, 1), HN + (size_t)row * D, lane);
    }
}
DEV void phase_residual(KArgs a, LAS unsigned char* lds, int bid, int G, int l, int j, float w, int nl, int nj, bool first, bool last) {
    const int tid = tid_l(), lane = tid & 63, wave = tid >> 6;
    LAS float* vec = (LAS float*)lds;
    bf16* HN = (bf16*)(a->ws + WS_HN); const float* ng = a->in[I_NORMG]; _Float16* X = (_Float16*)(a->ws + WS_X);
    const bf16* O0 = (const bf16*)(a->ws + WS_OUT); const bf16* O1 = O0 + (size_t)T * D;
    for (int chunk = bid; chunk < T / 16; chunk += G) {
        const int row0 = 16 * chunk, g = grp_of_row(row0);
        lds_barrier();
        for (int e = tid; e < 5 * D / 4; e += NTHR) { const int v = e / (D / 4), i = 4 * (e % (D / 4)); const float* src;
            if (v == 0) src = modvec(a, l, g, 3 * j + 2); else if (v == 1) src = ng + (size_t)(l * 6 + 2 * j + 1) * D;
            else if (nl < 0) src = ng; else if (v == 2) src = ng + (size_t)(nl * 6 + 2 * nj) * D; else if (v == 3) src = modvec(a, nl, g, 3 * nj); else src = modvec(a, nl, g, 3 * nj + 1);
            *(LAS f32x4*)(vec + v * D + i) = *(const f32x4*)(src + i); }
        lds_barrier();
        u32x2 p0[2][8], p1[2][8]; f32x4 x[2][8]; float ss[2];
#define UNPK_SUM(a_, b_) (f32x4){__uint_as_float((a_).x << 16) + __uint_as_float((b_).x << 16), __uint_as_float((a_).x & 0xffff0000u) + __uint_as_float((b_).x & 0xffff0000u), \
                                 __uint_as_float((a_).y << 16) + __uint_as_float((b_).y << 16), __uint_as_float((a_).y & 0xffff0000u) + __uint_as_float((b_).y & 0xffff0000u)}
#pragma unroll
        for (int rr = 0; rr < 2; ++rr) { const int row = row0 + 2 * wave + rr;
            const float* xr = row < TP ? a->in[I_XP] + (size_t)row * D : a->in[I_XS] + (size_t)(row - TP) * D; const _Float16* xh = X + (size_t)row * D;
#pragma unroll
            for (int k = 0; k < 8; ++k) { const int e = 256 * k + 4 * lane; p0[rr][k] = __builtin_nontemporal_load((const u32x2*)(O0 + (size_t)row * D + e)); p1[rr][k] = __builtin_nontemporal_load((const u32x2*)(O1 + (size_t)row * D + e));
                if (first) x[rr][k] = *(const f32x4*)(xr + e); else x[rr][k] = __builtin_convertvector(__builtin_nontemporal_load((const f16x4*)(xh + e)), f32x4); } }
#pragma unroll
        for (int rr = 0; rr < 2; ++rr) { float s = 0.f;
#pragma unroll
            for (int k = 0; k < 8; ++k) { const f32x4 o = UNPK_SUM(p0[rr][k], p1[rr][k]); s += (o[0] * o[0] + o[1] * o[1]) + (o[2] * o[2] + o[3] * o[3]); }
            ss[rr] = s; }
#pragma unroll
        for (int of = 1; of < 64; of <<= 1) { ss[0] += __shfl_xor(ss[0], of); ss[1] += __shfl_xor(ss[1], of); }
        float s2[2];
#pragma unroll
        for (int rr = 0; rr < 2; ++rr) { const int row = row0 + 2 * wave + rr; const float rstd = rsqrtf(ss[rr] * (1.0f / D) + 1e-6f);
            float* xo = a->out + OUT_Y + (size_t)row * D; _Float16* xoh = X + (size_t)row * D; float s = 0.f;
#pragma unroll
            for (int k = 0; k < 8; ++k) { const int e = 256 * k + 4 * lane; const f32x4 gt = *(const LAS f32x4*)(vec + e), gp = *(const LAS f32x4*)(vec + D + e); const f32x4 o = UNPK_SUM(p0[rr][k], p1[rr][k]);
                x[rr][k] = x[rr][k] + w * gt * (o * rstd * gp);
                if (last) __builtin_nontemporal_store(x[rr][k], (f32x4*)(xo + e)); else __builtin_nontemporal_store(__builtin_convertvector(x[rr][k], f16x4), (f16x4*)(xoh + e));
                s += (x[rr][k][0] * x[rr][k][0] + x[rr][k][1] * x[rr][k][1]) + (x[rr][k][2] * x[rr][k][2] + x[rr][k][3] * x[rr][k][3]); SCHED_FENCE(); }
            s2[rr] = s; }
#undef UNPK_SUM
        if (nl >= 0) {
#pragma unroll
            for (int of = 1; of < 64; of <<= 1) { s2[0] += __shfl_xor(s2[0], of); s2[1] += __shfl_xor(s2[1], of); }
#pragma unroll
            for (int rr = 0; rr < 2; ++rr) { const int row = row0 + 2 * wave + rr; const float rstd = rsqrtf(s2[rr] * (1.0f / D) + 1e-6f);
#pragma unroll
                for (int k = 0; k < 8; ++k) { const int e = 256 * k + 4 * lane; const f32x4 gq = *(const LAS f32x4*)(vec + 2 * D + e), sh = *(const LAS f32x4*)(vec + 3 * D + e), sc = *(const LAS f32x4*)(vec + 4 * D + e);
                    const f32x4 h = x[rr][k] * rstd * gq * (1.0f + sc) + sh; u32x2 ow; ow.x = pk2(h[0], h[1]); ow.y = pk2(h[2], h[3]); *(u32x2*)(HN + (size_t)row * D + e) = ow; SCHED_FENCE(); } }
        }
    }
}
constexpr float LOG2E = 1.4426950408889634f;
DEV void phase_rope_kvout(KArgs a, int bid, int G) {
    const int lane = tid_l() & 63, gw = bid * NWAVES + (tid_l() >> 6), NGW = G * NWAVES;
    bf16* QKV = (bf16*)(a->ws + WS_QKV);
    for (int it = gw; it < TS * 10; it += NGW) {
        const int ts = it / 10, slot = it % 10, pos = ts % L_S; bf16* p = QKV + (size_t)(TP + ts) * NQKV + slot * 128;
        const int half = lane >> 5, dd = lane & 31, d1 = 64 * half + dd;
        const float inv = exp2f(-(float)dd * (13.287712379549449f / 32.0f));
        const float ang = (float)(half ? (pos % 64) : (pos / 64)) * inv; const float cs = fast_cos(ang), sn = fast_sin(ang);
        const float x1 = bf2f(p[d1]), x2 = bf2f(p[d1 + 32]);
        p[d1] = (bf16)f2bf(x1 * cs - x2 * sn); p[d1 + 32] = (bf16)f2bf(x2 * cs + x1 * sn);
    }
    const size_t gt = (size_t)bid * NTHR + tid_l(), NGT = (size_t)G * NTHR; const size_t n = (size_t)NB_P * 2 * L_P * 128;
    for (size_t i = gt; i < 2 * n; i += NGT) { const int isv = i >= n; const size_t o = isv ? i - n : i; const int d = (int)(o % 128), t = (int)((o / 128) % L_P), kvh = (int)((o / ((size_t)128 * L_P)) % 2), b = (int)(o / ((size_t)256 * L_P));
        a->out[(isv ? OUT_V : OUT_K) + o] = bf2f(QKV[(size_t)(b * L_P + t) * NQKV + 1024 + 256 * isv + kvh * 128 + d]); }
}
template <int L, int NB> struct HyRegs { static constexpr int NUC = (3 * NB * L / 8 + NTHR - 1) / NTHR, NFC = (4 * L / 8 + NTHR - 1) / NTHR; u32x4 u[NUC]; u32x4 f[NFC]; float w[3][3], cb[3], hb[2]; };
template <int L, int NB>
DEV void hyena_load(KArgs a, int c, int tok0, const bf16* FT, HyRegs<L, NB>& g, int tid) {
    const bf16* UT = (const bf16*)(a->ws + WS_UT); const float* cw = a->in[I_HCW]; const float* cb = a->in[I_HCB]; const float* hb = a->in[I_HBIAS];
#pragma unroll
    for (int k = 0; k < HyRegs<L, NB>::NUC; ++k) { const int e = tid + NTHR * k; if (e < 3 * NB * L / 8) { const int x = e / (NB * L / 8), i = e % (NB * L / 8), b = i / (L / 8), t8 = i % (L / 8);
        g.u[k] = __builtin_nontemporal_load((const u32x4*)(UT + (size_t)(1024 * x + c) * T + tok0 + b * L + 8 * t8)); } }
#pragma unroll
    for (int k = 0; k < HyRegs<L, NB>::NFC; ++k) { const int e = tid + NTHR * k; if (e < 4 * L / 8) { const int nd = e / (L / 8), t8 = e % (L / 8); g.f[k] = *(const u32x4*)(FT + ((size_t)nd * 1024 + c) * L + 8 * t8); } }
#pragma unroll
    for (int x = 0; x < 3; ++x) { const int ch = 1024 * x + c; g.w[x][0] = cw[ch]; g.w[x][1] = cw[3072 + ch]; g.w[x][2] = cw[2 * 3072 + ch]; g.cb[x] = cb[ch]; }
    g.hb[0] = hb[c]; g.hb[1] = hb[1024 + c];
}
template <int L, int NB>
DEV void hyena_item(KArgs a, LAS unsigned char* lds, int c, int tok0, const HyRegs<L, NB>& g) {
    constexpr int ZP = L + 8, UP = L + 16, NTW = L / 128, NS = L / 32, CS = 2 * L + 32;
    LAS bf16* zin = (LAS bf16*)lds; LAS bf16* z1 = zin + NB * ZP; LAS bf16* R = z1 + NB * ZP; LAS bf16* U = R + 2 * 4 * CS;
    const int tid = tid_l(), lane = tid & 63, wave = tid >> 6, q = lane >> 4, r = lane & 15;
    bf16* YT = (bf16*)(a->ws + WS_YT);
#pragma unroll
    for (int k = 0; k < HyRegs<L, NB>::NUC; ++k) { const int e = tid + NTHR * k; if (e < 3 * NB * L / 8) { const int x = e / (NB * L / 8), i = e % (NB * L / 8), b = i / (L / 8), t8 = i % (L / 8);
        *(LAS u32x4*)(U + (x * NB + b) * UP + 8 + 8 * t8) = g.u[k]; } }
    for (int e = tid; e < 3 * NB * 2; e += NTHR) { const int rowi = e >> 1; U[rowi * UP + ((e & 1) ? 8 + L : 7)] = 0; }
#pragma unroll
    for (int k = 0; k < HyRegs<L, NB>::NFC; ++k) { const int e = tid + NTHR * k; if (e < 4 * L / 8) { const int nd = e / (L / 8), t8 = e % (L / 8), n = nd >> 1, dir = nd & 1; const bf16x8 v = __builtin_bit_cast(bf16x8, g.f[k]);
#pragma unroll
        for (int j = 0; j < 8; ++j) { const int t = 8 * t8 + j; if (dir == 1 && t == 0) continue; const int i = dir ? L + t : L - t;
#pragma unroll
            for (int m = 0; m < 4; ++m) if (i - m >= 0) R[(n * 4 + m) * CS + i - m] = (bf16)v[j]; } } }
    lds_barrier();
    { const float w0 = g.w[0][0], w1 = g.w[0][1], w2 = g.w[0][2], bb = g.cb[0];
      for (int e = tid; e < NB * L / 4; e += NTHR) { const int b = e / (L / 4), t = 4 * (e % (L / 4)); const LAS bf16* u = U + b * UP + 8 + t; float uu[6];
#pragma unroll
          for (int x = 0; x < 6; ++x) uu[x] = bf2f(u[x - 1]);
          u32x2 w; w.x = pk2(bb + w0 * uu[0] + w1 * uu[1] + w2 * uu[2], bb + w0 * uu[1] + w1 * uu[2] + w2 * uu[3]); w.y = pk2(bb + w0 * uu[2] + w1 * uu[3] + w2 * uu[4], bb + w0 * uu[3] + w1 * uu[4] + w2 * uu[5]);
          *(LAS u32x2*)(zin + b * ZP + t) = w; } }
    lds_barrier();
    const int i0 = wave * NTW;
#pragma unroll
    for (int n = 0; n < 2; ++n) {
        const LAS bf16* zi = n == 0 ? zin : z1; const LAS bf16* Rn = R + n * 4 * CS;
        f32x4 acc[NTW];
#pragma unroll
        for (int i = 0; i < NTW; ++i) acc[i] = (f32x4){0.f, 0.f, 0.f, 0.f};
        constexpr int KB = 4, NWV = NTW + 2 * (KB - 1), NKB = NS / KB;
        static_assert(NS % KB == 0, "s-tiles per step");
        const int mshift = (4 - (r & 3)) & 3;
        const LAS bf16* zrow = zi + (r % NB) * ZP + 8 * q; const LAS bf16* Cb = Rn + mshift * CS - mshift + (L - (16 * i0 + r - 8 * q));
#define HY_LOAD(Bf_, Af_, kb_) do { \
            _Pragma("unroll") for (int kk = 0; kk < KB; ++kk) Bf_[kk] = *(const LAS bf16x8*)(zrow + 32 * (KB * (kb_) + kk)); \
            _Pragma("unroll") for (int wv = 0; wv < NWV; ++wv) { const LAS bf16* Cm = Cb + 32 * KB * (kb_) - 16 * (wv - 2 * (KB - 1)); const bf16x4 a0 = *(const volatile LAS bf16x4*)Cm, a1 = *(const volatile LAS bf16x4*)(Cm + 4);     \
                bf16x8 A; A[0] = a0[0]; A[1] = a0[1]; A[2] = a0[2]; A[3] = a0[3]; A[4] = a1[0]; A[5] = a1[1]; A[6] = a1[2]; A[7] = a1[3]; Af_[wv] = A; } } while (0)
#define HY_MMA(Bf_, Af_) do { \
            _Pragma("unroll") for (int kk = 0; kk < KB; ++kk) _Pragma("unroll") for (int ii = 0; ii < NTW; ++ii) acc[ii] = mfma16(Af_[ii - 2 * kk + 2 * (KB - 1)], Bf_[kk], acc[ii]); } while (0)
        bf16x8 Bf0[KB], Af0[NWV], Bf1[KB], Af1[NWV];
        HY_LOAD(Bf0, Af0, 0);
        for (int kb = 0; kb < NKB; kb += 2) {
            if (kb + 1 < NKB) HY_LOAD(Bf1, Af1, kb + 1);
            HY_MMA(Bf0, Af0);
            if (kb + 1 >= NKB) break;
            if (kb + 2 < NKB) HY_LOAD(Bf0, Af0, kb + 2);
            HY_MMA(Bf1, Af1);
        }
#undef HY_LOAD
#undef HY_MMA
        if (r < NB) {
            const float w0 = g.w[n + 1][0], w1 = g.w[n + 1][1], w2 = g.w[n + 1][2], bb = g.cb[n + 1], hbias = g.hb[n];
            const LAS bf16* ug = U + ((n + 1) * NB + r) * UP + 8;
#pragma unroll
            for (int ti = 0; ti < NTW; ++ti) { const int t = 16 * (i0 + ti) + 4 * q; float uu[6];
#pragma unroll
                for (int x = 0; x < 6; ++x) uu[x] = bf2f(ug[t - 1 + x]);
                float o[4];
#pragma unroll
                for (int x = 0; x < 4; ++x) { const float gate = bb + w0 * uu[x] + w1 * uu[x + 1] + w2 * uu[x + 2]; o[x] = gate * (acc[ti][x] + hbias * bf2f(zi[r * ZP + t + x])); }
                u32x2 w; w.x = pk2(o[0], o[1]); w.y = pk2(o[2], o[3]);
                if (n == 0) *(LAS u32x2*)(z1 + r * ZP + t) = w; else __builtin_nontemporal_store(w, (u32x2*)(YT + (size_t)c * T + tok0 + r * L + t)); }
        }
        lds_barrier();
    }
}
template <int L, int NB>
DEV void hyena_run(KArgs a, LAS unsigned char* lds, int first, int last, int G, int cbase, int tok0, const bf16* FT) {
    if (first >= last) return;
    const int tid = tid_l();
    HyRegs<L, NB> cur; hyena_load<L, NB>(a, first - cbase, tok0, FT, cur, tid);
    for (int it = first; it < last; it += G) {
        HyRegs<L, NB> nx = cur; const int nxt = it + G;
        if (nxt < last) hyena_load<L, NB>(a, nxt - cbase, tok0, FT, nx, tid);
        hyena_item<L, NB>(a, lds, it - cbase, tok0, cur);
        cur = nx;
    }
}
DEV void phase_hyena(KArgs a, LAS unsigned char* lds, int bid, int G) {
    const bf16* fp = (const bf16*)(a->ws + WS_FILT); const bf16* fs = fp + (size_t)4 * 1024 * L_P;
    hyena_run<L_S, NB_S>(a, lds, bid, 1024, G, 0, TP, fs);
    const int firstp = bid + ((1024 - bid + G - 1) / G) * G;
    hyena_run<L_P, NB_P>(a, lds, firstp, 2048, G, 1024, 0, fp);
    __syncthreads();
}

template <int NKS, bool WIN>
DEV void attn_segment(float& m, float& lsum, f32x4 (&o)[8], const bf16x8 (&Q)[NKS], const bf16* K, int ldk, const bf16* KR, const bf16* VT, int ldvt, int k0, int k1, int qpos, float sc, int r, int q) {
    for (int kt = k0; kt < k1; kt += 32) {
        f32x4 s[2];
#pragma unroll
        for (int tl = 0; tl < 2; ++tl) { s[tl] = (f32x4){0.f, 0.f, 0.f, 0.f}; const bf16* krow = K + (size_t)(kt + 16 * tl + r) * ldk + 8 * q;
#pragma unroll
            for (int ks = 0; ks < 4; ++ks) s[tl] = mfma16(ld_bf16x8(krow + 32 * ks), Q[ks], s[tl]);
            if constexpr (NKS > 4) { const bf16* kr = KR + (size_t)(kt + 16 * tl + r) * 64 + 8 * q;
#pragma unroll
                for (int ks = 4; ks < NKS; ++ks) s[tl] = mfma16(ld_bf16x8(kr + 32 * (ks - 4)), Q[ks], s[tl]); } }
        float p[8]; float tmax = -1e30f;
#pragma unroll
        for (int tl = 0; tl < 2; ++tl)
#pragma unroll
            for (int x = 0; x < 4; ++x) { float v = s[tl][x] * sc; if (WIN) { const int dlt = kt + 16 * tl + 4 * q + x - qpos; if (dlt > 128 || dlt < -128) v = -1e30f; } p[4 * tl + x] = v; tmax = fmaxf(tmax, v); }
        tmax = fmaxf(tmax, __shfl_xor(tmax, 16)); tmax = fmaxf(tmax, __shfl_xor(tmax, 32));
        const float mnew = fmaxf(m, tmax), alpha = exp2f(m - mnew); float psum = 0.f;
#pragma unroll
        for (int x = 0; x < 8; ++x) { p[x] = exp2f(p[x] - mnew); psum += p[x]; }
        lsum = lsum * alpha + psum; m = mnew;
        bf16x8 P;
#pragma unroll
        for (int x = 0; x < 8; ++x) P[x] = (short)f2bf(p[x]);
#pragma unroll
        for (int dt = 0; dt < 8; ++dt) { const bf16* vp = VT + (size_t)(16 * dt + r) * ldvt + kt + 4 * q; const bf16x4 v0 = *(const bf16x4*)vp, v1 = *(const bf16x4*)(vp + 16);
            bf16x8 V; V[0] = v0[0]; V[1] = v0[1]; V[2] = v0[2]; V[3] = v0[3]; V[4] = v1[0]; V[5] = v1[1]; V[6] = v1[2]; V[7] = v1[3];
            o[dt] = mfma16(V, P, o[dt] * alpha); }
    }
}
DEV void attn_store(const f32x4 (&o)[8], float lsum, bf16* orow  , int q) {
    lsum = xrow16_sum(lsum); const float inv = fast_rcp(lsum);
#pragma unroll
    for (int dt = 0; dt < 8; ++dt) { u32x2 w; w.x = pk2(o[dt][0] * inv, o[dt][1] * inv); w.y = pk2(o[dt][2] * inv, o[dt][3] * inv); *(u32x2*)(orow + 16 * dt + 4 * q) = w; }
}
DEV void phase_attn_even(KArgs a, int bid, int G) {
    const int lane = tid_l() & 63, gw = bid * NWAVES + (tid_l() >> 6), NGW = G * NWAVES, r = lane & 15, q = lane >> 4;
    const bf16* QKV = (const bf16*)(a->ws + WS_QKV); const bf16* VTE = (const bf16*)(a->ws + WS_VTE); const bf16* KC = (const bf16*)(a->ws + WS_KC); const bf16* VTC = (const bf16*)(a->ws + WS_VTC);
    bf16* MIX = (bf16*)(a->ws + WS_MIX); const float* sink = a->in[I_SINK];
    constexpr int NQS = L_S / 16, NQP = L_P / 16, NI_S = NB_S * 2 * NQS * 4, NI_P = NB_P * 2 * NQP * 4;
    const float sc = 0.08838834764831845f * LOG2E;
    for (int it = gw; it < NI_S + NI_P; it += NGW) {
        const bool smp = it < NI_S; const int i2 = smp ? it : it - NI_S; const int g = i2 & 3, NQ = smp ? NQS : NQP, qt = (i2 >> 2) % NQ, bk = (i2 >> 2) / NQ, kvh = bk & 1, b = bk >> 1;
        const int head = kvh * 4 + g, seq0 = smp ? TP + b * L_S : b * L_P, q0 = 16 * qt;
        const bf16* qrow = QKV + (size_t)(seq0 + q0 + r) * NQKV + head * 128 + 8 * q;
        bf16x8 Q[4];
#pragma unroll
        for (int ks = 0; ks < 4; ++ks) Q[ks] = ld_bf16x8(qrow + 32 * ks);
        float m = sink[head] * LOG2E, lsum = (q == 0) ? 1.0f : 0.0f; f32x4 o[8];
#pragma unroll
        for (int dt = 0; dt < 8; ++dt) o[dt] = (f32x4){0.f, 0.f, 0.f, 0.f};
        const bf16* K = QKV + (size_t)seq0 * NQKV + 1024 + kvh * 128; const bf16* VT = VTE + (size_t)(kvh * 128) * T + seq0;
        if (smp) {
            int k0 = q0 - 128; if (k0 < 0) k0 = 0; k0 &= ~31; int k1 = (q0 + 16 + 128 + 31) & ~31; if (k1 > L_S) k1 = L_S;
            attn_segment<4, true>(m, lsum, o, Q, K, NQKV, nullptr, VT, T, k0, k1, q0 + r, sc, r, q);
            attn_segment<4, false>(m, lsum, o, Q, KC + (size_t)((b * 2 + kvh) * PAST) * 128, 128, nullptr, VTC + (size_t)((b * 2 + kvh) * 128) * PAST, PAST, 0, PAST, 0, sc, r, q);
        } else attn_segment<4, false>(m, lsum, o, Q, K, NQKV, nullptr, VT, T, 0, L_P, 0, sc, r, q);
        attn_store(o, lsum, MIX + (size_t)(seq0 + q0 + r) * D + 1024 + head * 128, q);
    }
}
DEV void phase_ytrans(KArgs a, LAS unsigned char* lds, int bid, int G) {
    const int lane = tid_l() & 63, wave = tid_l() >> 6, gw = bid * NWAVES + wave, NGW = G * NWAVES;
    LAS bf16* scr = (LAS bf16*)(lds + wave * 16384); constexpr int PT = 36;
    const bf16* YT = (const bf16*)(a->ws + WS_YT); bf16* MIX = (bf16*)(a->ws + WS_MIX);
    for (int it = gw; it < 32 * (T / 64); it += NGW) { const int c0 = 32 * (it % 32), t0 = 64 * (it / 32);
        wsync();
#pragma unroll
        for (int rr = 0; rr < 8; ++rr) { const int c = 4 * rr + (lane >> 4), tk = (lane & 15) * 4; const bf16x4 v = *(const bf16x4*)(YT + (size_t)(c0 + c) * T + t0 + tk);
#pragma unroll
            for (int x = 0; x < 4; ++x) scr[(tk + x) * PT + c] = (bf16)v[x]; }
        wsync();
#pragma unroll
        for (int rr = 0; rr < 8; ++rr) { const int tk = 8 * rr + (lane >> 3), cc = (lane & 7) * 4; *(u32x2*)(MIX + (size_t)(t0 + tk) * D + c0 + cc) = *(const LAS u32x2*)(scr + tk * PT + cc); }
    }
}
#ifdef EMU
DEV bool ANY_LANE(bool p) { int v = p ? 1 : 0; for (int o = 1; o < 64; o <<= 1) v |= __shfl_xor(v, o); return v != 0; }
#else
DEV bool ANY_LANE(bool p) { return __builtin_amdgcn_ballot_w64(p) != 0ull; }
#endif
struct AttnSeg { const bf16* K; const bf16* KR; const bf16* VT; int ldk, ldvt, ntiles, kt0; };
template <int DQK> struct AttnLds { static constexpr int KP = DQK + 8, KB = 32 * KP * 2, VB = 128 * 40 * 2, BUF = KB + VB; };
template <int DQK>
DEV void attn_tile_load(const AttnSeg& s, int kt, u32x4 (&kreg)[2], u32x4& vreg, int tid) {
    constexpr int CPR = DQK / 8;
#pragma unroll
    for (int i = 0; i < 2; ++i) { const int c = tid + 512 * i; if (c < 32 * CPR) { const int key = c / CPR, part = c % CPR;
        const bf16* p = (part < 16) ? s.K + (size_t)(kt + key) * s.ldk + part * 8 : s.KR + (size_t)(kt + key) * 64 + (part - 16) * 8; kreg[i] = *(const u32x4*)p; } }
    { const int dv = tid >> 2, kc = tid & 3; vreg = *(const u32x4*)(s.VT + (size_t)dv * s.ldvt + kt + 8 * kc); }
}
template <int DQK>
DEV void attn_tile_store(LAS unsigned char* buf, const u32x4 (&kreg)[2], const u32x4& vreg, int tid) {
    constexpr int CPR = DQK / 8, KP = AttnLds<DQK>::KP;
#pragma unroll
    for (int i = 0; i < 2; ++i) { const int c = tid + 512 * i; if (c < 32 * CPR) { const int key = c / CPR, part = c % CPR; *(LAS u32x4*)(buf + (key * KP + part * 8) * 2) = kreg[i]; } }
    { const int dv = tid >> 2, kc = tid & 3; LAS unsigned char* vb = buf + AttnLds<DQK>::KB + dv * 80;
      const int k4a = 2 * kc, k4b = 2 * kc + 1;
      *(LAS u32x2*)(vb + (8 * (k4a & 3) + 4 * (k4a >> 2)) * 2) = (u32x2){vreg.x, vreg.y}; *(LAS u32x2*)(vb + (8 * (k4b & 3) + 4 * (k4b >> 2)) * 2) = (u32x2){vreg.z, vreg.w}; }
}
template <int DQK, int QT>
DEV void attn_block(LAS unsigned char* lds, const AttnSeg& s0, const AttnSeg& s1, const bf16x8 (&Q)[QT][DQK / 32], float m0, float l0, bool active, bool win, int qw0, float sc,
                    bf16* orow0  , int tid) {
    constexpr int NKS = DQK / 32, KP = AttnLds<DQK>::KP, BUF = AttnLds<DQK>::BUF;
    const int lane = tid & 63, r = lane & 15, q = lane >> 4;
    float m[QT], ls[QT]; f32x4 o[QT][8];
#pragma unroll
    for (int qi = 0; qi < QT; ++qi) { m[qi] = m0; ls[qi] = (q == 0) ? l0 : 0.f;
#pragma unroll
        for (int dt = 0; dt < 8; ++dt) o[qi][dt] = (f32x4){0.f, 0.f, 0.f, 0.f}; }
    const int nt = s0.ntiles + s1.ntiles;
    u32x4 kreg[2]; u32x4 vreg;
    __syncthreads();
    attn_tile_load<DQK>(s0, s0.kt0, kreg, vreg, tid);
    attn_tile_store<DQK>(lds, kreg, vreg, tid);
    __syncthreads();
    for (int ti = 0; ti < nt; ++ti) {
        LAS unsigned char* cur = lds + (ti & 1) * BUF; LAS unsigned char* nxt = lds + ((ti + 1) & 1) * BUF;
        const bool has_next = ti + 1 < nt;
        if (has_next) { const int tn = ti + 1; if (tn < s0.ntiles) attn_tile_load<DQK>(s0, s0.kt0 + 32 * tn, kreg, vreg, tid); else attn_tile_load<DQK>(s1, s1.kt0 + 32 * (tn - s0.ntiles), kreg, vreg, tid); }
        const bool seg0 = ti < s0.ntiles; const int kt = seg0 ? s0.kt0 + 32 * ti : s1.kt0 + 32 * (ti - s0.ntiles);
        const bool wmask = win && seg0;
        bool doit = active;
        if (wmask) doit = doit && (kt + 31 >= qw0 - 128) && (kt <= qw0 + 16 * QT - 1 + 128);
        if (doit) {
            f32x4 sacc[QT][2];
#pragma unroll
            for (int tl = 0; tl < 2; ++tl) { bf16x8 Kf[NKS];
#pragma unroll
                for (int ks = 0; ks < NKS; ++ks) Kf[ks] = *(const LAS bf16x8*)(cur + ((16 * tl + r) * KP + 32 * ks + 8 * q) * 2);
#pragma unroll
                for (int qi = 0; qi < QT; ++qi) { sacc[qi][tl] = (f32x4){0.f, 0.f, 0.f, 0.f};
#pragma unroll
                    for (int ks = 0; ks < NKS; ++ks) sacc[qi][tl] = mfma16(Kf[ks], Q[qi][ks], sacc[qi][tl]); } }
            bf16x8 P[QT]; float alpha[QT]; bool moved = false;
#pragma unroll
            for (int qi = 0; qi < QT; ++qi) {
                const f32x4 (&s)[2] = sacc[qi];
                float p[8]; float tmax = -1e30f; const int qpos = qw0 + 16 * qi + r;
#pragma unroll
                for (int tl = 0; tl < 2; ++tl)
#pragma unroll
                    for (int x = 0; x < 4; ++x) { float v = s[tl][x]; if (wmask) { const int dlt = kt + 16 * tl + 4 * q + x - qpos; if (dlt > 128 || dlt < -128) v = -1e30f; } p[4 * tl + x] = v; tmax = fmaxf(tmax, v); }
                tmax = xrow16_max(tmax);
                const float mnew = fmaxf(m[qi], tmax * sc); alpha[qi] = fast_exp2(m[qi] - mnew); moved = moved || (mnew > m[qi]); float psum = 0.f;
#pragma unroll
                for (int x = 0; x < 8; ++x) { p[x] = fast_exp2(__builtin_fmaf(p[x], sc, -mnew)); psum += p[x]; }
                ls[qi] = ls[qi] * alpha[qi] + psum; m[qi] = mnew;
                { u32x4 pw; pw.x = pk2(p[0], p[1]); pw.y = pk2(p[2], p[3]); pw.z = pk2(p[4], p[5]); pw.w = pk2(p[6], p[7]); P[qi] = __builtin_bit_cast(bf16x8, pw); }
            }
            if (ANY_LANE(moved)) {
#pragma unroll
                for (int qi = 0; qi < QT; ++qi)
#pragma unroll
                    for (int dt = 0; dt < 8; ++dt) o[qi][dt] = o[qi][dt] * alpha[qi];
            }
#pragma unroll
            for (int dt = 0; dt < 8; ++dt) { const bf16x8 V = *(const LAS bf16x8*)(cur + AttnLds<DQK>::KB + (16 * dt + r) * 80 + 16 * q);
#pragma unroll
                for (int qi = 0; qi < QT; ++qi) o[qi][dt] = mfma16(V, P[qi], o[qi][dt]);
                SCHED_FENCE(); }
        }
        if (has_next) attn_tile_store<DQK>(nxt, kreg, vreg, tid);
        __syncthreads();
    }
    if (active) {
#pragma unroll
        for (int qi = 0; qi < QT; ++qi) attn_store(o[qi], ls[qi], orow0 + (size_t)(16 * qi + r) * D, q);
    }
}
constexpr int PO_QH = 0, PO_FF = 1024, PO_FB = 2048, PO_IH = 3072, PO_GH = 4096, PO_QL = 5120, PO_KVL = 5632, PO_KRP = 5888;
DEV void phase_mla_prep(KArgs a, int bid, int G) {
    const int lane = tid_l() & 63, gw = bid * NWAVES + (tid_l() >> 6), NGW = G * NWAVES;
    const bf16* P = (const bf16*)(a->ws + WS_P); bf16* QN = (bf16*)(a->ws + WS_QN); bf16* CKV = (bf16*)(a->ws + WS_CKV); bf16* KR = (bf16*)(a->ws + WS_KR);
    const float* qn = a->in[I_QNORM]; const float* kvn = a->in[I_KVNORM];
    float qnv[8], kvnv[4];
#pragma unroll
    for (int i = 0; i < 8; ++i) qnv[i] = qn[8 * lane + i];
#pragma unroll
    for (int i = 0; i < 4; ++i) kvnv[i] = kvn[4 * lane + i];
    constexpr int RB = 3;
    for (int row0 = gw; row0 < T; row0 += RB * NGW) {
        bf16x8 xq[RB]; bf16x4 xkv[RB]; bf16 xkr[RB];
#pragma unroll
        for (int j = 0; j < RB; ++j) { const int row = row0 + j * NGW;
            if (row < T) { const bf16* pr = P + (size_t)row * OD_INP; xq[j] = ld_bf16x8(pr + PO_QL + 8 * lane); xkv[j] = *(const bf16x4*)(pr + PO_KVL + 4 * lane); xkr[j] = pr[PO_KRP + lane]; } }
#pragma unroll
        for (int j = 0; j < RB; ++j) { const int row = row0 + j * NGW;
            if (row < T) {
                { float v[8]; float ss = 0.f;
#pragma unroll
                  for (int i = 0; i < 8; ++i) { v[i] = bf2f((bf16)xq[j][i]); ss += v[i] * v[i]; }
                  const float rstd = rsqrtf(wave_sum(ss) * (1.0f / 512.0f) + 1e-6f); u32x4 o;
                  o.x = pk2(v[0] * rstd * qnv[0], v[1] * rstd * qnv[1]); o.y = pk2(v[2] * rstd * qnv[2], v[3] * rstd * qnv[3]);
                  o.z = pk2(v[4] * rstd * qnv[4], v[5] * rstd * qnv[5]); o.w = pk2(v[6] * rstd * qnv[6], v[7] * rstd * qnv[7]);
                  *(u32x4*)(QN + (size_t)row * 512 + 8 * lane) = o; }
                { float v[4]; float ss = 0.f;
#pragma unroll
                  for (int i = 0; i < 4; ++i) { v[i] = bf2f((bf16)xkv[j][i]); ss += v[i] * v[i]; }
                  const float rstd = rsqrtf(wave_sum(ss) * (1.0f / 256.0f) + 1e-6f);
#pragma unroll
                  for (int i = 0; i < 4; ++i) v[i] = v[i] * rstd * kvnv[i];
                  u32x2 o; o.x = pk2(v[0], v[1]); o.y = pk2(v[2], v[3]); *(u32x2*)(CKV + (size_t)row * 256 + 4 * lane) = o;
                  if (row < TP) *(f32x4*)(a->out + OUT_CKV + (size_t)row * 256 + 4 * lane) = (f32x4){v[0], v[1], v[2], v[3]}; }
                { const float x = bf2f(xkr[j]);
                  if (row < TP) { KR[(size_t)row * 64 + lane] = xkr[j]; a->out[OUT_KR + (size_t)row * 64 + lane] = x; }
                  else { const int pos = (row - TP) % L_S, half = lane >> 5, dd = lane & 15, hi = (lane >> 4) & 1;
                      const float inv = exp2f(-(float)dd * (13.287712379549449f / 16.0f)); const float ang = (float)(half ? (pos % 64) : (pos / 64)) * inv; const float cs = fast_cos(ang), sn = fast_sin(ang);
                      const float other = __shfl_xor(x, 16);
                      const float y = hi ? (x * cs + other * sn) : (x * cs - other * sn);
                      KR[(size_t)row * 64 + lane] = (bf16)f2bf(y); } } } }
    }
    const size_t gt = (size_t)bid * NTHR + tid_l(), NGT = (size_t)G * NTHR;
    { const float* s = a->in[I_CCKV]; bf16* d = (bf16*)(a->ws + WS_CKV) + (size_t)T * 256; const size_t n = (size_t)CTX * 256 / 4;
      for (size_t i = gt; i < n; i += NGT) { const f32x4 v = *(const f32x4*)(s + 4 * i); u32x2 o; o.x = pk2(v[0], v[1]); o.y = pk2(v[2], v[3]); *(u32x2*)(d + 4 * i) = o; } }
    { const float* s = a->in[I_CKR]; bf16* d = (bf16*)(a->ws + WS_KR) + (size_t)T * 64; const size_t n = (size_t)CTX * 64 / 4;
      for (size_t i = gt; i < n; i += NGT) { const f32x4 v = *(const f32x4*)(s + 4 * i); u32x2 o; o.x = pk2(v[0], v[1]); o.y = pk2(v[2], v[3]); *(u32x2*)(d + 4 * i) = o; } }
}

constexpr int HG_QD = 0, HG_KD = HG_QD + 64 * 136 * 2, HG_KT = HG_KD + 64 * 136 * 2, HG_VT = HG_KT + 128 * 72 * 2, HG_AL = HG_VT + 128 * 72 * 2, HG_ST = HG_AL + 64 * 72 * 2,
              HG_TOT = HG_ST + 128 * 136 * 2, HG_BEND = HG_TOT + 8 * 128 * 4, HG_END = HG_BEND + 128 * 4;
static_assert(HG_END <= RING_BYTES, "HGRN LDS");
DEV void hgrn_load(const bf16* P, int seq0, int L, int dir, int n, int cg, int colf, int colq, int colv, unsigned (&rf)[8], unsigned (&rq)[8], unsigned (&rv)[8]) {
#pragma unroll
    for (int i = 0; i < 8; ++i) { const int cpos = 64 * n + 8 * cg + i; const int tok = seq0 + (dir ? (L - 1 - cpos) : cpos); const bf16* p = P + (size_t)tok * OD_INP;
        rf[i] = *(const unsigned*)(p + colf); rq[i] = *(const unsigned*)(p + colq); rv[i] = *(const unsigned*)(p + colv); }
}
DEV void hgrn_item(KArgs a, LAS unsigned char* lds, int seq0, int L, int h, int dir, const float* S0  , float* Sout  ) {
    const int tid = tid_l(), lane = tid & 63, wave = tid >> 6, q = lane >> 4, r = lane & 15;
    LAS bf16* qd = (LAS bf16*)(lds + HG_QD); LAS bf16* kd = (LAS bf16*)(lds + HG_KD); LAS bf16* kT = (LAS bf16*)(lds + HG_KT); LAS bf16* vT = (LAS bf16*)(lds + HG_VT);
    LAS bf16* aL = (LAS bf16*)(lds + HG_AL); LAS bf16* sT = (LAS bf16*)(lds + HG_ST); LAS float* tot = (LAS float*)(lds + HG_TOT); LAS float* bend = (LAS float*)(lds + HG_BEND);
    const bf16* P = (const bf16*)(a->ws + WS_P); _Float16* OD = (_Float16*)(a->ws + WS_HFF) + (size_t)dir * T * 1024;
    const int d = 2 * (tid & 63), cg = tid >> 6;
    float lb[2];
#pragma unroll
    for (int y = 0; y < 2; ++y) lb[y] = sigmoid_f(a->in[I_HGLB][(size_t)(1 * 2 + dir) * 1024 + h * 128 + d + y] - a->in[I_HGLB][(size_t)(0 * 2 + dir) * 1024 + h * 128 + d + y]);
    const int colf = (dir ? PO_FB : PO_FF) + h * 128 + d, colq = PO_QH + h * 128 + d, colv = PO_IH + h * 128 + d;
    f32x4 S[8];
#pragma unroll
    for (int dvt = 0; dvt < 8; ++dvt) S[dvt] = (f32x4){0.f, 0.f, 0.f, 0.f};
    if (S0) {
#pragma unroll
        for (int dvt = 0; dvt < 8; ++dvt)
#pragma unroll
            for (int x = 0; x < 4; ++x) S[dvt][x] = S0[(size_t)(16 * wave + 4 * q + x) * 128 + 16 * dvt + r]; }
#pragma unroll
    for (int dvt = 0; dvt < 8; ++dvt) {
        u32x2 w; w.x = pk2(S[dvt][0], S[dvt][1]); w.y = pk2(S[dvt][2], S[dvt][3]); *(LAS u32x2*)(sT + (16 * dvt + r) * 136 + 16 * wave + 4 * q) = w; }
    const int nch = L / 64;
    unsigned rf[8], rq[8], rv[8];
    hgrn_load(P, seq0, L, dir, 0, cg, colf, colq, colv, rf, rq, rv);
    f16x4 opend[4]; _Float16* opend_p = OD;
#pragma unroll
    for (int x = 0; x < 4; ++x) opend[x] = (f16x4){0, 0, 0, 0};
    for (int n = 0; n < nch; ++n) {
        if (n > 0) {
#pragma unroll
            for (int x = 0; x < 4; ++x) __builtin_nontemporal_store(opend[x], (f16x4*)(opend_p + 16 * x)); }
        unsigned nf[8], nq[8], nv[8];
        if (n + 1 < nch) hgrn_load(P, seq0, L, dir, n + 1, cg, colf, colq, colv, nf, nq, nv);
        float lf[2][8], kk[2][8], run[2] = {0.f, 0.f};
#pragma unroll
        for (int i = 0; i < 8; ++i)
#pragma unroll
            for (int y = 0; y < 2; ++y) { const float fz = y ? __uint_as_float(rf[i] & 0xffff0000u) : __uint_as_float(rf[i] << 16); const float f = lb[y] + (1.0f - lb[y]) * sigmoid_f(fz);
                kk[y][i] = 1.0f - f; run[y] += __logf(f); lf[y][i] = run[y]; }
        *(LAS f32x2*)(tot + cg * 128 + d) = (f32x2){run[0], run[1]};
        lds_barrier();
        float base[2] = {0.f, 0.f}, be[2] = {0.f, 0.f};
#pragma unroll
        for (int x = 0; x < 8; ++x) { const f32x2 tv = *(const LAS f32x2*)(tot + x * 128 + d); if (x < cg) { base[0] += tv[0]; base[1] += tv[1]; } be[0] += tv[0]; be[1] += tv[1]; }
        const float bendv[2] = {__expf(be[0]), __expf(be[1])};
        if (cg == 0) *(LAS f32x2*)(bend + d) = (f32x2){bendv[0], bendv[1]};
        { float kef[2][8]; unsigned kev[2][4], vv[2][4];
#pragma unroll
          for (int i = 0; i < 8; ++i) { float qdf[2], kdf[2];
#pragma unroll
              for (int y = 0; y < 2; ++y) { const float b = base[y] + lf[y][i]; const float qv = silu_f(y ? __uint_as_float(rq[i] & 0xffff0000u) : __uint_as_float(rq[i] << 16));
                  const float eb = __expf(b), enb = __expf(-b); qdf[y] = qv * eb; kdf[y] = kk[y][i] * enb; kef[y][i] = kk[y][i] * (bendv[y] * enb); }
              *(LAS unsigned*)(qd + (8 * cg + i) * 136 + d) = pk2(qdf[0], qdf[1]); *(LAS unsigned*)(kd + (8 * cg + i) * 136 + d) = pk2(kdf[0], kdf[1]); }
#pragma unroll
          for (int y = 0; y < 2; ++y)
#pragma unroll
              for (int i2 = 0; i2 < 4; ++i2) { kev[y][i2] = pk2(kef[y][2 * i2], kef[y][2 * i2 + 1]);
                  vv[y][i2] = y ? ((rv[2 * i2] >> 16) | (rv[2 * i2 + 1] & 0xffff0000u)) : ((rv[2 * i2] & 0xffffu) | (rv[2 * i2 + 1] << 16)); }
#pragma unroll
          for (int y = 0; y < 2; ++y) { *(LAS u32x4*)(kT + (d + y) * 72 + 8 * cg) = (u32x4){kev[y][0], kev[y][1], kev[y][2], kev[y][3]}; *(LAS u32x4*)(vT + (d + y) * 72 + 8 * cg) = (u32x4){vv[y][0], vv[y][1], vv[y][2], vv[y][3]}; } }
        lds_barrier();
        { const int ct = wave & 3, sp = wave >> 2;
#pragma unroll
          for (int x = 0; x < 2; ++x) { const int st = 2 * sp + x; f32x4 acc = (f32x4){0.f, 0.f, 0.f, 0.f};
#pragma unroll
              for (int ks = 0; ks < 4; ++ks) acc = mfma16(*(const LAS bf16x8*)(kd + (16 * st + r) * 136 + 32 * ks + 8 * q), *(const LAS bf16x8*)(qd + (16 * ct + r) * 136 + 32 * ks + 8 * q), acc);
              const int cc = 16 * ct + r, s0 = 16 * st + 4 * q; float v[4];
#pragma unroll
              for (int y = 0; y < 4; ++y) v[y] = (s0 + y <= cc) ? acc[y] : 0.f;
              u32x2 w; w.x = pk2(v[0], v[1]); w.y = pk2(v[2], v[3]); *(LAS u32x2*)(aL + cc * 72 + s0) = w; } }
        lds_barrier();
        { const int ct = wave & 3, dv0 = 4 * (wave >> 2);
          bf16x8 Ba[2], Bq[4];
#pragma unroll
          for (int kx = 0; kx < 2; ++kx) Ba[kx] = *(const LAS bf16x8*)(aL + (16 * ct + r) * 72 + 32 * kx + 8 * q);
#pragma unroll
          for (int ks = 0; ks < 4; ++ks) Bq[ks] = *(const LAS bf16x8*)(qd + (16 * ct + r) * 136 + 32 * ks + 8 * q);
          const int cpos = 64 * n + 16 * ct + r; const int tok = seq0 + (dir ? (L - 1 - cpos) : cpos);
#pragma unroll
          for (int x = 0; x < 4; ++x) { const int dvt = dv0 + x; f32x4 acc = (f32x4){0.f, 0.f, 0.f, 0.f};
#pragma unroll
              for (int kx = 0; kx < 2; ++kx) acc = mfma16(*(const LAS bf16x8*)(vT + (16 * dvt + r) * 72 + 32 * kx + 8 * q), Ba[kx], acc);
#pragma unroll
              for (int ks = 0; ks < 4; ++ks) acc = mfma16(*(const LAS bf16x8*)(sT + (16 * dvt + r) * 136 + 32 * ks + 8 * q), Bq[ks], acc);
              opend[x] = __builtin_convertvector(acc, f16x4); }
          opend_p = OD + (size_t)tok * 1024 + h * 128 + 16 * dv0 + 4 * q; }
        { bf16x8 Ak[2];
#pragma unroll
          for (int kx = 0; kx < 2; ++kx) Ak[kx] = *(const LAS bf16x8*)(kT + (16 * wave + r) * 72 + 32 * kx + 8 * q);
          const f32x4 dec = *(const LAS f32x4*)(bend + 16 * wave + 4 * q);
#pragma unroll
          for (int dvt = 0; dvt < 8; ++dvt) { f32x4 acc = S[dvt] * dec;
#pragma unroll
              for (int kx = 0; kx < 2; ++kx) acc = mfma16(Ak[kx], *(const LAS bf16x8*)(vT + (16 * dvt + r) * 72 + 32 * kx + 8 * q), acc);
              S[dvt] = acc; } }
        lds_barrier();
#pragma unroll
        for (int dvt = 0; dvt < 8; ++dvt) { u32x2 w; w.x = pk2(S[dvt][0], S[dvt][1]); w.y = pk2(S[dvt][2], S[dvt][3]); *(LAS u32x2*)(sT + (16 * dvt + r) * 136 + 16 * wave + 4 * q) = w; }
#pragma unroll
        for (int i = 0; i < 8; ++i) { rf[i] = nf[i]; rq[i] = nq[i]; rv[i] = nv[i]; }
    }
#pragma unroll
    for (int x = 0; x < 4; ++x) __builtin_nontemporal_store(opend[x], (f16x4*)(opend_p + 16 * x));
    if (Sout) {
#pragma unroll
        for (int dvt = 0; dvt < 8; ++dvt)
#pragma unroll
            for (int x = 0; x < 4; ++x) Sout[(size_t)(16 * wave + 4 * q + x) * 128 + 16 * dvt + r] = S[dvt][x];
    }
    __syncthreads();
}
DEV void hgrn_run(KArgs a, LAS unsigned char* lds, int item) {
    constexpr int NSI = NB_S * 8 * 2;
    const bool smp = item < NSI; const int i2 = smp ? item : item - NSI; const int dir = i2 & 1, h = (i2 >> 1) & 7, b = i2 >> 4;
    if (smp) hgrn_item(a, lds, TP + b * L_S, L_S, h, dir, a->in[I_ST] + ((size_t)(b * 2 + dir) * 8 + h) * 16384, nullptr);
    else hgrn_item(a, lds, b * L_P, L_P, h, dir, nullptr, a->out + OUT_ST + ((size_t)(b * 2 + dir) * 8 + h) * 16384);
}
DEV void phase_hgrn(KArgs a, LAS unsigned char* lds, int bid, int G) {
    constexpr int NSI = NB_S * 8 * 2, NPI = NB_P * 8 * 2;
    if (G > NSI) {
        const int nps = 0;
        if (bid < NSI) { hgrn_run(a, lds, bid); if (bid < nps) hgrn_run(a, lds, NSI + bid); }
        else for (int j = nps + bid - NSI; j < NPI; j += G - NSI) hgrn_run(a, lds, NSI + j);
    } else for (int it = bid; it < NSI + NPI; it += G) hgrn_run(a, lds, it);
}
typedef _Float16 f16x8 __attribute__((ext_vector_type(8)));
typedef float f32x8 __attribute__((ext_vector_type(8)));
DEV void phase_hgrn_combine(KArgs a, int bid, int G) {
    constexpr int RB = 3;
    const int lane = tid_l() & 63, gw = bid * NWAVES + (tid_l() >> 6), NGW = G * NWAVES;
    const _Float16* O0 = (const _Float16*)(a->ws + WS_HFF); const _Float16* O1 = O0 + (size_t)T * 1024; const bf16* P = (const bf16*)(a->ws + WS_P); bf16* MIX = (bf16*)(a->ws + WS_MIX);
    const float* hn = a->in[I_HGNORM];
    const int e0 = 16 * lane;
    float hnv[16];
#pragma unroll
    for (int i = 0; i < 16; ++i) hnv[i] = hn[(e0 + i) & 127];
    for (int row0 = gw; row0 < T; row0 += RB * NGW) {
        u32x4 xa[RB][2], xb[RB][2]; bf16x8 gg[RB][2];
#pragma unroll
        for (int j = 0; j < RB; ++j) { const int row = row0 + j * NGW;
            if (row < T) {
#pragma unroll
                for (int k = 0; k < 2; ++k) { xa[j][k] = __builtin_nontemporal_load((const u32x4*)(O0 + (size_t)row * 1024 + e0 + 8 * k)); xb[j][k] = __builtin_nontemporal_load((const u32x4*)(O1 + (size_t)row * 1024 + e0 + 8 * k));
                    gg[j][k] = ld_bf16x8(P + (size_t)row * OD_INP + PO_GH + e0 + 8 * k); } } }
#pragma unroll
        for (int j = 0; j < RB; ++j) { const int row = row0 + j * NGW;
            if (row < T) {
                float v[16]; float ss = 0.f;
#pragma unroll
                for (int k = 0; k < 2; ++k) { const f32x8 x = __builtin_convertvector(__builtin_bit_cast(f16x8, xa[j][k]), f32x8) + __builtin_convertvector(__builtin_bit_cast(f16x8, xb[j][k]), f32x8);
#pragma unroll
                    for (int i = 0; i < 8; ++i) { v[8 * k + i] = x[i]; ss += x[i] * x[i]; } }
                ss += __shfl_xor(ss, 1); ss += __shfl_xor(ss, 2); ss += __shfl_xor(ss, 4);
                const float rstd = rsqrtf(ss * (1.0f / 128.0f) + 1e-6f);
                float o[16];
#pragma unroll
                for (int i = 0; i < 16; ++i) { const float gz = bf2f((bf16)gg[j][i >> 3][i & 7]); o[i] = v[i] * rstd * hnv[i] * silu_f(gz); }
                u32x4 w0, w1; w0.x = pk2(o[0], o[1]); w0.y = pk2(o[2], o[3]); w0.z = pk2(o[4], o[5]); w0.w = pk2(o[6], o[7]); w1.x = pk2(o[8], o[9]); w1.y = pk2(o[10], o[11]); w1.z = pk2(o[12], o[13]); w1.w = pk2(o[14], o[15]);
                *(u32x4*)(MIX + (size_t)row * D + e0) = w0; *(u32x4*)(MIX + (size_t)row * D + e0 + 8) = w1; } }
    }
}
DEV void phase_attn_mla(KArgs a, int bid, int G) {
    const int lane = tid_l() & 63, gw = bid * NWAVES + (tid_l() >> 6), NGW = G * NWAVES, r = lane & 15, q = lane >> 4;
    const bf16* QM = (const bf16*)(a->ws + WS_QM); const bf16* KN = (const bf16*)(a->ws + WS_KN); const bf16* KRb = (const bf16*)(a->ws + WS_KR); const bf16* VTM = (const bf16*)(a->ws + WS_VTM);
    bf16* MIX = (bf16*)(a->ws + WS_MIX);
    constexpr int NQS = L_S / 16, NQP = L_P / 16, NI_S = NB_S * 8 * NQS, NI_P = NB_P * 8 * NQP;
    const float sc = 0.07216878364870323f * LOG2E;
    for (int it = gw; it < NI_S + NI_P; it += NGW) {
        const bool smp = it < NI_S; const int i2 = smp ? it : it - NI_S; const int NQ = smp ? NQS : NQP, h = i2 & 7, qt = (i2 >> 3) % NQ, b = (i2 >> 3) / NQ;
        const int seq0 = smp ? TP + b * L_S : b * L_P, q0 = 16 * qt;
        const bf16* qrow = QM + (size_t)(seq0 + q0 + r) * 1536 + h * 192;
        bf16x8 Q[6];
#pragma unroll
        for (int ks = 0; ks < 4; ++ks) Q[ks] = ld_bf16x8(qrow + 32 * ks + 8 * q);
#pragma unroll
        for (int ks = 4; ks < 6; ++ks) { const bf16x8 own = ld_bf16x8(qrow + 32 * ks + 8 * q);
            if (smp) { const bf16x8 oth = ld_bf16x8(qrow + 32 * ks + 8 * (q ^ 2)); const int pos = q0 + r; const float pp = (float)(ks == 4 ? (pos / 64) : (pos % 64)); bf16x8 o;
#pragma unroll
                for (int j = 0; j < 8; ++j) { const int dd = (8 * q + j) & 15; const float inv = exp2f(-(float)dd * (13.287712379549449f / 16.0f)); const float ang = pp * inv, cs = fast_cos(ang), sn = fast_sin(ang);
                    const float x = bf2f((bf16)own[j]), y = bf2f((bf16)oth[j]); o[j] = (short)f2bf((q & 2) ? (x * cs + y * sn) : (x * cs - y * sn)); }
                Q[ks] = o; }
            else Q[ks] = own; }
        float m = -1e30f, lsum = 0.f; f32x4 o[8];
#pragma unroll
        for (int dt = 0; dt < 8; ++dt) o[dt] = (f32x4){0.f, 0.f, 0.f, 0.f};
        attn_segment<6, false>(m, lsum, o, Q, KN + (size_t)seq0 * 1024 + h * 128, 1024, KRb + (size_t)seq0 * 64, VTM + (size_t)(h * 128) * TK + seq0, TK, 0, smp ? L_S : L_P, 0, sc, r, q);
        if (smp) { const int c0 = T + b * PAST; attn_segment<6, false>(m, lsum, o, Q, KN + (size_t)c0 * 1024 + h * 128, 1024, KRb + (size_t)c0 * 64, VTM + (size_t)(h * 128) * TK + c0, TK, 0, PAST, 0, sc, r, q); }
        attn_store(o, lsum, MIX + (size_t)(seq0 + q0 + r) * D + 1024 + h * 128, q);
    }
}
DEV void phase_attn_even2(KArgs a, LAS unsigned char* lds, int bid, int G) {
    constexpr int QT = 2, PPB = 2 * 16 * QT;
    const int tid = tid_l(), lane = tid & 63, wave = tid >> 6, r = lane & 15, q = lane >> 4;
    const bf16* QKV = (const bf16*)(a->ws + WS_QKV); const bf16* VTE = (const bf16*)(a->ws + WS_VTE); const bf16* KC = (const bf16*)(a->ws + WS_KC); const bf16* VTC = (const bf16*)(a->ws + WS_VTC);
    bf16* MIX = (bf16*)(a->ws + WS_MIX); const float* sink = a->in[I_SINK];
    constexpr int NBS = L_S / PPB, NBP = L_P / PPB, NI_S = NB_S * 2 * NBS, NI_P = NB_P * 2 * NBP;
    const float sc = 0.08838834764831845f * LOG2E;
    for (int it = bid; it < NI_S + NI_P; it += G) {
        const bool smp = it < NI_S; const int i2 = smp ? it : it - NI_S; const int NBq = smp ? NBS : NBP, qb = i2 % NBq, kvh = (i2 / NBq) & 1, b = (i2 / NBq) >> 1;
        const int g = wave & 3, pg = wave >> 2, head = kvh * 4 + g, seq0 = smp ? TP + b * L_S : b * L_P, L = smp ? L_S : L_P, qw0 = qb * PPB + pg * 16 * QT;
        bf16x8 Q[QT][4];
#pragma unroll
        for (int qi = 0; qi < QT; ++qi) { const bf16* qrow = QKV + (size_t)(seq0 + qw0 + 16 * qi + r) * NQKV + head * 128 + 8 * q;
#pragma unroll
            for (int ks = 0; ks < 4; ++ks) Q[qi][ks] = ld_bf16x8(qrow + 32 * ks); }
        AttnSeg s0, s1;
        s0.K = QKV + (size_t)seq0 * NQKV + 1024 + kvh * 128; s0.KR = nullptr; s0.VT = VTE + (size_t)(kvh * 128) * T + seq0; s0.ldk = NQKV; s0.ldvt = T;
        if (smp) { int k0 = qb * PPB - 128; if (k0 < 0) k0 = 0; k0 &= ~31; int k1 = (qb * PPB + PPB + 128 + 31) & ~31; if (k1 > L) k1 = L; s0.kt0 = k0; s0.ntiles = (k1 - k0) / 32;
            s1.K = KC + (size_t)((b * 2 + kvh) * PAST) * 128; s1.KR = nullptr; s1.VT = VTC + (size_t)((b * 2 + kvh) * 128) * PAST; s1.ldk = 128; s1.ldvt = PAST; s1.ntiles = PAST / 32; s1.kt0 = 0; }
        else { s0.kt0 = 0; s0.ntiles = L / 32; s1 = s0; s1.ntiles = 0; }
        attn_block<128, QT>(lds, s0, s1, Q, sink[head] * LOG2E, 1.0f, true, smp, qw0, sc, MIX + (size_t)(seq0 + qw0) * D + 1024 + head * 128, tid);
    }
}
DEV void phase_attn_mla2(KArgs a, LAS unsigned char* lds, int bid, int G) {
    constexpr int QT = 2, RPB = 8 * 16 * QT;
    const int tid = tid_l(), lane = tid & 63, wave = tid >> 6, r = lane & 15, q = lane >> 4;
    const bf16* QM = (const bf16*)(a->ws + WS_QM); const bf16* KN = (const bf16*)(a->ws + WS_KN); const bf16* KRb = (const bf16*)(a->ws + WS_KR); const bf16* VTM = (const bf16*)(a->ws + WS_VTM);
    bf16* MIX = (bf16*)(a->ws + WS_MIX);
    constexpr int NBS = (L_S + RPB - 1) / RPB, NBP = (L_P + RPB - 1) / RPB, NI_S = NB_S * 8 * NBS, NI_P = NB_P * 8 * NBP;
    const float sc = 0.07216878364870323f * LOG2E;
    for (int it = bid; it < NI_S + NI_P; it += G) {
        const bool smp = it < NI_S; const int i2 = smp ? it : it - NI_S; const int NBq = smp ? NBS : NBP, qb = i2 % NBq, h = (i2 / NBq) & 7, b = (i2 / NBq) >> 3;
        const int seq0 = smp ? TP + b * L_S : b * L_P, L = smp ? L_S : L_P, qw0 = qb * RPB + wave * 16 * QT; const bool active = qw0 < L;
        bf16x8 Q[QT][6];
#pragma unroll
        for (int qi = 0; qi < QT; ++qi) { const int pos = active ? qw0 + 16 * qi + r : r; const bf16* qrow = QM + (size_t)(seq0 + pos) * 1536 + h * 192;
#pragma unroll
            for (int ks = 0; ks < 4; ++ks) Q[qi][ks] = ld_bf16x8(qrow + 32 * ks + 8 * q);
#pragma unroll
            for (int ks = 4; ks < 6; ++ks) { const bf16x8 own = ld_bf16x8(qrow + 32 * ks + 8 * q);
                if (smp) { const bf16x8 oth = ld_bf16x8(qrow + 32 * ks + 8 * (q ^ 2)); const float pp = (float)(ks == 4 ? (pos / 64) : (pos % 64)); bf16x8 o;
#pragma unroll
                    for (int j = 0; j < 8; ++j) { const int dd = (8 * q + j) & 15; const float inv = exp2f(-(float)dd * (13.287712379549449f / 16.0f)); const float ang = pp * inv, cs = fast_cos(ang), sn = fast_sin(ang);
                        const float x = bf2f((bf16)own[j]), y = bf2f((bf16)oth[j]); o[j] = (short)f2bf((q & 2) ? (x * cs + y * sn) : (x * cs - y * sn)); }
                    Q[qi][ks] = o; }
                else Q[qi][ks] = own; } }
        AttnSeg s0, s1;
        s0.K = KN + (size_t)seq0 * 1024 + h * 128; s0.KR = KRb + (size_t)seq0 * 64; s0.VT = VTM + (size_t)(h * 128) * TK + seq0; s0.ldk = 1024; s0.ldvt = TK; s0.kt0 = 0; s0.ntiles = L / 32;
        s1 = s0; s1.ntiles = 0;
        if (smp) { const int c0 = T + b * PAST; s1.K = KN + (size_t)c0 * 1024 + h * 128; s1.KR = KRb + (size_t)c0 * 64; s1.VT = VTM + (size_t)(h * 128) * TK + c0; s1.ntiles = PAST / 32; }
        attn_block<192, QT>(lds, s0, s1, Q, -1e30f, 0.0f, active, false, qw0, sc, MIX + (size_t)(seq0 + (active ? qw0 : 0)) * D + 1024 + h * 128, tid);
    }
}
#ifndef EMU
#define XB_TMO      128
#define XB_XCNT(j)  (256  + 64 * (j))
#define XB_XSUB(j)  (1280 + 64 * (j))
#define XB_XGEN(j)  (2304 + 64 * (j))
#define XB_TOP      3328
#define XB_TOPGEN   3392
#define XCD_BAR_WORDS 3456
#define XB_SPIN_CAP (1u << 18)
__device__ __forceinline__ unsigned xb_ld(unsigned* p)              { return __hip_atomic_load(p, __ATOMIC_RELAXED, __HIP_MEMORY_SCOPE_AGENT); }
__device__ __forceinline__ unsigned xb_add(unsigned* p, unsigned v) { return __hip_atomic_fetch_add(p, v, __ATOMIC_RELAXED, __HIP_MEMORY_SCOPE_AGENT); }
__device__ __forceinline__ unsigned xb_xcc_id() { return (unsigned)__builtin_amdgcn_s_getreg((3 << 11) | 20) & 0xFu; }
#define XB_SPIN(cond, bar) do { unsigned _sp = 0; while (cond) { __builtin_amdgcn_s_sleep(1); \
    if ((++_sp & 255u) == 0u) { if (xb_ld(&(bar)[XB_TMO])) break; if (_sp > XB_SPIN_CAP) { atomicAdd(&(bar)[XB_TMO], 1u); break; } } } } while (0)
struct XcdBarrier { unsigned* bar; unsigned x; volatile LAS unsigned* st; };
__device__ __forceinline__ XcdBarrier xcd_barrier_post(unsigned* bar, volatile LAS unsigned* st) {
    XcdBarrier b; b.bar = bar; b.x = xb_xcc_id(); b.st = st;
    if (threadIdx.x == 0) (void)xb_add(&bar[XB_XCNT(b.x)], 1u);
    return b;
}
__device__ __forceinline__ void xcd_barrier_complete(unsigned* bar, unsigned x, unsigned& nloc, unsigned& nx) {
    const unsigned G = gridDim.x * gridDim.y * gridDim.z;
    unsigned sum, cnt, mine, sp = 0u;
    for (;;) {
        sum = 0u; cnt = 0u; mine = 0u;
#pragma unroll
        for (unsigned j = 0; j < 16; ++j) { const unsigned c = xb_ld(&bar[XB_XCNT(j)]); sum += c; cnt += (c > 0u) ? 1u : 0u; mine = (j == x) ? c : mine; }
        if (sum == G) break;
        __builtin_amdgcn_s_sleep(1);
        if ((++sp & 255u) == 0u) { if (xb_ld(&bar[XB_TMO])) break; if (sp > XB_SPIN_CAP) { atomicAdd(&bar[XB_TMO], 1u); break; } }
    }
    nloc = mine > 0u ? mine : 1u; nx = cnt > 0u ? cnt : 1u;
}
__device__ __forceinline__ void xcd_barrier(const XcdBarrier& b) {
    asm volatile("s_waitcnt vmcnt(0)" ::: "memory");
    __syncthreads();
    if (threadIdx.x == 0) {
        unsigned* bar = b.bar;
        __builtin_amdgcn_s_waitcnt(0);
        unsigned nloc = b.st[0], nx = b.st[1];
        if (nloc == 0u) { xcd_barrier_complete(bar, b.x, nloc, nx); b.st[0] = nloc; b.st[1] = nx; }
        const unsigned old = xb_add(&bar[XB_XSUB(b.x)], 1u);
        const unsigned gen = old / nloc;
        if (old + 1u == (gen + 1u) * nloc) {
            __builtin_amdgcn_fence(__ATOMIC_RELEASE, "agent");
            asm volatile("s_waitcnt vmcnt(0)" ::: "memory");
            const unsigned og = xb_add(&bar[XB_TOP], 1u);
            const unsigned tg = og / nx;
            if (og + 1u == (tg + 1u) * nx) xb_add(&bar[XB_TOPGEN], 1u);
            else XB_SPIN(xb_ld(&bar[XB_TOPGEN]) == tg, bar);
            __builtin_amdgcn_fence(__ATOMIC_ACQUIRE, "agent");
            xb_add(&bar[XB_XGEN(b.x)], 1u);
            asm volatile("s_waitcnt vmcnt(0)" ::: "memory");
        } else {
            XB_SPIN(xb_ld(&bar[XB_XGEN(b.x)]) == gen, bar);
            __builtin_amdgcn_fence(__ATOMIC_ACQUIRE, "agent");
            asm volatile("s_waitcnt vmcnt(0)" ::: "memory");
        }
    }
    __syncthreads();
}
#endif

constexpr int N_PHASES = 3 + 2 * 12;
constexpr int CW_BAR = 4096;
#ifdef EMU
struct XcdBarrier { int dummy; };
DEV void xcd_barrier(const XcdBarrier&) {}
#endif
#ifndef REP_MASK
#define REP_MASK 0ull
#endif
#ifdef EMU
DEV int launder_s(int x) { return x; }
#else
DEV int launder_s(int x) { asm volatile("" : "+s"(x)); return x; }
#endif
#define INP(k) (LO <= (k) && (k) < HI)
#define WSV unsigned char* ws = a->ws; bf16* HN = (bf16*)(ws + WS_HN); bf16* HFF = (bf16*)(ws + WS_HFF); float* OUT0 = (float*)(ws + WS_OUT); float* OUT1 = OUT0 + (size_t)T * D; bf16* MIX = (bf16*)(ws + WS_MIX); (void)HN; (void)HFF; (void)OUT0; (void)OUT1; (void)MIX;
#define PHASE(k, ...) do { if constexpr (INP(k)) { { KArgs a = kargs(); const int bid = launder_s(bid0), G = launder_s(G0); WSV __VA_ARGS__ } if constexpr (((REP_MASK) >> (k)) & 1ull) { xcd_barrier(bar); { KArgs a = kargs(); const int bid = launder_s(bid0), G = launder_s(G0); WSV __VA_ARGS__ } } } } while (0)
#define SEAMP(k) do { if constexpr (INP(k) && INP((k) + 1)) xcd_barrier(bar); } while (0)
template <int LO, int HI, int l, int s>
DEV void ffn_phases(LAS unsigned char* lds, int bid0, int G0, const XcdBarrier& bar) {
    constexpr int p0 = 3 + 12 * l + 9 * s;
    PHASE(p0,
        constexpr int units = (T / 256) * (2 * DFF / 256); constexpr bool hasconv = (p0 == 3 || p0 == 12 || p0 == 15);
        const int Gg = hasconv ? gemm_groups(units, G) : G;
        if (bid < Gg) {
            pg8::Gemm g{D, D, D}; pg8::MultiOrder S; constexpr int ns_ = 1, lda_ = D, ldb_ = D;
            const pg8::SubG g0_ = pg8::SubG{HN, (const bf16*)(ws + WS_WGU + (size_t)(l * 2 + s) * SZ_WGU1), T / 256, 2 * DFF / 256}; S.init(g0_, g0_, g0_, ns_, Gg, bid, lda_, ldb_);
            pg8::EpiSwiGLU E{HFF, DFF};
            pg8::gemm_phase<pg8::EpiSwiGLU, pg8::MultiOrder, true, true>(lds, g, S, E);
        }
        if constexpr (hasconv) { if (Gg == G) conv_work<p0>(a, lds, bid, G); else if (bid >= Gg) conv_work<p0>(a, lds, bid - Gg, G - Gg); }
    ); SEAMP(p0);
    PHASE(p0 + 1,
        constexpr int KH = DFF / 2; pg8::Gemm g{KH, DFF, DFF}; pg8::MultiOrder S; constexpr int ns_ = 2, lda_ = DFF, ldb_ = DFF;
        const bf16* wd = (const bf16*)(ws + WS_WD + (size_t)(l * 2 + s) * SZ_WD1);
        const pg8::SubG g0_ = pg8::SubG{HFF, wd, T / 256, D / 256}, g1_ = pg8::SubG{HFF + KH, wd + KH, T / 256, D / 256}; S.init(g0_, g1_, g0_, ns_, G, bid, lda_, ldb_);
        const pg8::EpiBf16M E = pg8::EpiBf16M::make((bf16*)OUT0, (bf16*)OUT0 + (size_t)T * D, nullptr, D, D, 0);
        pg8::gemm_phase<pg8::EpiBf16M, pg8::MultiOrder, true, true>(lds, g, S, E);
    ); SEAMP(p0 + 1);
    PHASE(p0 + 2,
        constexpr int j = 2 * s; constexpr bool first = (l == 0 && s == 0), last = (l == 1 && s == 1);
        constexpr int nl = (s == 0) ? l : (l == 0 ? 1 : -1), nj = (s == 0) ? 1 : 0;
        phase_residual(a, lds, bid, G, l, j, 0.5f, nl, nj, first, last);
    ); SEAMP(p0 + 2);
}
template <int LO, int HI, int l>
DEV void outproj_phases(LAS unsigned char* lds, int bid0, int G0, const XcdBarrier& bar) {
    constexpr int pb = 3 + 12 * l;
    PHASE(pb + 7,
        pg8::Gemm g{1024, D, D}; pg8::MultiOrder S; constexpr int ns_ = 2, lda_ = D, ldb_ = D;
        const bf16* wo = (const bf16*)(ws + (l == 0 ? WS_WEVOUT : WS_WODOUT));
        const pg8::SubG g0_ = pg8::SubG{MIX, wo, T / 256, D / 256}, g1_ = pg8::SubG{MIX + 1024, wo + 1024, T / 256, D / 256}; S.init(g0_, g1_, g0_, ns_, G, bid, lda_, ldb_);
        const pg8::EpiBf16M E = pg8::EpiBf16M::make((bf16*)OUT0, (bf16*)OUT0 + (size_t)T * D, nullptr, D, D, 0);
        pg8::gemm_phase<pg8::EpiBf16M, pg8::MultiOrder, true, true>(lds, g, S, E);
    ); SEAMP(pb + 7);
    PHASE(pb + 8,  phase_residual(a, lds, bid, G, l, 1, 1.0f, l, 2, false, false); ); SEAMP(pb + 8);
}
template <int LO, int HI>
DEV void even_mixer_phases(LAS unsigned char* lds, int bid0, int G0, const XcdBarrier& bar) {
    constexpr int pb = 3;
    PHASE(pb + 3,
        constexpr int units = (3072 / 256) * (T / 256) + (T / 256) * (NQKV / 256) + (T / 256);
        const int Gg = gemm_groups(units, G);
        if (bid < Gg) {
            const bf16* w = (const bf16*)(ws + WS_WEVIN);
            pg8::Gemm g{D, D, D}; pg8::MultiOrder S; constexpr int ns_ = 3, lda_ = D, ldb_ = D;
            const pg8::SubG g0_ = pg8::SubG{w, HN, 3072 / 256, T / 256}, g1_ = pg8::SubG{HN, w + (size_t)3072 * D, T / 256, NQKV / 256}, g2_ = pg8::SubG{w + (size_t)(3072 + 1280) * D, HN, 1, T / 256}; S.init(g0_, g1_, g2_, ns_, Gg, bid, lda_, ldb_);
            const pg8::EpiBf16M E = pg8::EpiBf16M::make((bf16*)(ws + WS_UT), (bf16*)(ws + WS_QKV), (bf16*)(ws + WS_VTE), T, NQKV, T);
            pg8::gemm_phase<pg8::EpiBf16M, pg8::MultiOrder, true, true>(lds, g, S, E);
        }
        if (Gg == G) conv_work<6>(a, lds, bid, G); else if (bid >= Gg) conv_work<6>(a, lds, bid - Gg, G - Gg);
    ); SEAMP(pb + 3);
    if constexpr (INP(pb + 4)) phase_rope_kvout(kargs(), launder_s(bid0), launder_s(G0));
    PHASE(pb + 4, phase_hyena(a, lds, bid, G); ); SEAMP(pb + 4);
    PHASE(pb + 5,  phase_attn_even2(a, lds, bid, G); phase_ytrans(a, lds, bid, G); );
    if constexpr (INP(pb + 5) && INP(pb + 7)) xcd_barrier(bar);
}
template <int LO, int HI>
DEV void odd_mixer_phases(LAS unsigned char* lds, int bid0, int G0, const XcdBarrier& bar) {
    constexpr int pb = 15;
    PHASE(pb + 3,
        constexpr int units = (T / 256) * (OD_INP / 256); const int Gg = gemm_groups(units, G);
        if (bid < Gg) {
            pg8::Gemm g{D, D, D}; pg8::MultiOrder S; constexpr int ns_ = 1, lda_ = D, ldb_ = D;
            const pg8::SubG g0_ = pg8::SubG{HN, (const bf16*)(ws + WS_WODIN), T / 256, OD_INP / 256}; S.init(g0_, g0_, g0_, ns_, Gg, bid, lda_, ldb_);
            const pg8::EpiBf16M E = pg8::EpiBf16M::make((bf16*)(ws + WS_P), nullptr, nullptr, OD_INP, 0, 0);
            pg8::gemm_phase<pg8::EpiBf16M, pg8::MultiOrder, true, true>(lds, g, S, E);
        }
        if (Gg == G) conv_work<18>(a, lds, bid, G); else if (bid >= Gg) conv_work<18>(a, lds, bid - Gg, G - Gg);
    ); SEAMP(pb + 3);
    PHASE(pb + 4,  phase_mla_prep(a, bid, G); ); SEAMP(pb + 4);
    PHASE(pb + 5,
        constexpr int NSI_ = NB_S * 8 * 2; const bool split = G > NSI_;
        phase_hgrn(a, lds, bid, G);
        if (!split || bid >= NSI_) { const int Gg = split ? G - NSI_ : G, cg = split ? bid - NSI_ : bid;
        { pg8::Gemm g{512, 512, 512}; pg8::MultiOrder S; constexpr int ns_ = 1, lda_ = 512, ldb_ = 512;
          const pg8::SubG g0_ = pg8::SubG{(const bf16*)(ws + WS_QN), (const bf16*)(ws + WS_WQB), T / 256, 1536 / 256}; S.init(g0_, g0_, g0_, ns_, Gg, cg, lda_, ldb_);
          const pg8::EpiBf16M E = pg8::EpiBf16M::make((bf16*)(ws + WS_QM), nullptr, nullptr, 1536, 0, 0);
          pg8::gemm_phase<pg8::EpiBf16M, pg8::MultiOrder, true, true>(lds, g, S, E); }
        { pg8::Gemm g{256, 256, 256}; pg8::MultiOrder S; constexpr int ns_ = 2, lda_ = 256, ldb_ = 256;
          const pg8::SubG g0_ = pg8::SubG{(const bf16*)(ws + WS_CKV), (const bf16*)(ws + WS_WKVK), TK / 256, 4}, g1_ = pg8::SubG{(const bf16*)(ws + WS_WKVV), (const bf16*)(ws + WS_CKV), 4, TK / 256}; S.init(g0_, g1_, g0_, ns_, Gg, cg, lda_, ldb_);
          const pg8::EpiBf16M E = pg8::EpiBf16M::make((bf16*)(ws + WS_KN), (bf16*)(ws + WS_VTM), nullptr, 1024, TK, 0);
          pg8::gemm_phase<pg8::EpiBf16M, pg8::MultiOrder, true, true>(lds, g, S, E); }
        }
    ); SEAMP(pb + 5);
    PHASE(pb + 6,  phase_attn_mla2(a, lds, bid, G); phase_hgrn_combine(a, bid, G); ); SEAMP(pb + 6);
}
template <int LO, int HI>
__global__ void __launch_bounds__(NTHR, 2) mk_fwd(Args args) {
#ifdef EMU
    unsigned char* lds = emu_lds_ptr(); XcdBarrier bar{0}; emu_args_p = &args;
#else
    extern __shared__ __attribute__((aligned(16))) unsigned char lds_raw[];
    LAS unsigned char* lds = (LAS unsigned char*)lds_raw;
#endif
        const int bid0 = blockIdx.x, G0 = gridDim.x;
#ifndef EMU
    XcdBarrier bar; bar.bar = (unsigned*)(kargs()->ws + WS_CTL) + CW_BAR; bar.x = 0; bar.st = nullptr;
    if constexpr (HI - LO > 1) {
        { volatile LAS unsigned* misc = (volatile LAS unsigned*)(lds + MISC_OFF); if (threadIdx.x < 32) misc[threadIdx.x] = 0u; }
        __syncthreads();
        bar = xcd_barrier_post((unsigned*)(kargs()->ws + WS_CTL) + CW_BAR, (volatile LAS unsigned*)(lds + MISC_OFF) + 8);
    }
#endif
    PHASE(0,  p0_prologue(a, lds, bid, G); ); SEAMP(0);
    PHASE(1,  p1_mods(a, lds, bid, G); ); SEAMP(1);
    PHASE(2,  phase_norm0(a, bid, G); ); SEAMP(2);
    ffn_phases<LO, HI, 0, 0>(lds, bid0, G0, bar);
    even_mixer_phases<LO, HI>(lds, bid0, G0, bar);
    outproj_phases<LO, HI, 0>(lds, bid0, G0, bar);
    ffn_phases<LO, HI, 0, 1>(lds, bid0, G0, bar);
    ffn_phases<LO, HI, 1, 0>(lds, bid0, G0, bar);
    odd_mixer_phases<LO, HI>(lds, bid0, G0, bar);
    outproj_phases<LO, HI, 1>(lds, bid0, G0, bar);
    ffn_phases<LO, HI, 1, 1>(lds, bid0, G0, bar);
}

#ifndef MK_ONE_LAUNCH
#define MK_ONE_LAUNCH 1
#endif
#ifdef EMU
template <int P> static void emu_run_phases(const Args& a, int grid, int p0, int p1) {
    if constexpr (P < N_PHASES) {
        if (P >= p0 && P < p1 && P != 9) { fprintf(stderr, "[emu] phase %d\n", P); emu_launch(grid, NTHR, LDS_BYTES, [&]() { mk_fwd<P, P + 1>(a); }); }
        emu_run_phases<P + 1>(a, grid, p0, p1);
    }
}
#else
template <int P> static void launch_phases(const Args& a, int grid, hipStream_t stream) {
    if constexpr (P < N_PHASES) {
        if constexpr (P != 9) {
            static bool attr_set = false;
            if (!attr_set) { (void)hipFuncSetAttribute((const void*)mk_fwd<P, P + 1>, hipFuncAttributeMaxDynamicSharedMemorySize, LDS_BYTES); attr_set = true; }
            hipLaunchKernelGGL((mk_fwd<P, P + 1>), dim3(grid), dim3(NTHR), LDS_BYTES, stream, a);
        }
        launch_phases<P + 1>(a, grid, stream);
    }
}
#endif

extern "C" void kernel_launch(void* const* d_in, const int* in_sizes, int n_in, void* d_out, int out_size, void* d_ws, size_t ws_size, hipStream_t stream) {
    static int grid = 0;
    if (grid == 0) {
        if (n_in != 35 || (size_t)out_size != OUT_END || ws_size < WS_END) { fprintf(stderr, "kernel_launch: unexpected problem (n_in %d, out %d vs %zu, ws %zu vs %zu); nothing launched\n", n_in, out_size, (size_t)OUT_END, ws_size, (size_t)WS_END); grid = -1; return; }
#ifdef EMU
        grid = 8; { const char* e = getenv("EMU_GRID"); if (e) grid = atoi(e); }
#else
        int dev = 0, cus = 0, per_cu = 0;
        if (hipGetDevice(&dev) != hipSuccess || hipDeviceGetAttribute(&cus, hipDeviceAttributeMultiprocessorCount, dev) != hipSuccess) { fprintf(stderr, "kernel_launch: device query failed\n"); grid = -1; return; }
#if MK_ONE_LAUNCH
        if (hipFuncSetAttribute((const void*)mk_fwd<0, N_PHASES>, hipFuncAttributeMaxDynamicSharedMemorySize, LDS_BYTES) != hipSuccess) { fprintf(stderr, "kernel_launch: hipFuncSetAttribute failed\n"); grid = -1; return; }
        if (hipOccupancyMaxActiveBlocksPerMultiprocessor(&per_cu, (const void*)mk_fwd<0, N_PHASES>, NTHR, LDS_BYTES) != hipSuccess || per_cu < 1) fprintf(stderr, "kernel_launch: occupancy query says %d blocks per CU\n", per_cu);
        (void)hipGetLastError();
#else
        (void)per_cu;
#endif
        grid = cus;
#endif
    }
    if (grid < 0) return;
    (void)hipMemsetAsync((char*)d_ws + WS_CTL, 0, CTL_BYTES, stream);
    Args a{};
    for (int i = 0; i < 35; ++i) a.in[i] = (const float*)d_in[i];
    a.out = (float*)d_out; a.ws = (unsigned char*)d_ws;
#ifdef EMU
    { int p0 = 0, p1 = N_PHASES; const char* e = getenv("EMU_PH0"); if (e) p0 = atoi(e); e = getenv("EMU_PH1"); if (e) p1 = atoi(e);
      emu_run_phases<0>(a, grid, p0, p1); }
#else
#if MK_ONE_LAUNCH
    hipLaunchKernelGGL((mk_fwd<0, N_PHASES>), dim3(grid), dim3(NTHR), LDS_BYTES, stream, a);
#else
    launch_phases<0>(a, grid, stream);
#endif
    const hipError_t le = hipGetLastError();
    if (le != hipSuccess) fprintf(stderr, "kernel_launch: launch failed: %s\n", hipGetErrorName(le));
#endif
}
```
